# Optimizing an MI355X kernel written in HIP

```python
import jax, jax.numpy as jnp
from jax import lax
import numpy as np

D_MODEL = 1024
BATCH = 2
SEQ = 8192
DEPTH = 1

EPS = 1e-6
D_FF = 2816
N_MOD = 9
GLA_HEADS = 4
GLA_DK = D_MODEL // 2
GLA_DV = D_MODEL
GLA_HK = GLA_DK // GLA_HEADS
GLA_HV = GLA_DV // GLA_HEADS
GLA_RANK = 16
GLA_TAU = 16.0
GLA_CHUNK = 64
FOX_HEADS = 16
FOX_HD = D_MODEL // FOX_HEADS
FOX_W = FOX_HEADS * FOX_HD
Q_BLOCK = 128
SPLITS = (GLA_DK, GLA_DK, GLA_DV, GLA_RANK, GLA_DV, FOX_W, FOX_W, FOX_W, FOX_HEADS, D_MODEL, D_MODEL)
IN_COLS = 2 * GLA_DK + 2 * GLA_DV + GLA_RANK + 3 * FOX_W + FOX_HEADS + 2 * D_MODEL

kernel_name = "hybrid_gla_fox_macaron_adaln"


def rmsnorm(x, g):
    xf = x.astype(jnp.float32)
    y = xf * lax.rsqrt(jnp.mean(xf * xf, axis=-1, keepdims=True) + EPS)
    return (y * g.astype(jnp.float32)).astype(x.dtype)


def swiglu(h, w_gu, w_dn):
    g, u = jnp.split(h @ w_gu, 2, axis=-1)
    return (jax.nn.silu(g) * u) @ w_dn


def gla_chunked(q, k, v, log_a):
    B, H, T, dk = q.shape
    dv = v.shape[-1]
    C = GLA_CHUNK
    N = T // C

    def to_chunks(a):
        return a.reshape(B, H, N, C, a.shape[-1]).transpose(2, 0, 1, 3, 4)

    qc, kc, vc, gc = to_chunks(q), to_chunks(k), to_chunks(v), to_chunks(log_a)
    causal = jnp.tril(jnp.ones((C, C), dtype=bool))[:, :, None]

    def step(S, inp):
        qi, ki, vi, gi = inp
        b = jnp.cumsum(gi, axis=2)
        o_inter = jnp.einsum('bhtd,bhde->bhte', qi * jnp.exp(b), S)
        diff = b[:, :, :, None, :] - b[:, :, None, :, :]
        decay = jnp.exp(jnp.where(causal, diff, -jnp.inf))
        A = jnp.einsum('bhtd,bhsd,bhtsd->bhts', qi, ki, decay)
        o = o_inter + jnp.einsum('bhts,bhse->bhte', A, vi)
        b_last = b[:, :, -1:, :]
        S_new = jnp.exp(b_last[:, :, 0, :, None]) * S + jnp.einsum(
            'bhsd,bhse->bhde', ki * jnp.exp(b_last - b), vi)
        return S_new, o

    S0 = jnp.zeros((B, H, dk, dv), jnp.float32)
    _, o = lax.scan(step, S0, (qc, kc, vc, gc))
    return o.transpose(1, 2, 0, 3, 4).reshape(B, H, T, dv)


def fox_attention(q, k, v, logf):
    B, H, T, hd = q.shape
    F = jnp.cumsum(logf, axis=-1)
    nb = T // Q_BLOCK
    qb = q.reshape(B, H, nb, Q_BLOCK, hd).transpose(2, 0, 1, 3, 4)
    Fb = F.reshape(B, H, nb, Q_BLOCK).transpose(2, 0, 1, 3)
    kpos = jnp.arange(T)
    scale = hd ** -0.5

    def block(args):
        qi, Fi, i = args
        s = jnp.einsum('bhqd,bhkd->bhqk', qi, k).astype(jnp.float32) * scale
        s = s + Fi[..., None] - F[:, :, None, :]
        qpos = i * Q_BLOCK + jnp.arange(Q_BLOCK)
        s = jnp.where(kpos[None, :] <= qpos[:, None], s, -jnp.inf)
        p = jax.nn.softmax(s, axis=-1)
        return jnp.einsum('bhqk,bhkd->bhqd', p.astype(v.dtype), v)

    o = lax.map(block, (qb, Fb, jnp.arange(nb)))
    return o.transpose(1, 2, 0, 3, 4).reshape(B, H, T, hd)


def token_mixer(h, w_in, w_a2, b_a, b_f, g_gla, w_pa, w_pb, w_out):
    B, T, _ = h.shape
    f32 = jnp.float32
    z = h @ w_in
    cuts = np.cumsum(SPLITS)[:-1].tolist()
    q_a, k_a, v_a, a_low, r_a, q_b, k_b, v_b, f_b, gate_a, gate_b = jnp.split(z, cuts, axis=-1)

    def heads(t, n):
        return t.reshape(B, T, n, -1).transpose(0, 2, 1, 3)

    log_a = jax.nn.log_sigmoid((a_low @ w_a2 + b_a).astype(f32)) / GLA_TAU
    o_a = gla_chunked(heads(q_a.astype(f32) * (GLA_HK ** -0.5), GLA_HEADS),
                      heads(k_a.astype(f32), GLA_HEADS),
                      heads(v_a.astype(f32), GLA_HEADS),
                      heads(log_a, GLA_HEADS))
    o_a = rmsnorm(o_a.transpose(0, 2, 1, 3), g_gla.reshape(GLA_HEADS, GLA_HV))
    o_a = o_a.astype(h.dtype).reshape(B, T, GLA_DV) * jax.nn.silu(r_a)

    logf = jax.nn.log_sigmoid((f_b + b_f).astype(f32)).transpose(0, 2, 1)
    o_b = fox_attention(heads(q_b, FOX_HEADS), heads(k_b, FOX_HEADS), heads(v_b, FOX_HEADS), logf)
    o_b = o_b.transpose(0, 2, 1, 3).reshape(B, T, FOX_W)

    merged = jax.nn.sigmoid(gate_a) * (o_a @ w_pa) + jax.nn.sigmoid(gate_b) * (o_b @ w_pb)
    return merged @ w_out


def setup_inputs(seed: int = 0) -> dict:
    key = jax.random.key(seed)
    ks = jax.random.split(key, 20)
    L, D = DEPTH, D_MODEL
    nrm = jax.random.normal

    def w(k, shape, fan_in):
        return nrm(k, shape, jnp.float32) * fan_in ** -0.5

    return {
        "x": nrm(ks[0], (BATCH, SEQ, D), jnp.float32),
        "c": nrm(ks[1], (BATCH, D), jnp.float32),
        "w_ada": w(ks[2], (L, D, N_MOD * D), D) * 0.5,
        "b_ada": 0.02 * nrm(ks[3], (L, N_MOD * D), jnp.float32),
        "g_pre": 1.0 + 0.05 * nrm(ks[4], (L, 3, D), jnp.float32),
        "g_post": 1.0 + 0.05 * nrm(ks[5], (L, 3, D), jnp.float32),
        "w_gu1": w(ks[6], (L, D, 2 * D_FF), D),
        "w_dn1": w(ks[7], (L, D_FF, D), D_FF),
        "w_gu2": w(ks[8], (L, D, 2 * D_FF), D),
        "w_dn2": w(ks[9], (L, D_FF, D), D_FF),
        "w_in": w(ks[10], (L, D, IN_COLS), D),
        "w_a2": w(ks[11], (L, GLA_RANK, GLA_DK), GLA_RANK),
        "b_a": 0.1 * nrm(ks[12], (L, GLA_DK), jnp.float32),
        "b_f": 1.0 + 0.1 * nrm(ks[13], (L, FOX_HEADS), jnp.float32),
        "g_gla": 1.0 + 0.05 * nrm(ks[14], (L, GLA_DV), jnp.float32),
        "w_pa": w(ks[15], (L, GLA_DV, D), GLA_DV),
        "w_pb": w(ks[16], (L, FOX_W, D), FOX_W),
        "w_out": w(ks[17], (L, D, D), D),
    }


def reference(x, c, w_ada, b_ada, g_pre, g_post, w_gu1, w_dn1, w_gu2, w_dn2,
              w_in, w_a2, b_a, b_f, g_gla, w_pa, w_pb, w_out):
    B = x.shape[0]
    for l in range(DEPTH):
        mods = (jax.nn.silu(c) @ w_ada[l] + b_ada[l]).reshape(B, N_MOD, 1, D_MODEL)
        sh1, sc1, gt1, sh2, sc2, gt2, sh3, sc3, gt3 = [mods[:, i] for i in range(N_MOD)]

        h = rmsnorm(x, g_pre[l, 0]) * (1 + sc1) + sh1
        x = x + 0.5 * gt1 * rmsnorm(swiglu(h, w_gu1[l], w_dn1[l]), g_post[l, 0])

        h = rmsnorm(x, g_pre[l, 1]) * (1 + sc2) + sh2
        y = token_mixer(h, w_in[l], w_a2[l], b_a[l], b_f[l], g_gla[l], w_pa[l], w_pb[l], w_out[l])
        x = x + gt2 * rmsnorm(y, g_post[l, 1])

        h = rmsnorm(x, g_pre[l, 2]) * (1 + sc3) + sh3
        x = x + 0.5 * gt3 * rmsnorm(swiglu(h, w_gu2[l], w_dn2[l]), g_post[l, 2])
    return x
```

```cpp
#include <hip/hip_runtime.h>
#include <hip/hip_cooperative_groups.h>
#include <cstdio>
#include <cstdint>
namespace cg = cooperative_groups;

#define DEVI __device__ __forceinline__
typedef unsigned short bf16_t;
typedef float f32x4 __attribute__((ext_vector_type(4)));
typedef unsigned u32x4 __attribute__((ext_vector_type(4)));
typedef unsigned u32x2 __attribute__((ext_vector_type(2)));

constexpr int BATCH = 2, T = 8192, D = 1024, M = BATCH * T, DFF = 2816, NMODS = 9 * D, INC = 8224;
constexpr float EPS = 1e-6f, LOG2E = 1.4426950408889634f;
constexpr float C2 = 0.125f * LOG2E;
constexpr float QA_SCALE = 0.08838834764831845f;

constexpr size_t MiB = 1u << 20;
constexpr size_t WS_CTL = 0;
constexpr size_t WS_WIN1 = 1 * MiB;
constexpr size_t WS_WIN2 = 11 * MiB;
constexpr size_t WS_WPA = 17 * MiB, WS_WPB = 19 * MiB, WS_WOUT = 21 * MiB;
constexpr size_t WS_MODS = 23 * MiB;
constexpr size_t WS_MODP = 23 * MiB + 128 * 1024;
constexpr size_t WS_DEC = 23 * MiB + 768 * 1024;
constexpr size_t WS_ALOW = 24 * MiB;
constexpr size_t WS_LOGF = 25 * MiB;
constexpr size_t WS_FCUM = 26 * MiB;
constexpr size_t WS_XN = 27 * MiB;
constexpr size_t WS_QA = 59 * MiB, WS_KA = 75 * MiB, WS_VA = 91 * MiB, WS_QB = 123 * MiB, WS_KB = 155 * MiB, WS_VB = 187 * MiB;
constexpr size_t WS_RA = 59 * MiB, WS_GA = 155 * MiB, WS_GB = 187 * MiB;
constexpr size_t WS_H = 59 * MiB;
constexpr size_t WS_Y = 147 * MiB;
constexpr size_t WS_Y2 = 59 * MiB;
constexpr size_t WS_WGU = 219 * MiB;
constexpr size_t WS_WDN = 230 * MiB;
constexpr size_t WS_U = 219 * MiB;
constexpr int LDS_BYTES = 147456;

struct Params { const float* in[18]; float* out; unsigned char* ws; };
enum { I_X = 0, I_C, I_WADA, I_BADA, I_GPRE, I_GPOST, I_WGU1, I_WDN1, I_WGU2, I_WDN2, I_WIN, I_WA2, I_BA, I_BF, I_GGLA, I_WPA, I_WPB, I_WOUT };

DEVI float bf2f(bf16_t v) { return __uint_as_float((unsigned)v << 16); }
DEVI unsigned f2bf(float f) { unsigned u = __float_as_uint(f); return (u + 0x7fffu + ((u >> 16) & 1u)) >> 16; }
DEVI unsigned pk2(float lo, float hi) { return f2bf(lo) | (f2bf(hi) << 16); }
DEVI float wave_sum(float v) {
#pragma unroll
    for (int o = 1; o < 64; o <<= 1) v += __shfl_xor(v, o);
    return v;
}
DEVI float sigmoid_f(float x) { return 1.f / (1.f + __expf(-x)); }
DEVI float silu_f(float x) { return x / (1.f + __expf(-x)); }
DEVI float logsigmoid_f(float x) { return fminf(x, 0.f) - log1pf(__expf(-fabsf(x))); }
DEVI void unpack8(const u32x4 v, float* f) {
    f[0] = __uint_as_float(v.x << 16); f[1] = __uint_as_float(v.x & 0xffff0000u);
    f[2] = __uint_as_float(v.y << 16); f[3] = __uint_as_float(v.y & 0xffff0000u);
    f[4] = __uint_as_float(v.z << 16); f[5] = __uint_as_float(v.z & 0xffff0000u);
    f[6] = __uint_as_float(v.w << 16); f[7] = __uint_as_float(v.w & 0xffff0000u);
}

DEVI void transpose_item(const float* W, int K, int N, int k0, int srcn0, bf16_t* WT, int dstrow0, float* scr, int lane) {
#pragma unroll 8
    for (int i = 0; i < 32; ++i) { const int kk = 2 * i + (lane >> 5); scr[kk * 33 + (lane & 31)] = W[(size_t)(k0 + kk) * N + srcn0 + (lane & 31)]; }
    __builtin_amdgcn_s_waitcnt(0); __builtin_amdgcn_wave_barrier();
    const int c = lane & 7;
#pragma unroll
    for (int j = 0; j < 4; ++j) { const int n = (lane >> 3) + 8 * j; const float* s = scr + (8 * c) * 33 + n;
        u32x4 o; o.x = pk2(s[0 * 33], s[1 * 33]); o.y = pk2(s[2 * 33], s[3 * 33]); o.z = pk2(s[4 * 33], s[5 * 33]); o.w = pk2(s[6 * 33], s[7 * 33]);
        *(u32x4*)(WT + (size_t)(dstrow0 + n) * K + k0 + 8 * c) = o; }
    __builtin_amdgcn_s_waitcnt(0); __builtin_amdgcn_wave_barrier();
}
DEVI int src_win1(int r) { return r < 2048 ? r : r + 1040; }
DEVI int src_win2(int r) { return r < 1024 ? r + 2064 : r + 5152; }
DEVI int src_gu(int r) { const int t = r >> 8, w = r & 255; return w < 128 ? 128 * t + w : DFF + 128 * t + (w - 128); }

DEVI void convert_ffn_weights(const Params& p, unsigned char* lds, const float* wgu, const float* wdn) {
    const int lane = threadIdx.x & 63, wave = threadIdx.x >> 6;
    float* scr = (float*)(lds + wave * 16384);
    const int gw = blockIdx.x * 8 + wave, NGW = gridDim.x * 8;
    bf16_t* WGU = (bf16_t*)(p.ws + WS_WGU); bf16_t* WDN = (bf16_t*)(p.ws + WS_WDN);
    constexpr int I_GU = 16 * 176, I_DN = 44 * 32;
    for (int it = gw; it < I_GU + I_DN; it += NGW) {
        if (it < I_GU) { const int kb = it / 176, nb = it % 176; transpose_item(wgu, D, 2 * DFF, 64 * kb, src_gu(32 * nb), WGU, 32 * nb, scr, lane); }
        else { const int r = it - I_GU, kb = r / 32, nb = r % 32; transpose_item(wdn, DFF, D, 64 * kb, 32 * nb, WDN, 32 * nb, scr, lane); }
    }
}

DEVI void ph_prologue(const Params& p, unsigned char* lds) {
    const int tid = threadIdx.x, lane = tid & 63, wave = tid >> 6;
    float* sc = (float*)lds;
    for (int v = tid; v < 2 * D; v += 512) sc[v] = silu_f(p.in[I_C][v]);
    __syncthreads();
    {
        const int g = blockIdx.x * 512 + tid;
        if (g < 8 * NMODS) {
            const int ks = g / NMODS, j = g % NMODS; const float* w = p.in[I_WADA] + (size_t)(ks * 128) * NMODS + j;
            float s0 = 0.f, s1 = 0.f;
#pragma unroll 8
            for (int i = 0; i < 128; ++i) { const float wv = w[(size_t)i * NMODS]; s0 += sc[ks * 128 + i] * wv; s1 += sc[D + ks * 128 + i] * wv; }
            float* mp = (float*)(p.ws + WS_MODP);
            mp[(ks * 2 + 0) * NMODS + j] = s0; mp[(ks * 2 + 1) * NMODS + j] = s1;
        }
    }
    __syncthreads();
    float* scr = (float*)(lds + wave * 16384);
    const int gw = blockIdx.x * 8 + wave, NGW = gridDim.x * 8;
    constexpr int I_W1 = 16 * 160, I_W2 = 16 * 96, I_P = 16 * 32;
    const float* win = p.in[I_WIN];
    for (int it = gw; it < I_W1 + I_W2 + 3 * I_P; it += NGW) {
        int r = it;
        if (r < I_W1) { const int kb = r / 160, nb = r % 160; transpose_item(win, D, INC, 64 * kb, src_win1(32 * nb), (bf16_t*)(p.ws + WS_WIN1), 32 * nb, scr, lane); continue; } r -= I_W1;
        if (r < I_W2) { const int kb = r / 96, nb = r % 96; transpose_item(win, D, INC, 64 * kb, src_win2(32 * nb), (bf16_t*)(p.ws + WS_WIN2), 32 * nb, scr, lane); continue; } r -= I_W2;
        const int w = r / I_P, q = r % I_P, kb = q / 32, nb = q % 32;
        const float* src = p.in[w == 0 ? I_WPA : (w == 1 ? I_WPB : I_WOUT)]; bf16_t* dst = (bf16_t*)(p.ws + (w == 0 ? WS_WPA : (w == 1 ? WS_WPB : WS_WOUT)));
        transpose_item(src, D, D, 64 * kb, 32 * nb, dst, 32 * nb, scr, lane);
    }
    convert_ffn_weights(p, lds, p.in[I_WGU1], p.in[I_WDN1]);
}

DEVI void ph_mods_xn1(const Params& p, unsigned char* lds) {
    const int tid = threadIdx.x, lane = tid & 63, wave = tid >> 6;
    const float* mp = (const float*)(p.ws + WS_MODP); float* mods = (float*)(p.ws + WS_MODS); const float* bada = p.in[I_BADA];
    for (int v = blockIdx.x * 512 + tid; v < 2 * NMODS; v += gridDim.x * 512) { const int b = v / NMODS, j = v % NMODS; float s = bada[j];
#pragma unroll
        for (int ks = 0; ks < 8; ++ks) s += mp[(ks * 2 + b) * NMODS + j];
        mods[v] = s; }
    float* lm = (float*)lds;
    for (int v = tid; v < 4096; v += 512) { const int b = v >> 11, j = v & 2047; float s = bada[j];
#pragma unroll
        for (int ks = 0; ks < 8; ++ks) s += mp[(ks * 2 + b) * NMODS + j];
        lm[v] = s; }
    __syncthreads();
    const int gw = blockIdx.x * 8 + wave, NGW = gridDim.x * 8;
    const float* gpre = p.in[I_GPRE]; bf16_t* XN = (bf16_t*)(p.ws + WS_XN);
    for (int m = gw; m < M; m += NGW) {
        const int b = m >> 13; const f32x4* xr = (const f32x4*)(p.in[I_X] + (size_t)m * D) + lane;
        f32x4 v[4]; float ss = 0.f;
#pragma unroll
        for (int j = 0; j < 4; ++j) { v[j] = xr[64 * j]; ss += (v[j].x * v[j].x + v[j].y * v[j].y) + (v[j].z * v[j].z + v[j].w * v[j].w); }
        const float rstd = rsqrtf(wave_sum(ss) * (1.f / D) + EPS);
        u32x2* o8 = (u32x2*)(XN + (size_t)m * D) + lane;
#pragma unroll
        for (int j = 0; j < 4; ++j) { const int col = 4 * lane + 256 * j; const f32x4 g = *(const f32x4*)(gpre + col);
            const f32x4 sh = *(const f32x4*)(lm + b * 2048 + col), s1 = *(const f32x4*)(lm + b * 2048 + 1024 + col);
            const f32x4 h = v[j] * rstd * g * (1.f + s1) + sh; u32x2 w; w.x = pk2(h.x, h.y); w.y = pk2(h.z, h.w); o8[64 * j] = w; }
    }
}

DEVI void ph_norm_res(const Params& p, const float* Y, const float* xin, float* xout, bool mk_xn, int sub  , float gs) {
    const int tid = threadIdx.x, lane = tid & 63, wave = tid >> 6;
    const int gw = blockIdx.x * 8 + wave, NGW = gridDim.x * 8;
    const float* mods = (const float*)(p.ws + WS_MODS); const float* gpost = p.in[I_GPOST] + sub * D; const float* gpre = p.in[I_GPRE] + (sub + 1) * D;
    bf16_t* XN = (bf16_t*)(p.ws + WS_XN);
    for (int m = gw; m < M; m += NGW) {
        const int b = m >> 13; const float* mb = mods + b * NMODS;
        const f32x4* yr = (const f32x4*)(Y + (size_t)m * D) + lane; const f32x4* xr = (const f32x4*)(xin + (size_t)m * D) + lane; f32x4* xo = (f32x4*)(xout + (size_t)m * D) + lane;
        f32x4 y[4]; float ss = 0.f;
#pragma unroll
        for (int j = 0; j < 4; ++j) { y[j] = yr[64 * j]; ss += (y[j].x * y[j].x + y[j].y * y[j].y) + (y[j].z * y[j].z + y[j].w * y[j].w); }
        const float rstd = rsqrtf(wave_sum(ss) * (1.f / D) + EPS); float s2 = 0.f;
#pragma unroll
        for (int j = 0; j < 4; ++j) { const int col = 4 * lane + 256 * j; const f32x4 g = *(const f32x4*)(gpost + col), gt = *(const f32x4*)(mb + (3 * sub + 2) * D + col);
            const f32x4 xn = xr[64 * j] + gs * gt * (y[j] * rstd * g); xo[64 * j] = xn; y[j] = xn; s2 += (xn.x * xn.x + xn.y * xn.y) + (xn.z * xn.z + xn.w * xn.w); }
        if (mk_xn) {
            const float r2 = rsqrtf(wave_sum(s2) * (1.f / D) + EPS); u32x2* o8 = (u32x2*)(XN + (size_t)m * D) + lane;
#pragma unroll
            for (int j = 0; j < 4; ++j) { const int col = 4 * lane + 256 * j; const f32x4 g = *(const f32x4*)(gpre + col);
                const f32x4 sh = *(const f32x4*)(mb + (3 * sub + 3) * D + col), s1 = *(const f32x4*)(mb + (3 * sub + 4) * D + col);
                const f32x4 h = y[j] * r2 * g * (1.f + s1) + sh; u32x2 w; w.x = pk2(h.x, h.y); w.y = pk2(h.z, h.w); o8[64 * j] = w; }
        }
    }
}

template <bool DUAL, class Epi>
DEVI void gemm_simple(unsigned char* lds, const bf16_t* A, const bf16_t* Bt, int Mrows, int Nlog, int K, const Epi& E) {
    float* As = (float*)lds; float* Bs = As + 32 * 132;
    const int tid = threadIdx.x, ty = tid >> 4, tx = tid & 15;
    const int LC = DUAL ? 64 : 128, ntn = Nlog / LC, ntiles = (Mrows / 128) * ntn;
    for (int tile = blockIdx.x; tile < ntiles; tile += gridDim.x) {
        const int tm = tile / ntn, tn = tile % ntn;
        float acc[4][8];
#pragma unroll
        for (int i = 0; i < 4; ++i)
#pragma unroll
            for (int j = 0; j < 8; ++j) acc[i][j] = 0.f;
        const int lr = tid >> 2, kc = (tid & 3) * 8;
        const int brow = DUAL ? ((tn >> 1) * 256 + (lr >= 64 ? 128 : 0) + (tn & 1) * 64 + (lr & 63)) : tn * 128 + lr;
        const bf16_t* ap = A + (size_t)(tm * 128 + lr) * K + kc; const bf16_t* bp = Bt + (size_t)brow * K + kc;
        for (int k0 = 0; k0 < K; k0 += 32) {
            float fa[8], fb[8]; unpack8(*(const u32x4*)(ap + k0), fa); unpack8(*(const u32x4*)(bp + k0), fb);
            __syncthreads();
#pragma unroll
            for (int i = 0; i < 8; ++i) { As[(kc + i) * 132 + lr] = fa[i]; Bs[(kc + i) * 132 + lr] = fb[i]; }
            __syncthreads();
#pragma unroll 8
            for (int kk = 0; kk < 32; ++kk) {
                const f32x4 a = *(const f32x4*)(As + kk * 132 + 4 * ty), b0 = *(const f32x4*)(Bs + kk * 132 + 4 * tx), b1 = *(const f32x4*)(Bs + kk * 132 + 64 + 4 * tx);
#pragma unroll
                for (int i = 0; i < 4; ++i) { acc[i][0] += a[i] * b0[0]; acc[i][1] += a[i] * b0[1]; acc[i][2] += a[i] * b0[2]; acc[i][3] += a[i] * b0[3];
                    acc[i][4] += a[i] * b1[0]; acc[i][5] += a[i] * b1[1]; acc[i][6] += a[i] * b1[2]; acc[i][7] += a[i] * b1[3]; }
            }
        }
#pragma unroll
        for (int i = 0; i < 4; ++i) { const int row = tm * 128 + 4 * ty + i;
            const f32x4 v0 = {acc[i][0], acc[i][1], acc[i][2], acc[i][3]}, v1 = {acc[i][4], acc[i][5], acc[i][6], acc[i][7]};
            if (DUAL) E(row, tn * 64 + 4 * tx, v0, v1);
            else { E(row, tn * 128 + 4 * tx, v0, v0); E(row, tn * 128 + 64 + 4 * tx, v1, v1); } }
    }
}

DEVI void st_bf4(bf16_t* p, f32x4 v) { u32x2 w; w.x = pk2(v.x, v.y); w.y = pk2(v.z, v.w); *(u32x2*)p = w; }
DEVI f32x4 ld_bf4(const bf16_t* p) { const u32x2 w = *(const u32x2*)p; return (f32x4){__uint_as_float(w.x << 16), __uint_as_float(w.x & 0xffff0000u), __uint_as_float(w.y << 16), __uint_as_float(w.y & 0xffff0000u)}; }
struct EpSwiglu { bf16_t* H; DEVI void operator()(int row, int col, f32x4 g, f32x4 u) const {
    f32x4 o; o.x = silu_f(g.x) * u.x; o.y = silu_f(g.y) * u.y; o.z = silu_f(g.z) * u.z; o.w = silu_f(g.w) * u.w; st_bf4(H + (size_t)row * DFF + col, o); } };
struct EpF32 { float* Y; DEVI void operator()(int row, int col, f32x4 v, f32x4) const { *(f32x4*)(Y + (size_t)row * D + col) = v; } };
struct EpWin1 { unsigned char* ws; DEVI void operator()(int row, int col, f32x4 v, f32x4) const {
    if (col < 512) st_bf4((bf16_t*)(ws + WS_QA) + (size_t)row * 512 + col, v * QA_SCALE);
    else if (col < 1024) st_bf4((bf16_t*)(ws + WS_KA) + (size_t)row * 512 + (col - 512), v);
    else if (col < 2048) st_bf4((bf16_t*)(ws + WS_VA) + (size_t)row * D + (col - 1024), v);
    else if (col < 3072) st_bf4((bf16_t*)(ws + WS_QB) + (size_t)row * D + (col - 2048), v * C2);
    else if (col < 4096) st_bf4((bf16_t*)(ws + WS_KB) + (size_t)row * D + (col - 3072), v);
    else st_bf4((bf16_t*)(ws + WS_VB) + (size_t)row * D + (col - 4096), v); } };
struct EpWin2 { unsigned char* ws; DEVI void operator()(int row, int col, f32x4 v, f32x4) const {
    if (col < 1024) { f32x4 o = {silu_f(v.x), silu_f(v.y), silu_f(v.z), silu_f(v.w)}; st_bf4((bf16_t*)(ws + WS_RA) + (size_t)row * D + col, o); }
    else { f32x4 o = {sigmoid_f(v.x), sigmoid_f(v.y), sigmoid_f(v.z), sigmoid_f(v.w)}; st_bf4((bf16_t*)(ws + (col < 2048 ? WS_GA : WS_GB)) + (size_t)row * D + (col & 1023), o); } } };
struct EpPa { bf16_t* GA; DEVI void operator()(int row, int col, f32x4 v, f32x4) const { bf16_t* q = GA + (size_t)row * D + col; st_bf4(q, ld_bf4(q) * v); } };
struct EpPb { const bf16_t* Tm; bf16_t* GB; DEVI void operator()(int row, int col, f32x4 v, f32x4) const { bf16_t* q = GB + (size_t)row * D + col; st_bf4(q, ld_bf4(Tm + (size_t)row * D + col) + ld_bf4(q) * v); } };

DEVI void ph_thin_cols(const Params& p) {
    const bf16_t* XN = (const bf16_t*)(p.ws + WS_XN); const float* win = p.in[I_WIN]; const float* bf = p.in[I_BF];
    float* alow = (float*)(p.ws + WS_ALOW); float* logf = (float*)(p.ws + WS_LOGF);
    for (int v = blockIdx.x * 512 + threadIdx.x; v < M * 32; v += gridDim.x * 512) {
        const int m = v >> 5, j = v & 31, col = j < 16 ? 2048 + j : 6160 + (j - 16);
        const bf16_t* xr = XN + (size_t)m * D; const float* w = win + col; float s = 0.f;
        for (int k = 0; k < D; k += 8) { float f[8]; unpack8(*(const u32x4*)(xr + k), f);
#pragma unroll
            for (int i = 0; i < 8; ++i) s += f[i] * w[(size_t)(k + i) * INC]; }
        if (j < 16) alow[m * 16 + j] = s; else logf[m * 16 + (j - 16)] = logsigmoid_f(s + bf[j - 16]);
    }
}
DEVI void ph_fcum(const Params& p) {
    const int lane = threadIdx.x & 63, gw = blockIdx.x * 8 + (threadIdx.x >> 6);
    if (gw >= 32) return;
    const int b = gw >> 4, hh = gw & 15; const float* lf = (const float*)(p.ws + WS_LOGF) + (size_t)(b * T) * 16 + hh; float* fc = (float*)(p.ws + WS_FCUM) + (size_t)gw * T;
    double s = 0.0;
    for (int i = 0; i < 128; ++i) s += (double)lf[(size_t)(lane * 128 + i) * 16];
    double incl = s;
#pragma unroll
    for (int o = 1; o < 64; o <<= 1) { const double t = __shfl_up(incl, o); if (lane >= o) incl += t; }
    double run = incl - s;
    for (int i = 0; i < 128; ++i) { run += (double)lf[(size_t)(lane * 128 + i) * 16]; fc[lane * 128 + i] = (float)run; }
}

template <bool OUT>
DEVI void gla_rec(const Params& p, unsigned char* lds, int unit) {
    const int j = unit & 31, bh = unit >> 5, h = bh & 3, b = bh >> 2;
    const int tid = threadIdx.x, e = tid & 255, dh = tid >> 8, d0 = dh * 64;
    float* qs = (float*)lds; float* ks = qs + 2048; float* al = ks + 2048; float* vs = al + 2048; float* red = vs + 4096; float* lsum = red + 8192;
    float* U = (float*)(p.ws + WS_U) + (size_t)unit * 32768;
    const bf16_t* QA = (const bf16_t*)(p.ws + WS_QA); const bf16_t* KA = (const bf16_t*)(p.ws + WS_KA); bf16_t* VA = (bf16_t*)(p.ws + WS_VA);
    const float* alow = (const float*)(p.ws + WS_ALOW);
    float S[64];
#pragma unroll
    for (int i = 0; i < 64; ++i) S[i] = OUT ? U[(d0 + i) * 256 + e] : 0.f;
    const int dd = tid & 127, tq = tid >> 7;
    float wa[16];
#pragma unroll
    for (int r = 0; r < 16; ++r) wa[r] = p.in[I_WA2][r * 512 + h * 128 + dd];
    const float ba = p.in[I_BA][h * 128 + dd];
    float lacc = 0.f;
    for (int sb = 0; sb < 16; ++sb) {
        const int t0 = b * T + j * 256 + sb * 16;
#pragma unroll
        for (int r = 0; r < 4; ++r) { const int tt = tq + 4 * r; const size_t row = (size_t)(t0 + tt);
            const f32x4* ar = (const f32x4*)(alow + row * 16); float s = ba;
#pragma unroll
            for (int q4 = 0; q4 < 4; ++q4) { const f32x4 a = ar[q4]; s += a.x * wa[4 * q4] + a.y * wa[4 * q4 + 1] + a.z * wa[4 * q4 + 2] + a.w * wa[4 * q4 + 3]; }
            const float la = logsigmoid_f(s) * (1.f / 16.f); lacc += la; al[tt * 128 + dd] = __expf(la);
            qs[tt * 128 + dd] = bf2f(QA[row * 512 + h * 128 + dd]); ks[tt * 128 + dd] = bf2f(KA[row * 512 + h * 128 + dd]); }
#pragma unroll
        for (int r = 0; r < 8; ++r) { const int idx = tid + 512 * r, tt = idx >> 8, ee = idx & 255; vs[idx] = bf2f(VA[(size_t)(t0 + tt) * D + h * 256 + ee]); }
        __syncthreads();
        for (int tt = 0; tt < 16; ++tt) {
            const float v = vs[tt * 256 + e]; float acc = 0.f;
            const float* alp = al + tt * 128 + d0; const float* kp = ks + tt * 128 + d0; const float* qp = qs + tt * 128 + d0;
#pragma unroll
            for (int i = 0; i < 64; ++i) { S[i] = alp[i] * S[i] + kp[i] * v; if (OUT) acc += qp[i] * S[i]; }
            if (OUT) red[(tt * 2 + dh) * 256 + e] = acc;
        }
        __syncthreads();
        if (OUT) {
#pragma unroll
            for (int r = 0; r < 8; ++r) { const int idx = tid + 512 * r, tt = idx >> 8, ee = idx & 255;
                VA[(size_t)(t0 + tt) * D + h * 256 + ee] = (bf16_t)f2bf(red[(tt * 2) * 256 + ee] + red[(tt * 2 + 1) * 256 + ee]); }
        }
    }
    if (!OUT) {
#pragma unroll
        for (int i = 0; i < 64; ++i) U[(d0 + i) * 256 + e] = S[i];
        lsum[tq * 128 + dd] = lacc; __syncthreads();
        if (tid < 128) ((float*)(p.ws + WS_DEC))[unit * 128 + tid] = __expf(lsum[tid] + lsum[128 + tid] + lsum[256 + tid] + lsum[384 + tid]);
    }
    __syncthreads();
}
DEVI void ph_gla_scan(const Params& p) {
    float* U = (float*)(p.ws + WS_U); const float* dec = (const float*)(p.ws + WS_DEC);
    for (int v = blockIdx.x * 512 + threadIdx.x; v < 8 * 32768; v += gridDim.x * 512) {
        const int bh = v >> 15, de = v & 32767, d = de >> 8; float s = 0.f;
        for (int j = 0; j < 32; ++j) { const int unit = bh * 32 + j; float* q = U + (size_t)unit * 32768 + de; const float u = *q; *q = s; s = dec[unit * 128 + d] * s + u; }
    }
}
DEVI void ph_oa_norm(const Params& p) {
    const int lane = threadIdx.x & 63, gw = blockIdx.x * 8 + (threadIdx.x >> 6), NGW = gridDim.x * 8;
    bf16_t* OA = (bf16_t*)(p.ws + WS_VA); const bf16_t* RA = (const bf16_t*)(p.ws + WS_RA); const float* gg = p.in[I_GGLA];
    for (int m = gw; m < M; m += NGW) {
        bf16_t* op = OA + (size_t)m * D + 16 * lane; const bf16_t* rp = RA + (size_t)m * D + 16 * lane;
        float o[16], r[16]; unpack8(*(const u32x4*)op, o); unpack8(*(const u32x4*)(op + 8), o + 8); unpack8(*(const u32x4*)rp, r); unpack8(*(const u32x4*)(rp + 8), r + 8);
        float ss = 0.f;
#pragma unroll
        for (int i = 0; i < 16; ++i) ss += o[i] * o[i];
        ss += __shfl_xor(ss, 1); ss += __shfl_xor(ss, 2); ss += __shfl_xor(ss, 4); ss += __shfl_xor(ss, 8);
        const float rstd = rsqrtf(ss * (1.f / 256.f) + EPS);
        u32x4 w0, w1; float t[16];
#pragma unroll
        for (int i = 0; i < 16; ++i) t[i] = o[i] * rstd * gg[16 * lane + i] * r[i];
        w0.x = pk2(t[0], t[1]); w0.y = pk2(t[2], t[3]); w0.z = pk2(t[4], t[5]); w0.w = pk2(t[6], t[7]);
        w1.x = pk2(t[8], t[9]); w1.y = pk2(t[10], t[11]); w1.z = pk2(t[12], t[13]); w1.w = pk2(t[14], t[15]);
        *(u32x4*)op = w0; *(u32x4*)(op + 8) = w1;
    }
}

DEVI void attn_simple_unit(const Params& p, unsigned char* lds, int unit) {
    const int qb = 15 - (unit >> 5), bh = unit & 31, b = bh >> 4, hh = bh & 15;
    float* Ks = (float*)lds; float* Vs = Ks + 4096; float* bs = Vs + 4096;
    const int tid = threadIdx.x, t = qb * 512 + tid; const size_t row = (size_t)(b * T + t);
    bf16_t* QB = (bf16_t*)(p.ws + WS_QB); const bf16_t* KB = (const bf16_t*)(p.ws + WS_KB); const bf16_t* VB = (const bf16_t*)(p.ws + WS_VB);
    const float* fc = (const float*)(p.ws + WS_FCUM) + (size_t)bh * T;
    float q[64], o[64];
#pragma unroll
    for (int i = 0; i < 8; ++i) unpack8(*(const u32x4*)(QB + row * D + hh * 64 + 8 * i), q + 8 * i);
#pragma unroll
    for (int i = 0; i < 64; ++i) o[i] = 0.f;
    float mx = -1e30f, l = 0.f; const float Fq0 = fc[qb * 512];
    const int nkt = (qb * 512 + 512) / 64;
    for (int kt = 0; kt < nkt; ++kt) {
        __syncthreads();
        { const int key = tid >> 3, c = (tid & 7) * 8; const size_t g = (size_t)(b * T + kt * 64 + key) * D + hh * 64 + c;
          unpack8(*(const u32x4*)(KB + g), Ks + key * 64 + c); unpack8(*(const u32x4*)(VB + g), Vs + key * 64 + c); }
        if (tid < 64) bs[tid] = (Fq0 - fc[kt * 64 + tid]) * LOG2E;
        __syncthreads();
        const int smax = t - kt * 64;
        for (int s = 0; s < 64; ++s) {
            if (s <= smax) {
                float sc = bs[s]; const float* kr = Ks + s * 64;
#pragma unroll
                for (int i = 0; i < 64; ++i) sc += q[i] * kr[i];
                if (sc > mx + 8.f) { const float f = exp2f(mx - sc); l *= f;
#pragma unroll
                    for (int i = 0; i < 64; ++i) o[i] *= f;
                    mx = sc; }
                const float pr = exp2f(sc - mx); l += pr; const float* vr = Vs + s * 64;
#pragma unroll
                for (int i = 0; i < 64; ++i) o[i] += pr * vr[i];
            }
        }
    }
    const float inv = 1.f / l;
#pragma unroll
    for (int i = 0; i < 8; ++i) { u32x4 w; w.x = pk2(o[8 * i] * inv, o[8 * i + 1] * inv); w.y = pk2(o[8 * i + 2] * inv, o[8 * i + 3] * inv); w.z = pk2(o[8 * i + 4] * inv, o[8 * i + 5] * inv); w.w = pk2(o[8 * i + 6] * inv, o[8 * i + 7] * inv);
        *(u32x4*)(QB + row * D + hh * 64 + 8 * i) = w; }
    __syncthreads();
}

__global__ void __launch_bounds__(512, 2) mega_fwd(Params p) {
    extern __shared__ __attribute__((aligned(16))) unsigned char lds[];
    cg::grid_group grid = cg::this_grid();
    unsigned char* ws = p.ws;
    bf16_t* XN = (bf16_t*)(ws + WS_XN); bf16_t* HB = (bf16_t*)(ws + WS_H);
    ph_prologue(p, lds); grid.sync();
    ph_mods_xn1(p, lds); grid.sync();
    { EpSwiglu E{HB}; gemm_simple<true>(lds, XN, (const bf16_t*)(ws + WS_WGU), M, DFF, D, E); } grid.sync();
    { EpF32 E{(float*)(ws + WS_Y)}; gemm_simple<false>(lds, HB, (const bf16_t*)(ws + WS_WDN), M, D, DFF, E); } grid.sync();
    ph_norm_res(p, (const float*)(ws + WS_Y), p.in[I_X], p.out, true, 0, 0.5f); grid.sync();
    { EpWin1 E{ws}; gemm_simple<false>(lds, XN, (const bf16_t*)(ws + WS_WIN1), M, 5120, D, E); }
    ph_thin_cols(p); grid.sync();
    ph_fcum(p);
    for (int u = blockIdx.x; u < 256; u += gridDim.x) gla_rec<false>(p, lds, u);
    grid.sync();
    ph_gla_scan(p); grid.sync();
    for (int u = blockIdx.x; u < 256; u += gridDim.x) gla_rec<true>(p, lds, u);
    for (int u = blockIdx.x; u < 512; u += gridDim.x) attn_simple_unit(p, lds, u);
    grid.sync();
    { EpWin2 E{ws}; gemm_simple<false>(lds, XN, (const bf16_t*)(ws + WS_WIN2), M, 3072, D, E); }
    __syncthreads();
    convert_ffn_weights(p, lds, p.in[I_WGU2], p.in[I_WDN2]); grid.sync();
    ph_oa_norm(p); grid.sync();
    { EpPa E{(bf16_t*)(ws + WS_GA)}; gemm_simple<false>(lds, (const bf16_t*)(ws + WS_VA), (const bf16_t*)(ws + WS_WPA), M, D, D, E); } grid.sync();
    { EpPb E{(const bf16_t*)(ws + WS_GA), (bf16_t*)(ws + WS_GB)}; gemm_simple<false>(lds, (const bf16_t*)(ws + WS_QB), (const bf16_t*)(ws + WS_WPB), M, D, D, E); } grid.sync();
    { EpF32 E{(float*)(ws + WS_Y2)}; gemm_simple<false>(lds, (const bf16_t*)(ws + WS_GB), (const bf16_t*)(ws + WS_WOUT), M, D, D, E); } grid.sync();
    ph_norm_res(p, (const float*)(ws + WS_Y2), p.out, p.out, true, 1, 1.0f); grid.sync();
    { EpSwiglu E{HB}; gemm_simple<true>(lds, XN, (const bf16_t*)(ws + WS_WGU), M, DFF, D, E); } grid.sync();
    { EpF32 E{(float*)(ws + WS_Y)}; gemm_simple<false>(lds, HB, (const bf16_t*)(ws + WS_WDN), M, D, DFF, E); } grid.sync();
    ph_norm_res(p, (const float*)(ws + WS_Y), p.out, p.out, false, 2, 0.5f);
}

extern "C" void kernel_launch(void* const* d_in, const int* in_sizes, int n_in, void* d_out, int out_size, void* d_ws, size_t ws_size, hipStream_t stream) {
    static int grid = 0;
    if (grid == 0) {
        int dev = 0, cus = 0, per_cu = 0;
        hipGetDevice(&dev); hipDeviceGetAttribute(&cus, hipDeviceAttributeMultiprocessorCount, dev);
        if (hipFuncSetAttribute((const void*)mega_fwd, hipFuncAttributeMaxDynamicSharedMemorySize, LDS_BYTES) != hipSuccess) { fprintf(stderr, "hipFuncSetAttribute failed\n"); }
        if (hipOccupancyMaxActiveBlocksPerMultiprocessor(&per_cu, (const void*)mega_fwd, 512, LDS_BYTES) != hipSuccess || per_cu < 1) { fprintf(stderr, "occupancy query: %d\n", per_cu); per_cu = 1; }
        (void)hipGetLastError();
        grid = cus * per_cu;
        if (n_in != 18 || ws_size < 256 * MiB) fprintf(stderr, "unexpected n_in %d / ws %zu\n", n_in, ws_size);
    }
    Params p{};
    for (int i = 0; i < 18; ++i) p.in[i] = (const float*)d_in[i];
    p.out = (float*)d_out; p.ws = (unsigned char*)d_ws;
    void* args[] = {&p};
    hipError_t e = hipLaunchCooperativeKernel((const void*)mega_fwd, dim3(grid), dim3(512), args, LDS_BYTES, stream);
    if (e != hipSuccess) fprintf(stderr, "cooperative launch failed: %s (grid %d)\n", hipGetErrorString(e), grid);
}
```

```cpp
#include <hip/hip_runtime.h>
#include <hip/hip_cooperative_groups.h>
#include <cstdio>
#include <cstdint>
namespace cg = cooperative_groups;

#define DEVI __device__ __forceinline__
typedef unsigned short bf16_t;
typedef float f32x4 __attribute__((ext_vector_type(4)));
typedef unsigned u32x4 __attribute__((ext_vector_type(4)));
typedef unsigned u32x2 __attribute__((ext_vector_type(2)));

constexpr int BATCH = 2, T = 8192, D = 1024, M = BATCH * T, DFF = 2816, NMODS = 9 * D, INC = 8224;
constexpr float EPS = 1e-6f, LOG2E = 1.4426950408889634f;
constexpr float C2 = 0.125f * LOG2E;
constexpr float QA_SCALE = 0.08838834764831845f;

constexpr size_t MiB = 1u << 20;
constexpr size_t WS_CTL = 0;
constexpr size_t WS_WIN1 = 1 * MiB;
constexpr size_t WS_WIN2 = 11 * MiB;
constexpr size_t WS_WPA = 17 * MiB, WS_WPB = 19 * MiB, WS_WOUT = 21 * MiB;
constexpr size_t WS_MODS = 23 * MiB;
constexpr size_t WS_MODP = 23 * MiB + 128 * 1024;
constexpr size_t WS_DEC = 23 * MiB + 768 * 1024;
constexpr size_t WS_ALOW = 24 * MiB;
constexpr size_t WS_LOGF = 25 * MiB;
constexpr size_t WS_FCUM = 26 * MiB;
constexpr size_t WS_XN = 27 * MiB;
constexpr size_t WS_QA = 59 * MiB, WS_KA = 75 * MiB, WS_VA = 91 * MiB, WS_QB = 123 * MiB, WS_KB = 155 * MiB, WS_VB = 187 * MiB;
constexpr size_t WS_RA = 59 * MiB, WS_GA = 155 * MiB, WS_GB = 187 * MiB;
constexpr size_t WS_H = 59 * MiB;
constexpr size_t WS_Y = 147 * MiB;
constexpr size_t WS_Y2 = 59 * MiB;
constexpr size_t WS_WGU = 219 * MiB;
constexpr size_t WS_WDN = 230 * MiB;
constexpr size_t WS_U = 219 * MiB;
constexpr int LDS_BYTES = 147456;

struct Params { const float* in[18]; float* out; unsigned char* ws; };
enum { I_X = 0, I_C, I_WADA, I_BADA, I_GPRE, I_GPOST, I_WGU1, I_WDN1, I_WGU2, I_WDN2, I_WIN, I_WA2, I_BA, I_BF, I_GGLA, I_WPA, I_WPB, I_WOUT };

DEVI float bf2f(bf16_t v) { return __uint_as_float((unsigned)v << 16); }
DEVI unsigned f2bf(float f) { unsigned u = __float_as_uint(f); return (u + 0x7fffu + ((u >> 16) & 1u)) >> 16; }
DEVI unsigned pk2(float lo, float hi) { return f2bf(lo) | (f2bf(hi) << 16); }
DEVI float wave_sum(float v) {
#pragma unroll
    for (int o = 1; o < 64; o <<= 1) v += __shfl_xor(v, o);
    return v;
}
DEVI float sigmoid_f(float x) { return 1.f / (1.f + __expf(-x)); }
DEVI float silu_f(float x) { return x / (1.f + __expf(-x)); }
DEVI float logsigmoid_f(float x) { return fminf(x, 0.f) - log1pf(__expf(-fabsf(x))); }
DEVI void unpack8(const u32x4 v, float* f) {
    f[0] = __uint_as_float(v.x << 16); f[1] = __uint_as_float(v.x & 0xffff0000u);
    f[2] = __uint_as_float(v.y << 16); f[3] = __uint_as_float(v.y & 0xffff0000u);
    f[4] = __uint_as_float(v.z << 16); f[5] = __uint_as_float(v.z & 0xffff0000u);
    f[6] = __uint_as_float(v.w << 16); f[7] = __uint_as_float(v.w & 0xffff0000u);
}

DEVI void transpose_item(const float* W, int K, int N, int k0, int srcn0, bf16_t* WT, int dstrow0, float* scr, int lane) {
#pragma unroll 8
    for (int i = 0; i < 32; ++i) { const int kk = 2 * i + (lane >> 5); scr[kk * 33 + (lane & 31)] = W[(size_t)(k0 + kk) * N + srcn0 + (lane & 31)]; }
    __builtin_amdgcn_s_waitcnt(0); __builtin_amdgcn_wave_barrier();
    const int c = lane & 7;
#pragma unroll
    for (int j = 0; j < 4; ++j) { const int n = (lane >> 3) + 8 * j; const float* s = scr + (8 * c) * 33 + n;
        u32x4 o; o.x = pk2(s[0 * 33], s[1 * 33]); o.y = pk2(s[2 * 33], s[3 * 33]); o.z = pk2(s[4 * 33], s[5 * 33]); o.w = pk2(s[6 * 33], s[7 * 33]);
        *(u32x4*)(WT + (size_t)(dstrow0 + n) * K + k0 + 8 * c) = o; }
    __builtin_amdgcn_s_waitcnt(0); __builtin_amdgcn_wave_barrier();
}
DEVI int src_win1(int r) { return r < 2048 ? r : r + 1040; }
DEVI int src_win2(int r) { return r < 1024 ? r + 2064 : r + 5152; }
DEVI int src_gu(int r) { const int t = r >> 8, w = r & 255; return w < 128 ? 128 * t + w : DFF + 128 * t + (w - 128); }

DEVI void convert_ffn_weights(const Params& p, unsigned char* lds, const float* wgu, const float* wdn) {
    const int lane = threadIdx.x & 63, wave = threadIdx.x >> 6;
    float* scr = (float*)(lds + wave * 16384);
    const int gw = blockIdx.x * 8 + wave, NGW = gridDim.x * 8;
    bf16_t* WGU = (bf16_t*)(p.ws + WS_WGU); bf16_t* WDN = (bf16_t*)(p.ws + WS_WDN);
    constexpr int I_GU = 16 * 176, I_DN = 44 * 32;
    for (int it = gw; it < I_GU + I_DN; it += NGW) {
        if (it < I_GU) { const int kb = it / 176, nb = it % 176; transpose_item(wgu, D, 2 * DFF, 64 * kb, src_gu(32 * nb), WGU, 32 * nb, scr, lane); }
        else { const int r = it - I_GU, kb = r / 32, nb = r % 32; transpose_item(wdn, DFF, D, 64 * kb, 32 * nb, WDN, 32 * nb, scr, lane); }
    }
}

DEVI void ph_prologue(const Params& p, unsigned char* lds) {
    const int tid = threadIdx.x, lane = tid & 63, wave = tid >> 6;
    float* sc = (float*)lds;
    for (int v = tid; v < 2 * D; v += 512) sc[v] = silu_f(p.in[I_C][v]);
    __syncthreads();
    {
        const int g = blockIdx.x * 512 + tid;
        if (g < 8 * NMODS) {
            const int ks = g / NMODS, j = g % NMODS; const float* w = p.in[I_WADA] + (size_t)(ks * 128) * NMODS + j;
            float s0 = 0.f, s1 = 0.f;
#pragma unroll 8
            for (int i = 0; i < 128; ++i) { const float wv = w[(size_t)i * NMODS]; s0 += sc[ks * 128 + i] * wv; s1 += sc[D + ks * 128 + i] * wv; }
            float* mp = (float*)(p.ws + WS_MODP);
            mp[(ks * 2 + 0) * NMODS + j] = s0; mp[(ks * 2 + 1) * NMODS + j] = s1;
        }
    }
    __syncthreads();
    float* scr = (float*)(lds + wave * 16384);
    const int gw = blockIdx.x * 8 + wave, NGW = gridDim.x * 8;
    constexpr int I_W1 = 16 * 160, I_W2 = 16 * 96, I_P = 16 * 32;
    const float* win = p.in[I_WIN];
    for (int it = gw; it < I_W1 + I_W2 + 3 * I_P; it += NGW) {
        int r = it;
        if (r < I_W1) { const int kb = r / 160, nb = r % 160; transpose_item(win, D, INC, 64 * kb, src_win1(32 * nb), (bf16_t*)(p.ws + WS_WIN1), 32 * nb, scr, lane); continue; } r -= I_W1;
        if (r < I_W2) { const int kb = r / 96, nb = r % 96; transpose_item(win, D, INC, 64 * kb, src_win2(32 * nb), (bf16_t*)(p.ws + WS_WIN2), 32 * nb, scr, lane); continue; } r -= I_W2;
        const int w = r / I_P, q = r % I_P, kb = q / 32, nb = q % 32;
        const float* src = p.in[w == 0 ? I_WPA : (w == 1 ? I_WPB : I_WOUT)]; bf16_t* dst = (bf16_t*)(p.ws + (w == 0 ? WS_WPA : (w == 1 ? WS_WPB : WS_WOUT)));
        transpose_item(src, D, D, 64 * kb, 32 * nb, dst, 32 * nb, scr, lane);
    }
    convert_ffn_weights(p, lds, p.in[I_WGU1], p.in[I_WDN1]);
}

DEVI void ph_mods_xn1(const Params& p, unsigned char* lds) {
    const int tid = threadIdx.x, lane = tid & 63, wave = tid >> 6;
    const float* mp = (const float*)(p.ws + WS_MODP); float* mods = (float*)(p.ws + WS_MODS); const float* bada = p.in[I_BADA];
    for (int v = blockIdx.x * 512 + tid; v < 2 * NMODS; v += gridDim.x * 512) { const int b = v / NMODS, j = v % NMODS; float s = bada[j];
#pragma unroll
        for (int ks = 0; ks < 8; ++ks) s += mp[(ks * 2 + b) * NMODS + j];
        mods[v] = s; }
    float* lm = (float*)lds;
    for (int v = tid; v < 4096; v += 512) { const int b = v >> 11, j = v & 2047; float s = bada[j];
#pragma unroll
        for (int ks = 0; ks < 8; ++ks) s += mp[(ks * 2 + b) * NMODS + j];
        lm[v] = s; }
    __syncthreads();
    const int gw = blockIdx.x * 8 + wave, NGW = gridDim.x * 8;
    const float* gpre = p.in[I_GPRE]; bf16_t* XN = (bf16_t*)(p.ws + WS_XN);
    for (int m = gw; m < M; m += NGW) {
        const int b = m >> 13; const f32x4* xr = (const f32x4*)(p.in[I_X] + (size_t)m * D) + lane;
        f32x4 v[4]; float ss = 0.f;
#pragma unroll
        for (int j = 0; j < 4; ++j) { v[j] = xr[64 * j]; ss += (v[j].x * v[j].x + v[j].y * v[j].y) + (v[j].z * v[j].z + v[j].w * v[j].w); }
        const float rstd = rsqrtf(wave_sum(ss) * (1.f / D) + EPS);
        u32x2* o8 = (u32x2*)(XN + (size_t)m * D) + lane;
#pragma unroll
        for (int j = 0; j < 4; ++j) { const int col = 4 * lane + 256 * j; const f32x4 g = *(const f32x4*)(gpre + col);
            const f32x4 sh = *(const f32x4*)(lm + b * 2048 + col), s1 = *(const f32x4*)(lm + b * 2048 + 1024 + col);
            const f32x4 h = v[j] * rstd * g * (1.f + s1) + sh; u32x2 w; w.x = pk2(h.x, h.y); w.y = pk2(h.z, h.w); o8[64 * j] = w; }
    }
}

DEVI void ph_norm_res(const Params& p, const float* Y, const float* xin, float* xout, bool mk_xn, int sub  , float gs) {
    const int tid = threadIdx.x, lane = tid & 63, wave = tid >> 6;
    const int gw = blockIdx.x * 8 + wave, NGW = gridDim.x * 8;
    const float* mods = (const float*)(p.ws + WS_MODS); const float* gpost = p.in[I_GPOST] + sub * D; const float* gpre = p.in[I_GPRE] + (sub + 1) * D;
    bf16_t* XN = (bf16_t*)(p.ws + WS_XN);
    for (int m = gw; m < M; m += NGW) {
        const int b = m >> 13; const float* mb = mods + b * NMODS;
        const f32x4* yr = (const f32x4*)(Y + (size_t)m * D) + lane; const f32x4* xr = (const f32x4*)(xin + (size_t)m * D) + lane; f32x4* xo = (f32x4*)(xout + (size_t)m * D) + lane;
        f32x4 y[4]; float ss = 0.f;
#pragma unroll
        for (int j = 0; j < 4; ++j) { y[j] = yr[64 * j]; ss += (y[j].x * y[j].x + y[j].y * y[j].y) + (y[j].z * y[j].z + y[j].w * y[j].w); }
        const float rstd = rsqrtf(wave_sum(ss) * (1.f / D) + EPS); float s2 = 0.f;
#pragma unroll
        for (int j = 0; j < 4; ++j) { const int col = 4 * lane + 256 * j; const f32x4 g = *(const f32x4*)(gpost + col), gt = *(const f32x4*)(mb + (3 * sub + 2) * D + col);
            const f32x4 xn = xr[64 * j] + gs * gt * (y[j] * rstd * g); xo[64 * j] = xn; y[j] = xn; s2 += (xn.x * xn.x + xn.y * xn.y) + (xn.z * xn.z + xn.w * xn.w); }
        if (mk_xn) {
            const float r2 = rsqrtf(wave_sum(s2) * (1.f / D) + EPS); u32x2* o8 = (u32x2*)(XN + (size_t)m * D) + lane;
#pragma unroll
            for (int j = 0; j < 4; ++j) { const int col = 4 * lane + 256 * j; const f32x4 g = *(const f32x4*)(gpre + col);
                const f32x4 sh = *(const f32x4*)(mb + (3 * sub + 3) * D + col), s1 = *(const f32x4*)(mb + (3 * sub + 4) * D + col);
                const f32x4 h = y[j] * r2 * g * (1.f + s1) + sh; u32x2 w; w.x = pk2(h.x, h.y); w.y = pk2(h.z, h.w); o8[64 * j] = w; }
        }
    }
}

template <bool DUAL, class Epi>
DEVI void gemm_simple(unsigned char* lds, const bf16_t* A, const bf16_t* Bt, int Mrows, int Nlog, int K, const Epi& E) {
    float* As = (float*)lds; float* Bs = As + 32 * 132;
    const int tid = threadIdx.x, ty = tid >> 4, tx = tid & 15;
    const int LC = DUAL ? 64 : 128, ntn = Nlog / LC, ntiles = (Mrows / 128) * ntn;
    for (int tile = blockIdx.x; tile < ntiles; tile += gridDim.x) {
        const int tm = tile / ntn, tn = tile % ntn;
        float acc[4][8];
#pragma unroll
        for (int i = 0; i < 4; ++i)
#pragma unroll
            for (int j = 0; j < 8; ++j) acc[i][j] = 0.f;
        const int lr = tid >> 2, kc = (tid & 3) * 8;
        const int brow = DUAL ? ((tn >> 1) * 256 + (lr >= 64 ? 128 : 0) + (tn & 1) * 64 + (lr & 63)) : tn * 128 + lr;
        const bf16_t* ap = A + (size_t)(tm * 128 + lr) * K + kc; const bf16_t* bp = Bt + (size_t)brow * K + kc;
        for (int k0 = 0; k0 < K; k0 += 32) {
            float fa[8], fb[8]; unpack8(*(const u32x4*)(ap + k0), fa); unpack8(*(const u32x4*)(bp + k0), fb);
            __syncthreads();
#pragma unroll
            for (int i = 0; i < 8; ++i) { As[(kc + i) * 132 + lr] = fa[i]; Bs[(kc + i) * 132 + lr] = fb[i]; }
            __syncthreads();
#pragma unroll 8
            for (int kk = 0; kk < 32; ++kk) {
                const f32x4 a = *(const f32x4*)(As + kk * 132 + 4 * ty), b0 = *(const f32x4*)(Bs + kk * 132 + 4 * tx), b1 = *(const f32x4*)(Bs + kk * 132 + 64 + 4 * tx);
#pragma unroll
                for (int i = 0; i < 4; ++i) { acc[i][0] += a[i] * b0[0]; acc[i][1] += a[i] * b0[1]; acc[i][2] += a[i] * b0[2]; acc[i][3] += a[i] * b0[3];
                    acc[i][4] += a[i] * b1[0]; acc[i][5] += a[i] * b1[1]; acc[i][6] += a[i] * b1[2]; acc[i][7] += a[i] * b1[3]; }
            }
        }
#pragma unroll
        for (int i = 0; i < 4; ++i) { const int row = tm * 128 + 4 * ty + i;
            const f32x4 v0 = {acc[i][0], acc[i][1], acc[i][2], acc[i][3]}, v1 = {acc[i][4], acc[i][5], acc[i][6], acc[i][7]};
            if (DUAL) E(row, tn * 64 + 4 * tx, v0, v1);
            else { E(row, tn * 128 + 4 * tx, v0, v0); E(row, tn * 128 + 64 + 4 * tx, v1, v1); } }
    }
}

DEVI void st_bf4(bf16_t* p, f32x4 v) { u32x2 w; w.x = pk2(v.x, v.y); w.y = pk2(v.z, v.w); *(u32x2*)p = w; }
DEVI f32x4 ld_bf4(const bf16_t* p) { const u32x2 w = *(const u32x2*)p; return (f32x4){__uint_as_float(w.x << 16), __uint_as_float(w.x & 0xffff0000u), __uint_as_float(w.y << 16), __uint_as_float(w.y & 0xffff0000u)}; }
struct EpSwiglu { bf16_t* H; DEVI void operator()(int row, int col, f32x4 g, f32x4 u) const {
    f32x4 o; o.x = silu_f(g.x) * u.x; o.y = silu_f(g.y) * u.y; o.z = silu_f(g.z) * u.z; o.w = silu_f(g.w) * u.w; st_bf4(H + (size_t)row * DFF + col, o); } };
struct EpF32 { float* Y; DEVI void operator()(int row, int col, f32x4 v, f32x4) const { *(f32x4*)(Y + (size_t)row * D + col) = v; } };
struct EpWin1 { unsigned char* ws; DEVI void operator()(int row, int col, f32x4 v, f32x4) const {
    if (col < 512) st_bf4((bf16_t*)(ws + WS_QA) + (size_t)row * 512 + col, v * QA_SCALE);
    else if (col < 1024) st_bf4((bf16_t*)(ws + WS_KA) + (size_t)row * 512 + (col - 512), v);
    else if (col < 2048) st_bf4((bf16_t*)(ws + WS_VA) + (size_t)row * D + (col - 1024), v);
    else if (col < 3072) st_bf4((bf16_t*)(ws + WS_QB) + (size_t)row * D + (col - 2048), v * C2);
    else if (col < 4096) st_bf4((bf16_t*)(ws + WS_KB) + (size_t)row * D + (col - 3072), v);
    else st_bf4((bf16_t*)(ws + WS_VB) + (size_t)row * D + (col - 4096), v); } };
struct EpWin2 { unsigned char* ws; DEVI void operator()(int row, int col, f32x4 v, f32x4) const {
    if (col < 1024) { f32x4 o = {silu_f(v.x), silu_f(v.y), silu_f(v.z), silu_f(v.w)}; st_bf4((bf16_t*)(ws + WS_RA) + (size_t)row * D + col, o); }
    else { f32x4 o = {sigmoid_f(v.x), sigmoid_f(v.y), sigmoid_f(v.z), sigmoid_f(v.w)}; st_bf4((bf16_t*)(ws + (col < 2048 ? WS_GA : WS_GB)) + (size_t)row * D + (col & 1023), o); } } };
struct EpPa { bf16_t* GA; DEVI void operator()(int row, int col, f32x4 v, f32x4) const { bf16_t* q = GA + (size_t)row * D + col; st_bf4(q, ld_bf4(q) * v); } };
struct EpPb { const bf16_t* Tm; bf16_t* GB; DEVI void operator()(int row, int col, f32x4 v, f32x4) const { bf16_t* q = GB + (size_t)row * D + col; st_bf4(q, ld_bf4(Tm + (size_t)row * D + col) + ld_bf4(q) * v); } };

DEVI void ph_thin_cols(const Params& p) {
    const bf16_t* XN = (const bf16_t*)(p.ws + WS_XN); const float* win = p.in[I_WIN]; const float* bf = p.in[I_BF];
    float* alow = (float*)(p.ws + WS_ALOW); float* logf = (float*)(p.ws + WS_LOGF);
    for (int v = blockIdx.x * 512 + threadIdx.x; v < M * 32; v += gridDim.x * 512) {
        const int m = v >> 5, j = v & 31, col = j < 16 ? 2048 + j : 6160 + (j - 16);
        const bf16_t* xr = XN + (size_t)m * D; const float* w = win + col; float s = 0.f;
        for (int k = 0; k < D; k += 8) { float f[8]; unpack8(*(const u32x4*)(xr + k), f);
#pragma unroll
            for (int i = 0; i < 8; ++i) s += f[i] * w[(size_t)(k + i) * INC]; }
        if (j < 16) alow[m * 16 + j] = s; else logf[m * 16 + (j - 16)] = logsigmoid_f(s + bf[j - 16]);
    }
}
DEVI void ph_fcum(const Params& p) {
    const int lane = threadIdx.x & 63, gw = blockIdx.x * 8 + (threadIdx.x >> 6);
    if (gw >= 32) return;
    const int b = gw >> 4, hh = gw & 15; const float* lf = (const float*)(p.ws + WS_LOGF) + (size_t)(b * T) * 16 + hh; float* fc = (float*)(p.ws + WS_FCUM) + (size_t)gw * T;
    double s = 0.0;
    for (int i = 0; i < 128; ++i) s += (double)lf[(size_t)(lane * 128 + i) * 16];
    double incl = s;
#pragma unroll
    for (int o = 1; o < 64; o <<= 1) { const double t = __shfl_up(incl, o); if (lane >= o) incl += t; }
    double run = incl - s;
    for (int i = 0; i < 128; ++i) { run += (double)lf[(size_t)(lane * 128 + i) * 16]; fc[lane * 128 + i] = (float)run; }
}

template <bool OUT>
DEVI void gla_rec(const Params& p, unsigned char* lds, int unit) {
    const int j = unit & 31, bh = unit >> 5, h = bh & 3, b = bh >> 2;
    const int tid = threadIdx.x, e = tid & 255, dh = tid >> 8, d0 = dh * 64;
    float* qs = (float*)lds; float* ks = qs + 2048; float* al = ks + 2048; float* vs = al + 2048; float* red = vs + 4096; float* lsum = red + 8192;
    float* U = (float*)(p.ws + WS_U) + (size_t)unit * 32768;
    const bf16_t* QA = (const bf16_t*)(p.ws + WS_QA); const bf16_t* KA = (const bf16_t*)(p.ws + WS_KA); bf16_t* VA = (bf16_t*)(p.ws + WS_VA);
    const float* alow = (const float*)(p.ws + WS_ALOW);
    float S[64];
#pragma unroll
    for (int i = 0; i < 64; ++i) S[i] = OUT ? U[(d0 + i) * 256 + e] : 0.f;
    const int dd = tid & 127, tq = tid >> 7;
    float wa[16];
#pragma unroll
    for (int r = 0; r < 16; ++r) wa[r] = p.in[I_WA2][r * 512 + h * 128 + dd];
    const float ba = p.in[I_BA][h * 128 + dd];
    float lacc = 0.f;
    for (int sb = 0; sb < 16; ++sb) {
        const int t0 = b * T + j * 256 + sb * 16;
#pragma unroll
        for (int r = 0; r < 4; ++r) { const int tt = tq + 4 * r; const size_t row = (size_t)(t0 + tt);
            const f32x4* ar = (const f32x4*)(alow + row * 16); float s = ba;
#pragma unroll
            for (int q4 = 0; q4 < 4; ++q4) { const f32x4 a = ar[q4]; s += a.x * wa[4 * q4] + a.y * wa[4 * q4 + 1] + a.z * wa[4 * q4 + 2] + a.w * wa[4 * q4 + 3]; }
            const float la = logsigmoid_f(s) * (1.f / 16.f); lacc += la; al[tt * 128 + dd] = __expf(la);
            qs[tt * 128 + dd] = bf2f(QA[row * 512 + h * 128 + dd]); ks[tt * 128 + dd] = bf2f(KA[row * 512 + h * 128 + dd]); }
#pragma unroll
        for (int r = 0; r < 8; ++r) { const int idx = tid + 512 * r, tt = idx >> 8, ee = idx & 255; vs[idx] = bf2f(VA[(size_t)(t0 + tt) * D + h * 256 + ee]); }
        __syncthreads();
        for (int tt = 0; tt < 16; ++tt) {
            const float v = vs[tt * 256 + e]; float acc = 0.f;
            const float* alp = al + tt * 128 + d0; const float* kp = ks + tt * 128 + d0; const float* qp = qs + tt * 128 + d0;
#pragma unroll
            for (int i = 0; i < 64; ++i) { S[i] = alp[i] * S[i] + kp[i] * v; if (OUT) acc += qp[i] * S[i]; }
            if (OUT) red[(tt * 2 + dh) * 256 + e] = acc;
        }
        __syncthreads();
        if (OUT) {
#pragma unroll
            for (int r = 0; r < 8; ++r) { const int idx = tid + 512 * r, tt = idx >> 8, ee = idx & 255;
                VA[(size_t)(t0 + tt) * D + h * 256 + ee] = (bf16_t)f2bf(red[(tt * 2) * 256 + ee] + red[(tt * 2 + 1) * 256 + ee]); }
        }
    }
    if (!OUT) {
#pragma unroll
        for (int i = 0; i < 64; ++i) U[(d0 + i) * 256 + e] = S[i];
        lsum[tq * 128 + dd] = lacc; __syncthreads();
        if (tid < 128) ((float*)(p.ws + WS_DEC))[unit * 128 + tid] = __expf(lsum[tid] + lsum[128 + tid] + lsum[256 + tid] + lsum[384 + tid]);
    }
    __syncthreads();
}
DEVI void ph_gla_scan(const Params& p) {
    float* U = (float*)(p.ws + WS_U); const float* dec = (const float*)(p.ws + WS_DEC);
    for (int v = blockIdx.x * 512 + threadIdx.x; v < 8 * 32768; v += gridDim.x * 512) {
        const int bh = v >> 15, de = v & 32767, d = de >> 8; float s = 0.f;
        for (int j = 0; j < 32; ++j) { const int unit = bh * 32 + j; float* q = U + (size_t)unit * 32768 + de; const float u = *q; *q = s; s = dec[unit * 128 + d] * s + u; }
    }
}
DEVI void ph_oa_norm(const Params& p) {
    const int lane = threadIdx.x & 63, gw = blockIdx.x * 8 + (threadIdx.x >> 6), NGW = gridDim.x * 8;
    bf16_t* OA = (bf16_t*)(p.ws + WS_VA); const bf16_t* RA = (const bf16_t*)(p.ws + WS_RA); const float* gg = p.in[I_GGLA];
    for (int m = gw; m < M; m += NGW) {
        bf16_t* op = OA + (size_t)m * D + 16 * lane; const bf16_t* rp = RA + (size_t)m * D + 16 * lane;
        float o[16], r[16]; unpack8(*(const u32x4*)op, o); unpack8(*(const u32x4*)(op + 8), o + 8); unpack8(*(const u32x4*)rp, r); unpack8(*(const u32x4*)(rp + 8), r + 8);
        float ss = 0.f;
#pragma unroll
        for (int i = 0; i < 16; ++i) ss += o[i] * o[i];
        ss += __shfl_xor(ss, 1); ss += __shfl_xor(ss, 2); ss += __shfl_xor(ss, 4); ss += __shfl_xor(ss, 8);
        const float rstd = rsqrtf(ss * (1.f / 256.f) + EPS);
        u32x4 w0, w1; float t[16];
#pragma unroll
        for (int i = 0; i < 16; ++i) t[i] = o[i] * rstd * gg[16 * lane + i] * r[i];
        w0.x = pk2(t[0], t[1]); w0.y = pk2(t[2], t[3]); w0.z = pk2(t[4], t[5]); w0.w = pk2(t[6], t[7]);
        w1.x = pk2(t[8], t[9]); w1.y = pk2(t[10], t[11]); w1.z = pk2(t[12], t[13]); w1.w = pk2(t[14], t[15]);
        *(u32x4*)op = w0; *(u32x4*)(op + 8) = w1;
    }
}

DEVI void attn_simple_unit(const Params& p, unsigned char* lds, int unit) {
    const int qb = 15 - (unit >> 5), bh = unit & 31, b = bh >> 4, hh = bh & 15;
    float* Ks = (float*)lds; float* Vs = Ks + 4096; float* bs = Vs + 4096;
    const int tid = threadIdx.x, t = qb * 512 + tid; const size_t row = (size_t)(b * T + t);
    bf16_t* QB = (bf16_t*)(p.ws + WS_QB); const bf16_t* KB = (const bf16_t*)(p.ws + WS_KB); const bf16_t* VB = (const bf16_t*)(p.ws + WS_VB);
    const float* fc = (const float*)(p.ws + WS_FCUM) + (size_t)bh * T;
    float q[64], o[64];
#pragma unroll
    for (int i = 0; i < 8; ++i) unpack8(*(const u32x4*)(QB + row * D + hh * 64 + 8 * i), q + 8 * i);
#pragma unroll
    for (int i = 0; i < 64; ++i) o[i] = 0.f;
    float mx = -1e30f, l = 0.f; const float Fq0 = fc[qb * 512];
    const int nkt = (qb * 512 + 512) / 64;
    for (int kt = 0; kt < nkt; ++kt) {
        __syncthreads();
        { const int key = tid >> 3, c = (tid & 7) * 8; const size_t g = (size_t)(b * T + kt * 64 + key) * D + hh * 64 + c;
          unpack8(*(const u32x4*)(KB + g), Ks + key * 64 + c); unpack8(*(const u32x4*)(VB + g), Vs + key * 64 + c); }
        if (tid < 64) bs[tid] = (Fq0 - fc[kt * 64 + tid]) * LOG2E;
        __syncthreads();
        const int smax = t - kt * 64;
        for (int s = 0; s < 64; ++s) {
            if (s <= smax) {
                float sc = bs[s]; const float* kr = Ks + s * 64;
#pragma unroll
                for (int i = 0; i < 64; ++i) sc += q[i] * kr[i];
                if (sc > mx + 8.f) { const float f = exp2f(mx - sc); l *= f;
#pragma unroll
                    for (int i = 0; i < 64; ++i) o[i] *= f;
                    mx = sc; }
                const float pr = exp2f(sc - mx); l += pr; const float* vr = Vs + s * 64;
#pragma unroll
                for (int i = 0; i < 64; ++i) o[i] += pr * vr[i];
            }
        }
    }
    const float inv = 1.f / l;
#pragma unroll
    for (int i = 0; i < 8; ++i) { u32x4 w; w.x = pk2(o[8 * i] * inv, o[8 * i + 1] * inv); w.y = pk2(o[8 * i + 2] * inv, o[8 * i + 3] * inv); w.z = pk2(o[8 * i + 4] * inv, o[8 * i + 5] * inv); w.w = pk2(o[8 * i + 6] * inv, o[8 * i + 7] * inv);
        *(u32x4*)(QB + row * D + hh * 64 + 8 * i) = w; }
    __syncthreads();
}

namespace pg8 {
#define PG8_LAS __attribute__((address_space(3)))
typedef unsigned short bf16_t;
typedef short bf16x8 __attribute__((ext_vector_type(8)));
typedef float f32x4 __attribute__((ext_vector_type(4)));
typedef unsigned u32x4 __attribute__((ext_vector_type(4)));
constexpr int BM = 256, BK = 64, HALF = 128, HTB = HALF * BK * 2  , STAGE_BYTES = 8 * HTB, NXCD = 8, WGM = 8;

__host__ __device__ __forceinline__ int lds_byte(int r, int c) { const int st = (r >> 4) * 2 + (c >> 5), rr = r & 15, cc = c & 31, ob = rr * 64 + cc * 2; return st * 1024 + (ob ^ (((ob >> 9) & 1) << 5)); }
__host__ __device__ __forceinline__ void stage_rc(int b, int& R, int& C) { const int st = b / 1024, sb = b % 1024, swz = sb ^ (((sb >> 9) & 1) << 5); R = (st >> 1) * 16 + swz / 64; C = (st & 1) * 32 + (swz % 64) / 2; }
__host__ __device__ __forceinline__ int perm32(int rho) { const int n = rho >> 4, i = rho & 15; return 8 * (i >> 2) + 4 * n + (i & 3); }

struct Unit { int pm, pn; };
struct Gemm { const bf16_t* A; const bf16_t* Bt; int M, N, K; };

struct StaticOrder {
    int nM, nN, nwg, G, c;
    __host__ __device__ void init(int M, int N, int G_, int c_) { nM = M / BM; nN = N / BM; nwg = nM * nN; G = G_; c = c_; }
    __host__ __device__ bool next(int i, Unit& u) const {
        const long L = (long)i * G + c; if (L >= nwg) return false;
        int wgid = (int)L; { const int q = nwg / NXCD, r = nwg % NXCD, xcd = wgid % NXCD, off = wgid / NXCD; wgid = (xcd < r ? xcd * (q + 1) : r * (q + 1) + (xcd - r) * q) + off; }
        const int nig = WGM * nN, gid = wgid / nig, fm = gid * WGM, gsz = (nM - fm) < WGM ? (nM - fm) : WGM;
        u.pm = fm + ((wgid % nig) % gsz); u.pn = (wgid % nig) / gsz; return true;
    }
    __device__ __forceinline__ void a_ready(const Unit&) const {}
    __device__ __forceinline__ void done(const Unit&) const {}
};

__device__ __forceinline__ unsigned cvt_pk_bf16(float lo, float hi) { unsigned r; asm volatile("v_cvt_pk_bf16_f32 %0, %1, %2" : "=v"(r) : "v"(lo), "v"(hi)); return r; }
typedef float f32x2 __attribute__((ext_vector_type(2)));

__device__ __forceinline__ float silu_fast(float x) { return x * __builtin_amdgcn_rcpf(1.f + __expf(-x)); }
__device__ __forceinline__ float sigm_fast(float x) { return __builtin_amdgcn_rcpf(1.f + __expf(-x)); }
__device__ __forceinline__ u32x4 pack8(const f32x4 a, const f32x4 b) { u32x4 w; w.x = cvt_pk_bf16(a[0], a[1]); w.y = cvt_pk_bf16(a[2], a[3]); w.z = cvt_pk_bf16(b[0], b[1]); w.w = cvt_pk_bf16(b[2], b[3]); return w; }
__device__ __forceinline__ void unpack8v(const u32x4 v, f32x4& a, f32x4& b) {
    a[0] = __uint_as_float(v.x << 16); a[1] = __uint_as_float(v.x & 0xffff0000u); a[2] = __uint_as_float(v.y << 16); a[3] = __uint_as_float(v.y & 0xffff0000u);
    b[0] = __uint_as_float(v.z << 16); b[1] = __uint_as_float(v.z & 0xffff0000u); b[2] = __uint_as_float(v.w << 16); b[3] = __uint_as_float(v.w & 0xffff0000u); }
struct EpiSwiglu { static constexpr bool PERM = true, AFTER_DRAIN = false; bf16_t* H; int ldh;
    __device__ __forceinline__ void operator()(const f32x4 (&acc)[2][2][4][2], const Unit& u, int wr, int wc, int fr, int fq) const {
        const int row0 = u.pm * BM + wr * 64 + fr, col0 = u.pn * HALF + wc * 32 + 8 * fq;
#pragma unroll
        for (int ai = 0; ai < 2; ++ai)
#pragma unroll
            for (int m = 0; m < 4; ++m) { f32x4 o0, o1;
#pragma unroll
                for (int i = 0; i < 4; ++i) { o0[i] = silu_fast(acc[ai][0][m][0][i]) * acc[ai][1][m][0][i]; o1[i] = silu_fast(acc[ai][0][m][1][i]) * acc[ai][1][m][1][i]; }
                *(u32x4*)(H + (size_t)(row0 + ai * HALF + m * 16) * ldh + col0) = pack8(o0, o1); }
    }
};
struct Seg { bf16_t* base; int ld, colt, act; float sc; };
struct EpiSeg { static constexpr bool PERM = true, AFTER_DRAIN = false; unsigned char* ws; int which;
    __device__ __forceinline__ Seg seg(int pn) const { Seg s; s.sc = 1.f; s.act = 0;
        if (which == 0) {
            if (pn < 2) { s.base = (bf16_t*)(ws + WS_QA); s.ld = 512; s.colt = pn * 256; s.sc = QA_SCALE; }
            else if (pn < 4) { s.base = (bf16_t*)(ws + WS_KA); s.ld = 512; s.colt = (pn - 2) * 256; }
            else if (pn < 8) { s.base = (bf16_t*)(ws + WS_VA); s.ld = 1024; s.colt = (pn - 4) * 256; }
            else if (pn < 12) { s.base = (bf16_t*)(ws + WS_QB); s.ld = 1024; s.colt = (pn - 8) * 256; s.sc = C2; }
            else if (pn < 16) { s.base = (bf16_t*)(ws + WS_KB); s.ld = 1024; s.colt = (pn - 12) * 256; }
            else { s.base = (bf16_t*)(ws + WS_VB); s.ld = 1024; s.colt = (pn - 16) * 256; }
        } else {
            s.ld = 1024; s.colt = (pn & 3) * 256;
            if (pn < 4) { s.base = (bf16_t*)(ws + WS_RA); s.act = 1; } else if (pn < 8) { s.base = (bf16_t*)(ws + WS_GA); s.act = 2; } else { s.base = (bf16_t*)(ws + WS_GB); s.act = 2; }
        }
        return s; }
    __device__ __forceinline__ void operator()(const f32x4 (&acc)[2][2][4][2], const Unit& u, int wr, int wc, int fr, int fq) const {
        const Seg s = seg(u.pn); const int row0 = u.pm * BM + wr * 64 + fr, col0 = s.colt + wc * 32 + 8 * fq;
#pragma unroll
        for (int ai = 0; ai < 2; ++ai)
#pragma unroll
            for (int m = 0; m < 4; ++m) { bf16_t* rowp = s.base + (size_t)(row0 + ai * HALF + m * 16) * s.ld + col0;
#pragma unroll
                for (int bj = 0; bj < 2; ++bj) { f32x4 v0 = acc[ai][bj][m][0], v1 = acc[ai][bj][m][1];
                    if (s.act == 1) {
#pragma unroll
                        for (int i = 0; i < 4; ++i) { v0[i] = silu_fast(v0[i]); v1[i] = silu_fast(v1[i]); } }
                    else if (s.act == 2) {
#pragma unroll
                        for (int i = 0; i < 4; ++i) { v0[i] = sigm_fast(v0[i]); v1[i] = sigm_fast(v1[i]); } }
                    else { v0 = v0 * s.sc; v1 = v1 * s.sc; }
                    *(u32x4*)(rowp + bj * HALF) = pack8(v0, v1); } }
    }
};
template <int MODE> struct EpiGate { static constexpr bool PERM = true, AFTER_DRAIN = false; bf16_t* G; const bf16_t* Tm;
    __device__ __forceinline__ void operator()(const f32x4 (&acc)[2][2][4][2], const Unit& u, int wr, int wc, int fr, int fq) const {
        const int row0 = u.pm * BM + wr * 64 + fr, col0 = u.pn * BM + wc * 32 + 8 * fq;
#pragma unroll
        for (int ai = 0; ai < 2; ++ai)
#pragma unroll
            for (int m = 0; m < 4; ++m) { const size_t off = (size_t)(row0 + ai * HALF + m * 16) * D + col0;
#pragma unroll
                for (int bj = 0; bj < 2; ++bj) { f32x4 g0, g1; unpack8v(*(const u32x4*)(G + off + bj * HALF), g0, g1);
                    f32x4 v0 = g0 * acc[ai][bj][m][0], v1 = g1 * acc[ai][bj][m][1];
                    if (MODE == 1) { f32x4 t0, t1; unpack8v(*(const u32x4*)(Tm + off + bj * HALF), t0, t1); v0 += t0; v1 += t1; }
                    *(u32x4*)(G + off + bj * HALF) = pack8(v0, v1); } }
    }
};
struct EpiF32 { static constexpr bool PERM = false, AFTER_DRAIN = false; float* Y;
    __device__ __forceinline__ void operator()(const f32x4 (&acc)[2][2][4][2], const Unit& u, int wr, int wc, int fr, int fq) const {
        const int row0 = u.pm * BM + wr * 64 + fr, col0 = u.pn * BM + wc * 32 + 4 * fq;
#pragma unroll
        for (int ai = 0; ai < 2; ++ai)
#pragma unroll
            for (int m = 0; m < 4; ++m) { float* rowp = Y + (size_t)(row0 + ai * HALF + m * 16) * D + col0;
#pragma unroll
                for (int bj = 0; bj < 2; ++bj)
#pragma unroll
                    for (int n = 0; n < 2; ++n) *(f32x4*)(rowp + bj * HALF + n * 16) = acc[ai][bj][m][n]; }
    }
};

template <class Epi, class Sched, bool ALIGN_EPI = false, bool SP2 = false>
__device__ __forceinline__ void gemm_phase(PG8_LAS unsigned char* lds, const Gemm g, const Sched& S, const Epi& E) {
    int tid_ = threadIdx.x; asm volatile("" : "+v"(tid_));
    const int tid = tid_, wid = __builtin_amdgcn_readfirstlane(tid >> 6), lane = tid & 63, wr = wid >> 2, wc = wid & 3, fr = lane & 15, fq = lane >> 4;
    const int K = g.K, nt = K / BK;
    unsigned voffA[2], voffB[2];
#pragma unroll
    for (int i = 0; i < 2; ++i) { int R, C; stage_rc(tid * 16 + i * 8192, R, C); const int Rb = Epi::PERM ? ((R & ~31) + perm32(R & 31)) : R;
        voffA[i] = (unsigned)(R * K + C) * 2u; voffB[i] = (unsigned)(Rb * K + C) * 2u; }
    const size_t kstep = (size_t)(BK * 2);
    const size_t hstep = (size_t)HALF * K * 2;
    const size_t tstep = 2 * hstep;
    const unsigned ldsw = (unsigned)wid * 1024u;
    const int aoff = lds_byte(wr * 64 + fr, fq * 8), boff = lds_byte(wc * 32 + fr, fq * 8);
#define PG8_SA(b, h) (((b) * 2 + (h)) * HTB)
#define PG8_SB(b, h) ((4 + (b) * 2 + (h)) * HTB)
#define PG8_STAGE(bufoff, gbase, voff) do { _Pragma("unroll") for (int _i = 0; _i < 2; ++_i) \
        __builtin_amdgcn_global_load_lds((const unsigned*)((const char*)(gbase) + (voff)[_i]), (PG8_LAS unsigned*)(lds + (bufoff) + ldsw + _i * 8192), 16, 0, 0); } while (0)
#define PG8_LDA(dst, b, h) do { _Pragma("unroll") for (int m = 0; m < 4; ++m) _Pragma("unroll") for (int k = 0; k < 2; ++k) dst[m][k] = *(const PG8_LAS bf16x8*)(lds + PG8_SA(b, h) + aoff + m * 2048 + k * 1024); } while (0)
#define PG8_LDB(dst, b, h) do { _Pragma("unroll") for (int n = 0; n < 2; ++n) _Pragma("unroll") for (int k = 0; k < 2; ++k) dst[n][k] = *(const PG8_LAS bf16x8*)(lds + PG8_SB(b, h) + boff + n * 2048 + k * 1024); } while (0)
#define PG8_MMA(ai, bj, At, Bt) do { __builtin_amdgcn_s_setprio(1); _Pragma("unroll") for (int m = 0; m < 4; ++m) _Pragma("unroll") for (int n = 0; n < 2; ++n) _Pragma("unroll") for (int k = 0; k < 2; ++k) \
        acc[ai][bj][m][n] = __builtin_amdgcn_mfma_f32_16x16x32_bf16(Bt[n][k], At[m][k], acc[ai][bj][m][n], 0, 0, 0); __builtin_amdgcn_s_setprio(0); } while (0)
#define PG8_WAIT_V(n) asm volatile("s_waitcnt vmcnt(" #n ")" ::: "memory")
#define PG8_WAIT_L(n) asm volatile("s_waitcnt lgkmcnt(" #n ")" ::: "memory")
#define PG8_BAR __builtin_amdgcn_s_barrier()
#define PG8_SCHED __builtin_amdgcn_sched_barrier(0)
    Unit cur, nxt; int ui = 0;
    if (!S.next(0, cur)) return;
    f32x4 acc[2][2][4][2];
#pragma unroll
    for (int a = 0; a < 2; ++a)
#pragma unroll
        for (int b = 0; b < 2; ++b)
#pragma unroll
            for (int m = 0; m < 4; ++m)
#pragma unroll
                for (int n = 0; n < 2; ++n) acc[a][b][m][n] = (f32x4){0.f, 0.f, 0.f, 0.f};
    bf16x8 At[4][2], B0[2][2], B1[2][2];
    const char* cA = (const char*)g.A + (size_t)cur.pm * tstep; const char* cB = (const char*)g.Bt + (size_t)cur.pn * tstep;
    S.a_ready(cur);
    if constexpr (SP2) {
        PG8_STAGE(PG8_SB(0, 0), cB, voffB); PG8_STAGE(PG8_SB(0, 1), cB + hstep, voffB); PG8_STAGE(PG8_SA(0, 0), cA, voffA); PG8_STAGE(PG8_SA(0, 1), cA + hstep, voffA);
        if (wr == 1) PG8_BAR;
        PG8_WAIT_V(2); PG8_BAR;
        PG8_STAGE(PG8_SB(1, 0), cB + kstep, voffB); PG8_STAGE(PG8_SA(1, 0), cA + kstep, voffA); PG8_STAGE(PG8_SB(1, 1), cB + hstep + kstep, voffB);
        PG8_WAIT_V(6); PG8_BAR;
    } else {
        PG8_STAGE(PG8_SB(0, 0), cB, voffB); PG8_STAGE(PG8_SA(0, 0), cA, voffA); PG8_STAGE(PG8_SB(0, 1), cB + hstep, voffB); PG8_STAGE(PG8_SA(0, 1), cA + hstep, voffA);
        if (wr == 1) PG8_BAR;
        PG8_WAIT_V(4); PG8_BAR;
        PG8_STAGE(PG8_SB(1, 0), cB + kstep, voffB); PG8_STAGE(PG8_SA(1, 0), cA + kstep, voffA); PG8_STAGE(PG8_SB(1, 1), cB + hstep + kstep, voffB);
        PG8_WAIT_V(6); PG8_BAR;
    }
    for (;;) {
        const bool has_next = S.next(ui + 1, nxt);
        const char* nA = has_next ? (const char*)g.A + (size_t)nxt.pm * tstep : cA; const char* nB = has_next ? (const char*)g.Bt + (size_t)nxt.pn * tstep : cB;
        for (int t = 0; t < nt; t += 2) {
            const bool last = (t == nt - 2);
            const char* a1 = cA + (size_t)(t + 1) * kstep;
            const char* a2 = last ? nA : cA + (size_t)(t + 2) * kstep; const char* b2 = last ? nB : cB + (size_t)(t + 2) * kstep;
            const char* a3 = a2 + kstep; const char* b3 = b2 + kstep;
            if (last && has_next) S.a_ready(nxt);
            if constexpr (SP2) {
            PG8_LDB(B0, 0, 0); PG8_LDB(B1, 0, 1); PG8_SCHED; PG8_LDA(At, 0, 0); PG8_STAGE(PG8_SA(1, 1), a1 + hstep, voffA);
            PG8_WAIT_V(8); PG8_WAIT_L(0); PG8_BAR; PG8_MMA(0, 0, At, B0); PG8_MMA(0, 1, At, B1); PG8_BAR; PG8_SCHED;
            PG8_LDA(At, 0, 1); PG8_STAGE(PG8_SB(0, 0), b2, voffB); PG8_STAGE(PG8_SB(0, 1), b2 + hstep, voffB); PG8_STAGE(PG8_SA(0, 0), a2, voffA);
            PG8_WAIT_V(8); PG8_WAIT_L(0); PG8_BAR; PG8_MMA(1, 0, At, B0); PG8_MMA(1, 1, At, B1); PG8_BAR; PG8_SCHED;
            PG8_LDB(B0, 1, 0); PG8_LDB(B1, 1, 1); PG8_SCHED; PG8_LDA(At, 1, 0); PG8_STAGE(PG8_SA(0, 1), a2 + hstep, voffA);
            PG8_WAIT_V(8); PG8_WAIT_L(0); PG8_BAR; PG8_MMA(0, 0, At, B0); PG8_MMA(0, 1, At, B1); PG8_BAR; PG8_SCHED;
            PG8_LDA(At, 1, 1); PG8_STAGE(PG8_SB(1, 0), b3, voffB); PG8_STAGE(PG8_SB(1, 1), b3 + hstep, voffB); PG8_STAGE(PG8_SA(1, 0), a3, voffA);
            PG8_WAIT_V(8); PG8_WAIT_L(0); PG8_BAR; PG8_MMA(1, 0, At, B0); PG8_MMA(1, 1, At, B1); PG8_BAR; PG8_SCHED;
            } else {
            PG8_LDB(B0, 0, 0); PG8_SCHED; PG8_LDA(At, 0, 0); PG8_STAGE(PG8_SA(1, 1), a1 + hstep, voffA);
            PG8_WAIT_L(8); PG8_BAR; PG8_WAIT_L(0); PG8_MMA(0, 0, At, B0); PG8_BAR; PG8_SCHED;
            PG8_LDB(B1, 0, 1); PG8_STAGE(PG8_SB(0, 0), b2, voffB);
            PG8_BAR; PG8_WAIT_L(0); PG8_MMA(0, 1, At, B1); PG8_BAR;
            PG8_LDA(At, 0, 1); PG8_STAGE(PG8_SA(0, 0), a2, voffA);
            PG8_BAR; PG8_WAIT_L(0); PG8_MMA(1, 0, At, B0); PG8_BAR; PG8_SCHED;
            PG8_STAGE(PG8_SB(0, 1), b2 + hstep, voffB);
            PG8_WAIT_V(6); PG8_BAR; PG8_MMA(1, 1, At, B1); PG8_BAR;
            PG8_LDB(B0, 1, 0); PG8_SCHED; PG8_LDA(At, 1, 0); PG8_STAGE(PG8_SA(0, 1), a2 + hstep, voffA);
            PG8_WAIT_L(8); PG8_BAR; PG8_WAIT_L(0); PG8_MMA(0, 0, At, B0); PG8_BAR; PG8_SCHED;
            PG8_LDB(B1, 1, 1); PG8_STAGE(PG8_SB(1, 0), b3, voffB);
            PG8_BAR; PG8_WAIT_L(0); PG8_MMA(0, 1, At, B1); PG8_BAR;
            PG8_LDA(At, 1, 1); PG8_STAGE(PG8_SA(1, 0), a3, voffA);
            PG8_BAR; PG8_WAIT_L(0); PG8_MMA(1, 0, At, B0); PG8_BAR; PG8_SCHED;
            PG8_STAGE(PG8_SB(1, 1), b3 + hstep, voffB);
            PG8_WAIT_V(6); PG8_BAR; PG8_MMA(1, 1, At, B1); PG8_BAR;
            }
        }
        if constexpr (ALIGN_EPI) { if (wr == 0) PG8_BAR; }
        if constexpr (!Epi::AFTER_DRAIN) { E(acc, cur, wr, wc, fr, fq); S.done(cur); }
        if (!has_next) break;
#pragma unroll
        for (int a = 0; a < 2; ++a)
#pragma unroll
            for (int b = 0; b < 2; ++b)
#pragma unroll
                for (int m = 0; m < 4; ++m)
#pragma unroll
                    for (int n = 0; n < 2; ++n) acc[a][b][m][n] = (f32x4){0.f, 0.f, 0.f, 0.f};
        cur = nxt; cA = nA; cB = nB; ++ui;
        if constexpr (ALIGN_EPI) { if (wr == 1) PG8_BAR; }
    }
    PG8_WAIT_V(0);
    if constexpr (!ALIGN_EPI) { if (wr == 0) PG8_BAR; }
    PG8_BAR;
    if constexpr (Epi::AFTER_DRAIN) { E.fused(acc, cur, wr, wc, fr, fq, lds, wid, lane); S.done(cur); }
#undef PG8_SA
#undef PG8_SB
#undef PG8_STAGE
#undef PG8_LDA
#undef PG8_LDB
#undef PG8_MMA
#undef PG8_WAIT_V
#undef PG8_WAIT_L
#undef PG8_BAR
#undef PG8_SCHED
}
}


template <class Epi, bool ALIGN>
DEVI void run_gemm(unsigned char* lds, const bf16_t* A, const bf16_t* Bt, int Mr, int N, int K, const Epi& E) {
    pg8::Gemm g{A, Bt, Mr, N, K}; pg8::StaticOrder S; S.init(Mr, N, (int)gridDim.x, (int)blockIdx.x);
    pg8::gemm_phase<Epi, pg8::StaticOrder, ALIGN, true>((PG8_LAS unsigned char*)lds, g, S, E);
}
#include <hip/hip_bf16.h>
#include <cmath>
namespace attn_body {
using bf16=__hip_bfloat16;
using bf16x8=__attribute__((ext_vector_type(8)))short;
using s16x4=__attribute__((ext_vector_type(4)))short;
using f32x16=__attribute__((ext_vector_type(16)))float;
using u32x4=__attribute__((ext_vector_type(4)))unsigned;
constexpr int BATCH=2,NHEAD=16,SEQ=8192,D=64,DM=NHEAD*D;
constexpr int NW=8,QBLK=32,QB=QBLK*NW,KVBLK=64,NQB=SEQ/QB;
constexpr int ATTN_PITCH=DM, ATTN_UNIT_ROWS=QB;
__device__ __forceinline__ int crow(int r,int hi){return (r&3)+8*(r>>2)+4*hi;}
#define SBAR() __builtin_amdgcn_sched_barrier(0)
__device__ __forceinline__ void cmask(f32x16&p0,f32x16&p1,int jb,int qrel,int hi){
  const float NEG=-INFINITY; int kb=64*jb+4*hi;
  #pragma unroll
  for(int r=0;r<16;++r){int kv=kb+(r&3)+8*(r>>2); if(kv>qrel)p0[r]=NEG; if(kv+32>qrel)p1[r]=NEG;}
}

constexpr int NSLOT=3, SLOTB=8192;
constexpr int LDS_K=0, LDS_V=NSLOT*SLOTB, LDS_WS=2*NSLOT*SLOTB, LDS_OST=LDS_WS+NW*64*4, LDS_BYTES=LDS_OST+NW*4096;
constexpr int LDS_FB=LDS_BYTES;
constexpr float C2=0.125f*1.4426950408889634f;
__device__ __forceinline__ void glds16(const void*gsrc,unsigned lds_dst){unsigned keep;
  asm volatile("s_mov_b32 %0, m0\n\ts_mov_b32 m0, %2\n\ts_nop 0\n\tglobal_load_lds_dwordx4 %1, off\n\ts_mov_b32 m0, %0":"=&s"(keep):"v"(gsrc),"s"(lds_dst):"memory");}
__device__ __forceinline__ float max3f(float a,float b,float c){float r;asm("v_max3_f32 %0, %1, %2, %3":"=v"(r):"v"(a),"v"(b),"v"(c));return r;}
__device__ __forceinline__ float max2f(float a,float b){float r;asm("v_max_f32_e32 %0, %1, %2":"=v"(r):"v"(a),"v"(b));return r;}
__device__ __forceinline__ float fadd_s(float a,float b){float r;asm("v_add_f32_e32 %0, %1, %2":"=v"(r):"v"(a),"v"(b));return r;}
__device__ __forceinline__ float fsub_s(float a,float b){float r;asm("v_sub_f32_e32 %0, %1, %2":"=v"(r):"v"(a),"v"(b));return r;}
typedef float f32x2_t __attribute__((ext_vector_type(2))); typedef float f32x4_t __attribute__((ext_vector_type(4))); typedef __bf16 bf16x2_t __attribute__((ext_vector_type(2)));
__device__ __forceinline__ unsigned cvtpk_s(float lo,float hi){f32x2_t v={lo,hi};bf16x2_t b=__builtin_convertvector(v,bf16x2_t);return __builtin_bit_cast(unsigned,b);}
#define WAIT_BAR(N) asm volatile("s_waitcnt vmcnt(" #N ") lgkmcnt(0)\n\ts_barrier":::"memory")

__device__ __forceinline__ void qkt(f32x16&p0,f32x16&p1,const char*Kslot,const bf16x8*qr,int r32,int hi){
  const char*kb=Kslot+hi*1024+r32*16;
  #pragma unroll
  for(int d0=0;d0<4;++d0){
    const bf16x8 b0=*reinterpret_cast<const bf16x8*>(kb+d0*2048);
    const bf16x8 b1=*reinterpret_cast<const bf16x8*>(kb+d0*2048+512);
    {p0=__builtin_amdgcn_mfma_f32_32x32x16_bf16(b0,qr[d0],p0,0,0,0);p1=__builtin_amdgcn_mfma_f32_32x32x16_bf16(b1,qr[d0],p1,0,0,0);}}
}
typedef __attribute__((address_space(3))) const char* lds_cptr;
typedef short v4i16_t __attribute__((ext_vector_type(4)));
__device__ __forceinline__ void kload8(bf16x8*kf,lds_cptr kp){
  kf[0]=*(const __attribute__((address_space(3))) bf16x8*)(kp);      kf[1]=*(const __attribute__((address_space(3))) bf16x8*)(kp+512);
  kf[2]=*(const __attribute__((address_space(3))) bf16x8*)(kp+2048); kf[3]=*(const __attribute__((address_space(3))) bf16x8*)(kp+2560);
  kf[4]=*(const __attribute__((address_space(3))) bf16x8*)(kp+4096); kf[5]=*(const __attribute__((address_space(3))) bf16x8*)(kp+4608);
  kf[6]=*(const __attribute__((address_space(3))) bf16x8*)(kp+6144); kf[7]=*(const __attribute__((address_space(3))) bf16x8*)(kp+6656);
}
__device__ __forceinline__ void kload2(bf16x8*kf,lds_cptr kp,int j){ kf[2*j]=*(const __attribute__((address_space(3))) bf16x8*)(kp+j*2048); kf[2*j+1]=*(const __attribute__((address_space(3))) bf16x8*)(kp+j*2048+512); }
__device__ __forceinline__ s16x4 vtr(lds_cptr p){ return __builtin_bit_cast(s16x4,__builtin_amdgcn_ds_read_tr16_b64_v4i16((__attribute__((address_space(3))) v4i16_t*)p)); }
__device__ __forceinline__ float rowmax(const f32x16&p0,const f32x16&p1){
  float a=max3f(p0[0],p0[1],p1[0]),b=max3f(p0[2],p0[3],p1[1]);a=max3f(a,p1[2],p1[3]);
  #pragma unroll
  for(int r=4;r<16;r+=4){a=max3f(a,p0[r],p0[r+1]);b=max3f(b,p0[r+2],p0[r+3]);a=max3f(a,p1[r],p1[r+1]);b=max3f(b,p1[r+2],p1[r+3]);}
  const float m=max2f(a,b);
  auto rr=__builtin_amdgcn_permlane32_swap(__float_as_uint(m),__float_as_uint(m),false,false);
  return max2f(__uint_as_float(rr[0]),__uint_as_float(rr[1]));
}
__device__ __forceinline__ void pv(f32x16*o,int vb,bf16x8 pa0,bf16x8 pa1,bf16x8 pa2,bf16x8 pa3){
  #pragma unroll
  for(int d0=0;d0<2;++d0){s16x4 lo[4],hi[4];
    #pragma unroll
    for(int ks=0;ks<4;++ks){
      asm volatile("ds_read_b64_tr_b16 %0,%1 offset:%c2":"=&v"(lo[ks]):"v"(vb),"i"(d0*4096+ks*1024):"memory");
      asm volatile("ds_read_b64_tr_b16 %0,%1 offset:%c2":"=&v"(hi[ks]):"v"(vb),"i"(d0*4096+ks*1024+512):"memory");}
    asm volatile("s_waitcnt lgkmcnt(0)":::"memory");SBAR();
    #define PK(k) (bf16x8){lo[k][0],lo[k][1],lo[k][2],lo[k][3],hi[k][0],hi[k][1],hi[k][2],hi[k][3]}
    o[d0]=__builtin_amdgcn_mfma_f32_32x32x16_bf16(pa0,PK(0),o[d0],0,0,0);
    o[d0]=__builtin_amdgcn_mfma_f32_32x32x16_bf16(pa1,PK(1),o[d0],0,0,0);
    o[d0]=__builtin_amdgcn_mfma_f32_32x32x16_bf16(pa2,PK(2),o[d0],0,0,0);
    o[d0]=__builtin_amdgcn_mfma_f32_32x32x16_bf16(pa3,PK(3),o[d0],0,0,0);
    #undef PK
  }
}

#ifndef ATTN_STORE16
#define ATTN_STORE16(p,v) (*(u32x4*)(p)=(v))
#endif
template<int THRL> __device__ __forceinline__ void attn_unit(int b,int h,int qb,const bf16*Q,const bf16*__restrict__ K,const bf16*__restrict__ V,bf16*O,const float*__restrict__ Fc,char*shm){
  int tid_=threadIdx.x; asm volatile("":"+v"(tid_)); const int tid=tid_,lane=tid&63,r32=lane&31,hi=lane>>5; const int wid=__builtin_amdgcn_readfirstlane(tid>>6);
  const long rowbase=(long)b*SEQ; const int q0=qb*QB;
  const bf16*Qw=Q+(rowbase+q0+wid*QBLK)*DM+h*D;
  const bf16*Kh=K+rowbase*DM+h*D,*Vh=V+rowbase*DM+h*D;
  const unsigned lds0=(unsigned)(uintptr_t)shm;
  float*wsf=(float*)(shm+LDS_WS)+wid*64;
  const bf16*ksrc=Kh+(long)lane*DM+wid*8;
  const bf16*vsrc=Vh+(long)(16*(wid&3)+(lane>>2))*DM+(wid>>2)*32+(lane&3)*8;
  const unsigned kdst=lds0+LDS_K+wid*1024, vdst=lds0+LDS_V+wid*1024;
  #define DMA_K(t,slot) glds16(ksrc+(long)(t)*KVBLK*DM,(unsigned)__builtin_amdgcn_readfirstlane(kdst+(slot)))
  #define DMA_V(t,slot) glds16(vsrc+(long)(t)*KVBLK*DM,(unsigned)__builtin_amdgcn_readfirstlane(vdst+(slot)))
  const int vb0=(int)(lds0+LDS_V)+((lane>>4)&1)*32+(lane&3)*8+(4*hi+((lane&15)>>2))*64;
  const char*Kbase=shm+LDS_K; bf16x8 kf[8];
  const lds_cptr shm3=(lds_cptr)shm; const lds_cptr kp0=shm3+LDS_K+hi*1024+r32*16; const lds_cptr vp0=shm3+LDS_V+((lane>>4)&1)*32+(lane&3)*8+(4*hi+((lane&15)>>2))*64;
  const int NT=(q0+QB)/KVBLK;
  DMA_K(0,0);DMA_V(0,0);DMA_K(1,SLOTB);
  bf16x8 qr[4];
  #pragma unroll
  for(int d0=0;d0<4;++d0)qr[d0]=*reinterpret_cast<const bf16x8*>(&Qw[(long)r32*DM+d0*16+hi*8]);
  float mhat=0.f,l_reg=0.f;f32x16 o[2];o[0]=f32x16{};o[1]=f32x16{};
  const int qrel=wid*QBLK+r32;
  #define CMASK(P0,P1,t) do{int jb_=(t)-(NT-4); if(jb_>=0)cmask(P0,P1,jb_,qrel,hi);}while(0)
  bool resc=false;
  #define START(P0,P1) do{ const float rm=rowmax(P0,P1); resc=false; \
    { const float dl=rm; mhat=fadd_s(mhat,dl); \
      _Pragma("unroll") for(int r=0;r<16;++r){P0[r]=fsub_s(P0[r],dl);P1[r]=fsub_s(P1[r],dl);} \
      } \
    _Pragma("unroll") for(int r=0;r<16;++r)P0[r]=__builtin_amdgcn_exp2f(P0[r]); }while(0)
  #define RESC() do{ if(resc){ asm volatile("s_waitcnt lgkmcnt(0)":::"memory"); \
      _Pragma("unroll") for(int d_=0;d_<2;++d_) _Pragma("unroll") for(int r=0;r<16;++r)o[d_][r]*=wsf[crow(r,hi)]; } }while(0)
  f32x16 pA0,pA1,pB0,pB1;
  int sl_prev=0,sl_cur=0,sl_next=SLOTB;
  #define ROT() do{sl_prev=sl_cur;sl_cur=sl_next;sl_next=(sl_next==(NSLOT-1)*SLOTB)?0:sl_next+SLOTB;}while(0)
  DMA_K(2,2*SLOTB);
  typedef __attribute__((address_space(3))) f32x4_t* lds_f4w; typedef const __attribute__((address_space(3))) f32x4_t* lds_f4ptr;
  { const float fq0=Fc[q0]; const lds_f4w fbw=(lds_f4w)((__attribute__((address_space(3))) char*)shm+LDS_FB); const f32x4_t*fsrc=(const f32x4_t*)Fc;
    for(int i=tid;i<NT*16;i+=NW*64){ const f32x4_t v=fsrc[i]; fbw[i]=(fq0-v)*1.4426950408889634f; } }
  #define FBINIT(X0,X1,tt) do{ const lds_f4ptr fp_=(lds_f4ptr)(shm3+LDS_FB+((tt)*64+4*hi)*4); \
    _Pragma("unroll") for(int g_=0;g_<4;++g_){ const f32x4_t a_=fp_[2*g_],b_=fp_[2*g_+8]; \
      X0[4*g_]=a_[0]-mhat;X0[4*g_+1]=a_[1]-mhat;X0[4*g_+2]=a_[2]-mhat;X0[4*g_+3]=a_[3]-mhat; X1[4*g_]=b_[0]-mhat;X1[4*g_+1]=b_[1]-mhat;X1[4*g_+2]=b_[2]-mhat;X1[4*g_+3]=b_[3]-mhat; } }while(0)
  WAIT_BAR(3);
  FBINIT(pA0,pA1,0); qkt(pA0,pA1,Kbase,qr,r32,hi);asm volatile("s_nop 15\n\ts_nop 7":"+v"(pA0),"+v"(pA1));CMASK(pA0,pA1,0);
  START(pA0,pA1);
  _Pragma("unroll") for(int r=0;r<16;++r)pA1[r]=__builtin_amdgcn_exp2f(pA1[r]);
  WAIT_BAR(0);
  DMA_K(3,0);DMA_V(1,SLOTB);
  ROT();
  kload8(kf,kp0+sl_cur);
  FBINIT(pB0,pB1,1);
  WAIT_BAR(2);
  s16x4 vlo[8],vhi[8]; u32x4 pw0,pw1,pw2,pw3;
  #define PKW(P,B) cvtpk_s(P[B],P[B+1])
  #define PAF(k) __builtin_bit_cast(bf16x8,pw##k)
  #define VFR(i) (bf16x8){vlo[i][0],vlo[i][1],vlo[i][2],vlo[i][3],vhi[i][0],vhi[i][1],vhi[i][2],vhi[i][3]}
  #define PIN(x) asm volatile("":"+v"(x))
  #define MX3(a,b,c) __builtin_fmaxf(__builtin_fmaxf((a),(b)),(c))
  #define GAPA(MF,A0,A1,A2,A3,W0,W1,PW) do{ MF; sacc+=A0; sacc+=A1; sacc+=A2; sacc+=A3; PIN(sacc); W0; W1; PIN(PW); SBAR(); }while(0)
  #define EX(v) __builtin_amdgcn_exp2f(v)
  #define GAPB(MF,X,B,BI) do{ MF; X[B]=EX(X[B]); X[B+1]=EX(X[B+1]); X[B+2]=EX(X[B+2]); X[B+3]=EX(X[B+3]); PIN(X); BI; SBAR(); }while(0)
  #define BINIT(PX,G,bv) do{ PX[4*(G)]=bv[0]-mhat; PX[4*(G)+1]=bv[1]-mhat; PX[4*(G)+2]=bv[2]-mhat; PX[4*(G)+3]=bv[3]-mhat; PIN(PX); }while(0)
  #define VRD(i) do{ vlo[i]=vtr(vp_+(((i)>>2)*4096+((i)&3)*1024)); vhi[i]=vtr(vp_+(((i)>>2)*4096+((i)&3)*1024+512)); }while(0)
  #define KRD(G,j) do{ if(G){ kload2(kf,kp0+sl_next,j); SBAR(); } }while(0)
  #define STEP(C0,C1,P0,P1,t,GK,GV,GL) do{ SBAR(); \
    const lds_cptr vp_=vp0+sl_prev; \
    VRD(0); SBAR(); float sacc=(P0[0]+P0[1]); \
    GAPA(C0=__builtin_amdgcn_mfma_f32_32x32x16_bf16(kf[0],qr[0],C0,0,0,0), P0[2],P0[3],P0[4],P0[5],     pw0[0]=PKW(P0,0), pw0[1]=PKW(P0,2), pw0); \
    VRD(4); SBAR(); GAPA(C1=__builtin_amdgcn_mfma_f32_32x32x16_bf16(kf[1],qr[0],C1,0,0,0), P0[6],P0[7],P0[8],P0[9],     pw0[2]=PKW(P0,4), pw0[3]=PKW(P0,6), pw0); \
    VRD(1); SBAR(); GAPA(C0=__builtin_amdgcn_mfma_f32_32x32x16_bf16(kf[2],qr[1],C0,0,0,0),   P0[10],P0[11],P0[12],P0[13], pw1[0]=PKW(P0,8), pw1[1]=PKW(P0,10), pw1); \
    VRD(5); SBAR(); GAPA(C1=__builtin_amdgcn_mfma_f32_32x32x16_bf16(kf[3],qr[1],C1,0,0,0),   P0[14],P0[15],P1[0],P1[1],   pw1[2]=PKW(P0,12),pw1[3]=PKW(P0,14), pw1); \
    VRD(2); SBAR(); GAPA(C0=__builtin_amdgcn_mfma_f32_32x32x16_bf16(kf[4],qr[2],C0,0,0,0),   P1[2],P1[3],P1[4],P1[5],     pw2[0]=PKW(P1,0), pw2[1]=PKW(P1,2), pw2); \
    VRD(6); SBAR(); GAPA(C1=__builtin_amdgcn_mfma_f32_32x32x16_bf16(kf[5],qr[2],C1,0,0,0),   P1[6],P1[7],P1[8],P1[9],     pw2[2]=PKW(P1,4), pw2[3]=PKW(P1,6), pw2); \
    VRD(3); SBAR(); GAPA(C0=__builtin_amdgcn_mfma_f32_32x32x16_bf16(kf[6],qr[3],C0,0,0,0),   P1[10],P1[11],P1[12],P1[13], pw3[0]=PKW(P1,8), pw3[1]=PKW(P1,10), pw3); \
    VRD(7); SBAR(); GAPA(C1=__builtin_amdgcn_mfma_f32_32x32x16_bf16(kf[7],qr[3],C1,0,0,0),   P1[14],P1[15],0.f,0.f,       pw3[2]=PKW(P1,12),pw3[3]=PKW(P1,14), pw3); \
    l_reg+=sacc; \
    if(GK){DMA_K((t)+3,sl_cur);} if(GV){DMA_V((t)+1,sl_next);} \
    CMASK(C0,C1,t); \
    const lds_f4ptr fbp_=(lds_f4ptr)(shm3+LDS_FB+(((t)+1)*64+4*hi)*4); f32x4_t bvA=fbp_[0]; \
    { float a=MX3(C0[0],C0[1],C1[0]),b=MX3(C0[2],C0[3],C1[1]); a=MX3(a,C1[2],C1[3]); \
      _Pragma("unroll") for(int r=4;r<16;r+=4){a=MX3(a,C0[r],C0[r+1]);b=MX3(b,C0[r+2],C0[r+3]);a=MX3(a,C1[r],C1[r+1]);b=MX3(b,C1[r+2],C1[r+3]);} \
      float rm=__builtin_fmaxf(a,b); { auto rr=__builtin_amdgcn_permlane32_swap(__float_as_uint(rm),__float_as_uint(rm),false,false); rm=__builtin_fmaxf(__uint_as_float(rr[0]),__uint_as_float(rr[1])); } \
      resc=false; \
      if(__builtin_expect(__any(rm>(float)THRL),0)){ const float dl=__builtin_fmaxf(rm,0.f); mhat+=dl; \
        _Pragma("unroll") for(int r=0;r<16;++r){C0[r]-=dl;C1[r]-=dl;} \
        const float f=__builtin_amdgcn_exp2f(-dl); l_reg*=f; if(hi==0)wsf[r32]=f; resc=true; } } \
    SBAR(); \
    GAPB(o[0]=__builtin_amdgcn_mfma_f32_32x32x16_bf16(PAF(0),VFR(0),o[0],0,0,0), C0,0,do{BINIT(P0,0,bvA); bvA=fbp_[2];}while(0)); \
    GAPB(o[1]=__builtin_amdgcn_mfma_f32_32x32x16_bf16(PAF(0),VFR(4),o[1],0,0,0), C0,4,do{BINIT(P0,1,bvA); bvA=fbp_[4];}while(0)); \
    KRD(GL,0); GAPB(o[0]=__builtin_amdgcn_mfma_f32_32x32x16_bf16(PAF(1),VFR(1),o[0],0,0,0), C0,8,do{BINIT(P0,2,bvA); bvA=fbp_[6];}while(0)); \
    KRD(GL,1); GAPB(o[1]=__builtin_amdgcn_mfma_f32_32x32x16_bf16(PAF(1),VFR(5),o[1],0,0,0), C0,12,do{BINIT(P0,3,bvA); bvA=fbp_[8];}while(0)); \
    KRD(GL,2); GAPB(o[0]=__builtin_amdgcn_mfma_f32_32x32x16_bf16(PAF(2),VFR(2),o[0],0,0,0), C1,0,do{BINIT(P1,0,bvA); bvA=fbp_[10];}while(0)); \
    KRD(GL,3); GAPB(o[1]=__builtin_amdgcn_mfma_f32_32x32x16_bf16(PAF(2),VFR(6),o[1],0,0,0), C1,4,do{BINIT(P1,1,bvA); bvA=fbp_[12];}while(0)); \
    GAPB(o[0]=__builtin_amdgcn_mfma_f32_32x32x16_bf16(PAF(3),VFR(3),o[0],0,0,0), C1,8,do{BINIT(P1,2,bvA); bvA=fbp_[14];}while(0)); \
    GAPB(o[1]=__builtin_amdgcn_mfma_f32_32x32x16_bf16(PAF(3),VFR(7),o[1],0,0,0), C1,12,do{BINIT(P1,3,bvA);}while(0)); \
    }while(0)
  int t=1;
  #undef CMASK
  #define CMASK(P0,P1,t) do{}while(0)
  for(;t+5<NT;t+=2){
    STEP(pB0,pB1,pA0,pA1,t,true,true,true);     WAIT_BAR(2); RESC(); ROT();
    STEP(pA0,pA1,pB0,pB1,t+1,true,true,true);   WAIT_BAR(2); RESC(); ROT();
  }
  #undef CMASK
  #define CMASK(P0,P1,t) do{int jb_=(t)-(NT-4); if(jb_>=0)cmask(P0,P1,jb_,qrel,hi);}while(0)
  #define ENDW(tt) do{ if((tt)+3<NT){WAIT_BAR(2);} else if((tt)+2<NT){WAIT_BAR(1);} else {WAIT_BAR(0);} }while(0)
  for(;t+1<NT;t+=2){
    STEP(pB0,pB1,pA0,pA1,t,(t+3<NT),(t+1<NT),(t+1<NT));       ENDW(t);   RESC(); ROT();
    STEP(pA0,pA1,pB0,pB1,t+1,(t+4<NT),(t+2<NT),(t+2<NT));     ENDW(t+1); RESC(); ROT();
  }
  STEP(pB0,pB1,pA0,pA1,NT-1,false,false,false); RESC();
  { float sacc=pB0[0]+pB0[1]; _Pragma("unroll") for(int r=2;r<16;++r)sacc+=pB0[r]; _Pragma("unroll") for(int r=0;r<16;++r)sacc+=pB1[r]; l_reg+=sacc;
    pw0=(u32x4){PKW(pB0,0),PKW(pB0,2),PKW(pB0,4),PKW(pB0,6)};pw1=(u32x4){PKW(pB0,8),PKW(pB0,10),PKW(pB0,12),PKW(pB0,14)};pw2=(u32x4){PKW(pB1,0),PKW(pB1,2),PKW(pB1,4),PKW(pB1,6)};pw3=(u32x4){PKW(pB1,8),PKW(pB1,10),PKW(pB1,12),PKW(pB1,14)};
    SBAR(); pv(o,vb0+sl_cur,PAF(0),PAF(1),PAF(2),PAF(3)); }
  #undef PKW
  #undef PAF
  #undef VFR
  #undef PIN
  #undef MX3
  #undef GAPA
  #undef GAPB
  #undef BINIT
  #undef FBINIT
  #undef EX
  #undef VRD
  #undef KRD
  #undef STEP
  #undef ENDW
  {auto rr=__builtin_amdgcn_permlane32_swap(__float_as_uint(l_reg),__float_as_uint(l_reg),false,false);l_reg=__uint_as_float(rr[0])+__uint_as_float(rr[1]);}
  if(hi==0)wsf[32+r32]=l_reg;asm volatile("s_waitcnt lgkmcnt(0)":::"memory");
  float rli[16];
  #pragma unroll
  for(int r=0;r<16;++r)rli[r]=__builtin_amdgcn_rcpf(wsf[32+crow(r,hi)]);
  bf16*Ow=O+(rowbase+q0+wid*QBLK)*DM+h*D;
  { bf16*stg=(bf16*)(shm+LDS_OST)+wid*2048;
    #pragma unroll
    for(int r=0;r<16;++r){const int orow=crow(r,hi);
      #pragma unroll
      for(int d0=0;d0<2;++d0)stg[orow*64+d0*32+r32]=__float2bfloat16(o[d0][r]*rli[r]);}
    asm volatile("s_waitcnt lgkmcnt(0)":::"memory");
    #pragma unroll
    for(int i=0;i<4;++i){const int row=i*8+(lane>>3),ch=lane&7; const u32x4 v=*(const u32x4*)(stg+row*64+ch*8); ATTN_STORE16(Ow+(long)row*DM+ch*8,v);} }
  asm volatile("s_waitcnt lgkmcnt(0)\n\ts_barrier":::"memory");
  #undef DMA_K
  #undef DMA_V
  #undef CMASK
  #undef START
  #undef RESC
  #undef ROT
}
constexpr int ATTN_LDS_BYTES=LDS_BYTES;
struct AttnTensors { const bf16* Q; const bf16* K; const bf16* V; bf16* O; const float* F; };
struct AttnUnit { int bh; int qb; };
struct StaticOrder {
  int vcu;
  __device__ __forceinline__ explicit StaticOrder(int grid,int block):vcu((block%8)*(grid/8)+block/8){}
  __device__ __forceinline__ bool next(int i,AttnUnit&u)const{ if(i>=4)return false; const int s=vcu&7; u.bh=vcu>>3; u.qb=(i==0)?s:(i==1)?15-s:(i==2)?16+s:31-s; return true; }
  __device__ __forceinline__ void a_ready(const AttnUnit&)const{}
  __device__ __forceinline__ void done(const AttnUnit&)const{}
};
template<class Sched,int THRL=8> __device__ __forceinline__ void attn_phase(char*lds,const AttnTensors&T,const Sched&S){
  AttnUnit u;
  for(int i=0;S.next(i,u);++i){ S.a_ready(u); attn_unit<THRL>(u.bh/NHEAD,u.bh%NHEAD,u.qb,T.Q,T.K,T.V,T.O,T.F+(size_t)u.bh*SEQ,lds); S.done(u); }
}
#undef SBAR
#undef WAIT_BAR
}

__global__ void __launch_bounds__(512, 2) mega_fwd(Params p) {
    extern __shared__ __attribute__((aligned(16))) unsigned char lds[];
    cg::grid_group grid = cg::this_grid();
    unsigned char* ws = p.ws;
    bf16_t* XN = (bf16_t*)(ws + WS_XN); bf16_t* HB = (bf16_t*)(ws + WS_H);
    ph_prologue(p, lds); grid.sync();
    ph_mods_xn1(p, lds); grid.sync();
    { pg8::EpiSwiglu E{HB, DFF}; run_gemm<pg8::EpiSwiglu, true>(lds, XN, (const bf16_t*)(ws + WS_WGU), M, 2 * DFF, D, E); } grid.sync();
    { pg8::EpiF32 E{(float*)(ws + WS_Y)}; run_gemm<pg8::EpiF32, false>(lds, HB, (const bf16_t*)(ws + WS_WDN), M, D, DFF, E); } grid.sync();
    ph_norm_res(p, (const float*)(ws + WS_Y), p.in[I_X], p.out, true, 0, 0.5f); grid.sync();
    { pg8::EpiSeg E{ws, 0}; run_gemm<pg8::EpiSeg, true>(lds, XN, (const bf16_t*)(ws + WS_WIN1), M, 5120, D, E); }
    ph_thin_cols(p); grid.sync();
    ph_fcum(p);
    for (int u = blockIdx.x; u < 256; u += gridDim.x) gla_rec<false>(p, lds, u);
    grid.sync();
    ph_gla_scan(p); grid.sync();
    for (int u = blockIdx.x; u < 256; u += gridDim.x) gla_rec<true>(p, lds, u);
    __syncthreads();
    { const attn_body::AttnTensors AT{(const attn_body::bf16*)(ws + WS_QB), (const attn_body::bf16*)(ws + WS_KB), (const attn_body::bf16*)(ws + WS_VB), (attn_body::bf16*)(ws + WS_QB), (const float*)(ws + WS_FCUM)};
      const attn_body::StaticOrder S((int)gridDim.x, (int)blockIdx.x); attn_body::attn_phase<attn_body::StaticOrder>((char*)lds, AT, S); }
    grid.sync();
    { pg8::EpiSeg E{ws, 1}; run_gemm<pg8::EpiSeg, true>(lds, XN, (const bf16_t*)(ws + WS_WIN2), M, 3072, D, E); }
    __syncthreads();
    convert_ffn_weights(p, lds, p.in[I_WGU2], p.in[I_WDN2]); grid.sync();
    ph_oa_norm(p); grid.sync();
    { pg8::EpiGate<0> E{(bf16_t*)(ws + WS_GA), nullptr}; run_gemm<pg8::EpiGate<0>, false>(lds, (const bf16_t*)(ws + WS_VA), (const bf16_t*)(ws + WS_WPA), M, D, D, E); } grid.sync();
    { pg8::EpiGate<1> E{(bf16_t*)(ws + WS_GB), (const bf16_t*)(ws + WS_GA)}; run_gemm<pg8::EpiGate<1>, false>(lds, (const bf16_t*)(ws + WS_QB), (const bf16_t*)(ws + WS_WPB), M, D, D, E); } grid.sync();
    { pg8::EpiF32 E{(float*)(ws + WS_Y2)}; run_gemm<pg8::EpiF32, false>(lds, (const bf16_t*)(ws + WS_GB), (const bf16_t*)(ws + WS_WOUT), M, D, D, E); } grid.sync();
    ph_norm_res(p, (const float*)(ws + WS_Y2), p.out, p.out, true, 1, 1.0f); grid.sync();
    { pg8::EpiSwiglu E{HB, DFF}; run_gemm<pg8::EpiSwiglu, true>(lds, XN, (const bf16_t*)(ws + WS_WGU), M, 2 * DFF, D, E); } grid.sync();
    { pg8::EpiF32 E{(float*)(ws + WS_Y)}; run_gemm<pg8::EpiF32, false>(lds, HB, (const bf16_t*)(ws + WS_WDN), M, D, DFF, E); } grid.sync();
    ph_norm_res(p, (const float*)(ws + WS_Y), p.out, p.out, false, 2, 0.5f);
}

extern "C" void kernel_launch(void* const* d_in, const int* in_sizes, int n_in, void* d_out, int out_size, void* d_ws, size_t ws_size, hipStream_t stream) {
    static int grid = 0;
    if (grid == 0) {
        int dev = 0, cus = 0, per_cu = 0;
        hipGetDevice(&dev); hipDeviceGetAttribute(&cus, hipDeviceAttributeMultiprocessorCount, dev);
        if (hipFuncSetAttribute((const void*)mega_fwd, hipFuncAttributeMaxDynamicSharedMemorySize, LDS_BYTES) != hipSuccess) { fprintf(stderr, "hipFuncSetAttribute failed\n"); }
        if (hipOccupancyMaxActiveBlocksPerMultiprocessor(&per_cu, (const void*)mega_fwd, 512, LDS_BYTES) != hipSuccess || per_cu < 1) { fprintf(stderr, "occupancy query: %d\n", per_cu); per_cu = 1; }
        (void)hipGetLastError();
        grid = cus * per_cu;
        if (n_in != 18 || ws_size < 256 * MiB) fprintf(stderr, "unexpected n_in %d / ws %zu\n", n_in, ws_size);
    }
    Params p{};
    for (int i = 0; i < 18; ++i) p.in[i] = (const float*)d_in[i];
    p.out = (float*)d_out; p.ws = (unsigned char*)d_ws;
    void* args[] = {&p};
    hipError_t e = hipLaunchCooperativeKernel((const void*)mega_fwd, dim3(grid), dim3(512), args, LDS_BYTES, stream);
    if (e != hipSuccess) fprintf(stderr, "cooperative launch failed: %s (grid %d)\n", hipGetErrorString(e), grid);
}
```

```cpp
#include <hip/hip_runtime.h>
#include <hip/hip_cooperative_groups.h>
#include <cstdio>
#include <cstdint>
namespace cg = cooperative_groups;

#define DEVI __device__ __forceinline__
typedef unsigned short bf16_t;
typedef float f32x4 __attribute__((ext_vector_type(4)));
typedef unsigned u32x4 __attribute__((ext_vector_type(4)));
typedef unsigned u32x2 __attribute__((ext_vector_type(2)));

constexpr int BATCH = 2, T = 8192, D = 1024, M = BATCH * T, DFF = 2816, NMODS = 9 * D, INC = 8224;
constexpr float EPS = 1e-6f, LOG2E = 1.4426950408889634f;
constexpr float C2 = 0.125f * LOG2E;
constexpr float QA_SCALE = 0.08838834764831845f;

constexpr size_t MiB = 1u << 20;
constexpr size_t WS_CTL = 0;
constexpr size_t WS_WIN1 = 1 * MiB;
constexpr size_t WS_WIN2 = 11 * MiB;
constexpr size_t WS_WPA = 17 * MiB, WS_WPB = 19 * MiB, WS_WOUT = 21 * MiB;
constexpr size_t WS_MODS = 23 * MiB;
constexpr size_t WS_MODP = 23 * MiB + 128 * 1024;
constexpr size_t WS_DEC = 23 * MiB + 768 * 1024;
constexpr size_t WS_KMAX = 23 * MiB + 896 * 1024;
constexpr size_t WS_QMAX = 23 * MiB + 912 * 1024;
constexpr size_t WS_ALOW = 24 * MiB;
constexpr size_t WS_LOGF = 25 * MiB;
constexpr size_t WS_FCUM = 26 * MiB;
constexpr size_t WS_XN = 27 * MiB;
constexpr size_t WS_QA = 59 * MiB, WS_KA = 75 * MiB, WS_VA = 91 * MiB, WS_QB = 123 * MiB, WS_KB = 155 * MiB, WS_VB = 187 * MiB;
constexpr size_t WS_RA = 59 * MiB, WS_GA = 155 * MiB, WS_GB = 187 * MiB;
constexpr size_t WS_H = 59 * MiB;
constexpr size_t WS_Y = 147 * MiB;
constexpr size_t WS_Y2 = 59 * MiB;
constexpr size_t WS_WGU = 219 * MiB;
constexpr size_t WS_WDN = 230 * MiB;
constexpr size_t WS_U = 219 * MiB;
constexpr int LDS_BYTES = 147456;

struct Params { const float* in[18]; float* out; unsigned char* ws; };
enum { I_X = 0, I_C, I_WADA, I_BADA, I_GPRE, I_GPOST, I_WGU1, I_WDN1, I_WGU2, I_WDN2, I_WIN, I_WA2, I_BA, I_BF, I_GGLA, I_WPA, I_WPB, I_WOUT };

DEVI float bf2f(bf16_t v) { return __uint_as_float((unsigned)v << 16); }
DEVI unsigned f2bf(float f) { unsigned u = __float_as_uint(f); return (u + 0x7fffu + ((u >> 16) & 1u)) >> 16; }
DEVI unsigned pk2(float lo, float hi) { return f2bf(lo) | (f2bf(hi) << 16); }
DEVI float wave_sum(float v) {
#pragma unroll
    for (int o = 1; o < 64; o <<= 1) v += __shfl_xor(v, o);
    return v;
}
DEVI float sigmoid_f(float x) { return 1.f / (1.f + __expf(-x)); }
DEVI float silu_f(float x) { return x / (1.f + __expf(-x)); }
DEVI float logsigmoid_f(float x) { return fminf(x, 0.f) - log1pf(__expf(-fabsf(x))); }
DEVI void unpack8(const u32x4 v, float* f) {
    f[0] = __uint_as_float(v.x << 16); f[1] = __uint_as_float(v.x & 0xffff0000u);
    f[2] = __uint_as_float(v.y << 16); f[3] = __uint_as_float(v.y & 0xffff0000u);
    f[4] = __uint_as_float(v.z << 16); f[5] = __uint_as_float(v.z & 0xffff0000u);
    f[6] = __uint_as_float(v.w << 16); f[7] = __uint_as_float(v.w & 0xffff0000u);
}

DEVI void transpose_item(const float* W, int K, int N, int k0, int srcn0, bf16_t* WT, int dstrow0, float* scr, int lane) {
#pragma unroll 8
    for (int i = 0; i < 32; ++i) { const int kk = 2 * i + (lane >> 5); scr[kk * 33 + (lane & 31)] = W[(size_t)(k0 + kk) * N + srcn0 + (lane & 31)]; }
    __builtin_amdgcn_s_waitcnt(0); __builtin_amdgcn_wave_barrier();
    const int c = lane & 7;
#pragma unroll
    for (int j = 0; j < 4; ++j) { const int n = (lane >> 3) + 8 * j; const float* s = scr + (8 * c) * 33 + n;
        u32x4 o; o.x = pk2(s[0 * 33], s[1 * 33]); o.y = pk2(s[2 * 33], s[3 * 33]); o.z = pk2(s[4 * 33], s[5 * 33]); o.w = pk2(s[6 * 33], s[7 * 33]);
        *(u32x4*)(WT + (size_t)(dstrow0 + n) * K + k0 + 8 * c) = o; }
    __builtin_amdgcn_s_waitcnt(0); __builtin_amdgcn_wave_barrier();
}
DEVI int src_win1(int r) { return r < 2048 ? r : r + 1040; }
DEVI int src_win2(int r) { return r < 1024 ? r + 2064 : r + 5152; }
DEVI int src_gu(int r) { const int t = r >> 8, w = r & 255; return w < 128 ? 128 * t + w : DFF + 128 * t + (w - 128); }

DEVI void convert_ffn_weights(const Params& p, unsigned char* lds, const float* wgu, const float* wdn) {
    const int lane = threadIdx.x & 63, wave = threadIdx.x >> 6;
    float* scr = (float*)(lds + wave * 16384);
    const int gw = blockIdx.x * 8 + wave, NGW = gridDim.x * 8;
    bf16_t* WGU = (bf16_t*)(p.ws + WS_WGU); bf16_t* WDN = (bf16_t*)(p.ws + WS_WDN);
    constexpr int I_GU = 16 * 176, I_DN = 44 * 32;
    for (int it = gw; it < I_GU + I_DN; it += NGW) {
        if (it < I_GU) { const int kb = it / 176, nb = it % 176; transpose_item(wgu, D, 2 * DFF, 64 * kb, src_gu(32 * nb), WGU, 32 * nb, scr, lane); }
        else { const int r = it - I_GU, kb = r / 32, nb = r % 32; transpose_item(wdn, DFF, D, 64 * kb, 32 * nb, WDN, 32 * nb, scr, lane); }
    }
}

DEVI void ph_prologue(const Params& p, unsigned char* lds) {
    const int tid = threadIdx.x, lane = tid & 63, wave = tid >> 6;
    float* sc = (float*)lds;
    for (int v = tid; v < 2 * D; v += 512) sc[v] = silu_f(p.in[I_C][v]);
    __syncthreads();
    {
        const int g = blockIdx.x * 512 + tid;
        if (g < 8 * NMODS) {
            const int ks = g / NMODS, j = g % NMODS; const float* w = p.in[I_WADA] + (size_t)(ks * 128) * NMODS + j;
            float s0 = 0.f, s1 = 0.f;
#pragma unroll 8
            for (int i = 0; i < 128; ++i) { const float wv = w[(size_t)i * NMODS]; s0 += sc[ks * 128 + i] * wv; s1 += sc[D + ks * 128 + i] * wv; }
            float* mp = (float*)(p.ws + WS_MODP);
            mp[(ks * 2 + 0) * NMODS + j] = s0; mp[(ks * 2 + 1) * NMODS + j] = s1;
        }
    }
    __syncthreads();
    for (int v = blockIdx.x * 512 + tid; v < 32 * 128 + 32 * 32; v += gridDim.x * 512) ((unsigned*)(p.ws + WS_KMAX))[v] = 0u;
    float* scr = (float*)(lds + wave * 16384);
    const int gw = blockIdx.x * 8 + wave, NGW = gridDim.x * 8;
    constexpr int I_W1 = 16 * 160, I_W2 = 16 * 96, I_P = 16 * 32;
    const float* win = p.in[I_WIN];
    for (int it = gw; it < I_W1 + I_W2 + 3 * I_P; it += NGW) {
        int r = it;
        if (r < I_W1) { const int kb = r / 160, nb = r % 160; transpose_item(win, D, INC, 64 * kb, src_win1(32 * nb), (bf16_t*)(p.ws + WS_WIN1), 32 * nb, scr, lane); continue; } r -= I_W1;
        if (r < I_W2) { const int kb = r / 96, nb = r % 96; transpose_item(win, D, INC, 64 * kb, src_win2(32 * nb), (bf16_t*)(p.ws + WS_WIN2), 32 * nb, scr, lane); continue; } r -= I_W2;
        const int w = r / I_P, q = r % I_P, kb = q / 32, nb = q % 32;
        const float* src = p.in[w == 0 ? I_WPA : (w == 1 ? I_WPB : I_WOUT)]; bf16_t* dst = (bf16_t*)(p.ws + (w == 0 ? WS_WPA : (w == 1 ? WS_WPB : WS_WOUT)));
        transpose_item(src, D, D, 64 * kb, 32 * nb, dst, 32 * nb, scr, lane);
    }
    convert_ffn_weights(p, lds, p.in[I_WGU1], p.in[I_WDN1]);
}

DEVI void ph_mods_xn1(const Params& p, unsigned char* lds) {
    const int tid = threadIdx.x, lane = tid & 63, wave = tid >> 6;
    const float* mp = (const float*)(p.ws + WS_MODP); float* mods = (float*)(p.ws + WS_MODS); const float* bada = p.in[I_BADA];
    for (int v = blockIdx.x * 512 + tid; v < 2 * NMODS; v += gridDim.x * 512) { const int b = v / NMODS, j = v % NMODS; float s = bada[j];
#pragma unroll
        for (int ks = 0; ks < 8; ++ks) s += mp[(ks * 2 + b) * NMODS + j];
        mods[v] = s; }
    float* lm = (float*)lds;
    for (int v = tid; v < 4096; v += 512) { const int b = v >> 11, j = v & 2047; float s = bada[j];
#pragma unroll
        for (int ks = 0; ks < 8; ++ks) s += mp[(ks * 2 + b) * NMODS + j];
        lm[v] = s; }
    __syncthreads();
    const int gw = blockIdx.x * 8 + wave, NGW = gridDim.x * 8;
    const float* gpre = p.in[I_GPRE]; bf16_t* XN = (bf16_t*)(p.ws + WS_XN);
    for (int m = gw; m < M; m += NGW) {
        const int b = m >> 13; const f32x4* xr = (const f32x4*)(p.in[I_X] + (size_t)m * D) + lane;
        f32x4 v[4]; float ss = 0.f;
#pragma unroll
        for (int j = 0; j < 4; ++j) { v[j] = xr[64 * j]; ss += (v[j].x * v[j].x + v[j].y * v[j].y) + (v[j].z * v[j].z + v[j].w * v[j].w); }
        const float rstd = rsqrtf(wave_sum(ss) * (1.f / D) + EPS);
        u32x2* o8 = (u32x2*)(XN + (size_t)m * D) + lane;
#pragma unroll
        for (int j = 0; j < 4; ++j) { const int col = 4 * lane + 256 * j; const f32x4 g = *(const f32x4*)(gpre + col);
            const f32x4 sh = *(const f32x4*)(lm + b * 2048 + col), s1 = *(const f32x4*)(lm + b * 2048 + 1024 + col);
            const f32x4 h = v[j] * rstd * g * (1.f + s1) + sh; u32x2 w; w.x = pk2(h.x, h.y); w.y = pk2(h.z, h.w); o8[64 * j] = w; }
    }
}

DEVI void ph_norm_res(const Params& p, const float* Y, const float* xin, float* xout, bool mk_xn, int sub  , float gs) {
    const int tid = threadIdx.x, lane = tid & 63, wave = tid >> 6;
    const int gw = blockIdx.x * 8 + wave, NGW = gridDim.x * 8;
    const float* mods = (const float*)(p.ws + WS_MODS); const float* gpost = p.in[I_GPOST] + sub * D; const float* gpre = p.in[I_GPRE] + (sub + 1) * D;
    bf16_t* XN = (bf16_t*)(p.ws + WS_XN);
    for (int m = gw; m < M; m += NGW) {
        const int b = m >> 13; const float* mb = mods + b * NMODS;
        const f32x4* yr = (const f32x4*)(Y + (size_t)m * D) + lane; const f32x4* xr = (const f32x4*)(xin + (size_t)m * D) + lane; f32x4* xo = (f32x4*)(xout + (size_t)m * D) + lane;
        f32x4 y[4]; float ss = 0.f;
#pragma unroll
        for (int j = 0; j < 4; ++j) { y[j] = yr[64 * j]; ss += (y[j].x * y[j].x + y[j].y * y[j].y) + (y[j].z * y[j].z + y[j].w * y[j].w); }
        const float rstd = rsqrtf(wave_sum(ss) * (1.f / D) + EPS); float s2 = 0.f;
#pragma unroll
        for (int j = 0; j < 4; ++j) { const int col = 4 * lane + 256 * j; const f32x4 g = *(const f32x4*)(gpost + col), gt = *(const f32x4*)(mb + (3 * sub + 2) * D + col);
            const f32x4 xn = xr[64 * j] + gs * gt * (y[j] * rstd * g); xo[64 * j] = xn; y[j] = xn; s2 += (xn.x * xn.x + xn.y * xn.y) + (xn.z * xn.z + xn.w * xn.w); }
        if (mk_xn) {
            const float r2 = rsqrtf(wave_sum(s2) * (1.f / D) + EPS); u32x2* o8 = (u32x2*)(XN + (size_t)m * D) + lane;
#pragma unroll
            for (int j = 0; j < 4; ++j) { const int col = 4 * lane + 256 * j; const f32x4 g = *(const f32x4*)(gpre + col);
                const f32x4 sh = *(const f32x4*)(mb + (3 * sub + 3) * D + col), s1 = *(const f32x4*)(mb + (3 * sub + 4) * D + col);
                const f32x4 h = y[j] * r2 * g * (1.f + s1) + sh; u32x2 w; w.x = pk2(h.x, h.y); w.y = pk2(h.z, h.w); o8[64 * j] = w; }
        }
    }
}

template <bool DUAL, class Epi>
DEVI void gemm_simple(unsigned char* lds, const bf16_t* A, const bf16_t* Bt, int Mrows, int Nlog, int K, const Epi& E) {
    float* As = (float*)lds; float* Bs = As + 32 * 132;
    const int tid = threadIdx.x, ty = tid >> 4, tx = tid & 15;
    const int LC = DUAL ? 64 : 128, ntn = Nlog / LC, ntiles = (Mrows / 128) * ntn;
    for (int tile = blockIdx.x; tile < ntiles; tile += gridDim.x) {
        const int tm = tile / ntn, tn = tile % ntn;
        float acc[4][8];
#pragma unroll
        for (int i = 0; i < 4; ++i)
#pragma unroll
            for (int j = 0; j < 8; ++j) acc[i][j] = 0.f;
        const int lr = tid >> 2, kc = (tid & 3) * 8;
        const int brow = DUAL ? ((tn >> 1) * 256 + (lr >= 64 ? 128 : 0) + (tn & 1) * 64 + (lr & 63)) : tn * 128 + lr;
        const bf16_t* ap = A + (size_t)(tm * 128 + lr) * K + kc; const bf16_t* bp = Bt + (size_t)brow * K + kc;
        for (int k0 = 0; k0 < K; k0 += 32) {
            float fa[8], fb[8]; unpack8(*(const u32x4*)(ap + k0), fa); unpack8(*(const u32x4*)(bp + k0), fb);
            __syncthreads();
#pragma unroll
            for (int i = 0; i < 8; ++i) { As[(kc + i) * 132 + lr] = fa[i]; Bs[(kc + i) * 132 + lr] = fb[i]; }
            __syncthreads();
#pragma unroll 8
            for (int kk = 0; kk < 32; ++kk) {
                const f32x4 a = *(const f32x4*)(As + kk * 132 + 4 * ty), b0 = *(const f32x4*)(Bs + kk * 132 + 4 * tx), b1 = *(const f32x4*)(Bs + kk * 132 + 64 + 4 * tx);
#pragma unroll
                for (int i = 0; i < 4; ++i) { acc[i][0] += a[i] * b0[0]; acc[i][1] += a[i] * b0[1]; acc[i][2] += a[i] * b0[2]; acc[i][3] += a[i] * b0[3];
                    acc[i][4] += a[i] * b1[0]; acc[i][5] += a[i] * b1[1]; acc[i][6] += a[i] * b1[2]; acc[i][7] += a[i] * b1[3]; }
            }
        }
#pragma unroll
        for (int i = 0; i < 4; ++i) { const int row = tm * 128 + 4 * ty + i;
            const f32x4 v0 = {acc[i][0], acc[i][1], acc[i][2], acc[i][3]}, v1 = {acc[i][4], acc[i][5], acc[i][6], acc[i][7]};
            if (DUAL) E(row, tn * 64 + 4 * tx, v0, v1);
            else { E(row, tn * 128 + 4 * tx, v0, v0); E(row, tn * 128 + 64 + 4 * tx, v1, v1); } }
    }
}

DEVI void st_bf4(bf16_t* p, f32x4 v) { u32x2 w; w.x = pk2(v.x, v.y); w.y = pk2(v.z, v.w); *(u32x2*)p = w; }
DEVI f32x4 ld_bf4(const bf16_t* p) { const u32x2 w = *(const u32x2*)p; return (f32x4){__uint_as_float(w.x << 16), __uint_as_float(w.x & 0xffff0000u), __uint_as_float(w.y << 16), __uint_as_float(w.y & 0xffff0000u)}; }
struct EpSwiglu { bf16_t* H; DEVI void operator()(int row, int col, f32x4 g, f32x4 u) const {
    f32x4 o; o.x = silu_f(g.x) * u.x; o.y = silu_f(g.y) * u.y; o.z = silu_f(g.z) * u.z; o.w = silu_f(g.w) * u.w; st_bf4(H + (size_t)row * DFF + col, o); } };
struct EpF32 { float* Y; DEVI void operator()(int row, int col, f32x4 v, f32x4) const { *(f32x4*)(Y + (size_t)row * D + col) = v; } };
struct EpWin1 { unsigned char* ws; DEVI void operator()(int row, int col, f32x4 v, f32x4) const {
    if (col < 512) st_bf4((bf16_t*)(ws + WS_QA) + (size_t)row * 512 + col, v * QA_SCALE);
    else if (col < 1024) st_bf4((bf16_t*)(ws + WS_KA) + (size_t)row * 512 + (col - 512), v);
    else if (col < 2048) st_bf4((bf16_t*)(ws + WS_VA) + (size_t)row * D + (col - 1024), v);
    else if (col < 3072) st_bf4((bf16_t*)(ws + WS_QB) + (size_t)row * D + (col - 2048), v * C2);
    else if (col < 4096) st_bf4((bf16_t*)(ws + WS_KB) + (size_t)row * D + (col - 3072), v);
    else st_bf4((bf16_t*)(ws + WS_VB) + (size_t)row * D + (col - 4096), v); } };
struct EpWin2 { unsigned char* ws; DEVI void operator()(int row, int col, f32x4 v, f32x4) const {
    if (col < 1024) { f32x4 o = {silu_f(v.x), silu_f(v.y), silu_f(v.z), silu_f(v.w)}; st_bf4((bf16_t*)(ws + WS_RA) + (size_t)row * D + col, o); }
    else { f32x4 o = {sigmoid_f(v.x), sigmoid_f(v.y), sigmoid_f(v.z), sigmoid_f(v.w)}; st_bf4((bf16_t*)(ws + (col < 2048 ? WS_GA : WS_GB)) + (size_t)row * D + (col & 1023), o); } } };
struct EpPa { bf16_t* GA; DEVI void operator()(int row, int col, f32x4 v, f32x4) const { bf16_t* q = GA + (size_t)row * D + col; st_bf4(q, ld_bf4(q) * v); } };
struct EpPb { const bf16_t* Tm; bf16_t* GB; DEVI void operator()(int row, int col, f32x4 v, f32x4) const { bf16_t* q = GB + (size_t)row * D + col; st_bf4(q, ld_bf4(Tm + (size_t)row * D + col) + ld_bf4(q) * v); } };

DEVI void ph_thin_cols(const Params& p) {
    const bf16_t* XN = (const bf16_t*)(p.ws + WS_XN); const float* win = p.in[I_WIN]; const float* bf = p.in[I_BF];
    float* alow = (float*)(p.ws + WS_ALOW); float* logf = (float*)(p.ws + WS_LOGF);
    for (int v = blockIdx.x * 512 + threadIdx.x; v < M * 32; v += gridDim.x * 512) {
        const int m = v >> 5, j = v & 31, col = j < 16 ? 2048 + j : 6160 + (j - 16);
        const bf16_t* xr = XN + (size_t)m * D; const float* w = win + col; float s = 0.f;
        for (int k = 0; k < D; k += 8) { float f[8]; unpack8(*(const u32x4*)(xr + k), f);
#pragma unroll
            for (int i = 0; i < 8; ++i) s += f[i] * w[(size_t)(k + i) * INC]; }
        if (j < 16) alow[m * 16 + j] = s; else logf[(size_t)((m >> 13) * 16 + (j - 16)) * T + (m & (T - 1))] = logsigmoid_f(s + bf[j - 16]);
    }
}
DEVI void ph_fcum(const Params& p, unsigned char* lds) {
    const int tid = threadIdx.x, lane = tid & 63, wave = tid >> 6;
    double* wt = (double*)lds;
    for (int bh = blockIdx.x; bh < 32; bh += gridDim.x) {
        const float* lf = (const float*)(p.ws + WS_LOGF) + (size_t)bh * T + tid * 16; float* fc = (float*)(p.ws + WS_FCUM) + (size_t)bh * T + tid * 16;
        f32x4 v[4]; double s = 0.0;
#pragma unroll
        for (int i = 0; i < 4; ++i) { v[i] = ((const f32x4*)lf)[i]; s += ((double)v[i].x + (double)v[i].y) + ((double)v[i].z + (double)v[i].w); }
        double incl = s;
#pragma unroll
        for (int o = 1; o < 64; o <<= 1) { const double t = __shfl_up(incl, o); if (lane >= o) incl += t; }
        __syncthreads();
        if (lane == 63) wt[wave] = incl;
        __syncthreads();
        double run = incl - s;
        for (int w = 0; w < wave; ++w) run += wt[w];
#pragma unroll
        for (int i = 0; i < 4; ++i) { f32x4 o; run += (double)v[i].x; o.x = (float)run; run += (double)v[i].y; o.y = (float)run; run += (double)v[i].z; o.z = (float)run; run += (double)v[i].w; o.w = (float)run; ((f32x4*)fc)[i] = o; }
    }
    __syncthreads();
}
DEVI void ph_qk_norms(const Params& p) {
    const int lane = threadIdx.x & 63, gw = blockIdx.x * 8 + (threadIdx.x >> 6), NGW = gridDim.x * 8;
    const bf16_t* QB = (const bf16_t*)(p.ws + WS_QB); const bf16_t* KB = (const bf16_t*)(p.ws + WS_KB);
    unsigned* kmax = (unsigned*)(p.ws + WS_KMAX); unsigned* qmax = (unsigned*)(p.ws + WS_QMAX);
    for (int g = gw; g < M / 8; g += NGW) {
        float qm = 0.f, km = 0.f;
        for (int r = 0; r < 8; ++r) { const size_t off = (size_t)(g * 8 + r) * D + 16 * lane; float f[16];
            unpack8(*(const u32x4*)(QB + off), f); unpack8(*(const u32x4*)(QB + off + 8), f + 8); float sq = 0.f;
#pragma unroll
            for (int i = 0; i < 16; ++i) sq += f[i] * f[i];
            unpack8(*(const u32x4*)(KB + off), f); unpack8(*(const u32x4*)(KB + off + 8), f + 8); float sk = 0.f;
#pragma unroll
            for (int i = 0; i < 16; ++i) sk += f[i] * f[i];
            sq += __shfl_xor(sq, 1); sq += __shfl_xor(sq, 2); sk += __shfl_xor(sk, 1); sk += __shfl_xor(sk, 2);
            qm = fmaxf(qm, sq); km = fmaxf(km, sk); }
        if ((lane & 3) == 0) { const int row0 = g * 8, b = row0 >> 13, t = row0 & (T - 1), bh = b * 16 + (lane >> 2);
            atomicMax(kmax + bh * 128 + (t >> 6), __float_as_uint(km)); atomicMax(qmax + bh * 32 + (t >> 8), __float_as_uint(qm)); }
    }
}

template <bool OUT>
DEVI void gla_rec(const Params& p, unsigned char* lds, int unit) {
    const int j = unit & 31, bh = unit >> 5, h = bh & 3, b = bh >> 2;
    const int tid = threadIdx.x, e = tid & 255, dh = tid >> 8, d0 = dh * 64;
    float* qs = (float*)lds; float* ks = qs + 2048; float* al = ks + 2048; float* vs = al + 2048; float* red = vs + 4096; float* lsum = red + 8192;
    float* U = (float*)(p.ws + WS_U) + (size_t)unit * 32768;
    const bf16_t* QA = (const bf16_t*)(p.ws + WS_QA); const bf16_t* KA = (const bf16_t*)(p.ws + WS_KA); bf16_t* VA = (bf16_t*)(p.ws + WS_VA);
    const float* alow = (const float*)(p.ws + WS_ALOW);
    float S[64];
#pragma unroll
    for (int i = 0; i < 64; ++i) S[i] = OUT ? U[(d0 + i) * 256 + e] : 0.f;
    const int dd = tid & 127, tq = tid >> 7;
    float wa[16];
#pragma unroll
    for (int r = 0; r < 16; ++r) wa[r] = p.in[I_WA2][r * 512 + h * 128 + dd];
    const float ba = p.in[I_BA][h * 128 + dd];
    float lacc = 0.f;
    for (int sb = 0; sb < 16; ++sb) {
        const int t0 = b * T + j * 256 + sb * 16;
#pragma unroll
        for (int r = 0; r < 4; ++r) { const int tt = tq + 4 * r; const size_t row = (size_t)(t0 + tt);
            const f32x4* ar = (const f32x4*)(alow + row * 16); float s = ba;
#pragma unroll
            for (int q4 = 0; q4 < 4; ++q4) { const f32x4 a = ar[q4]; s += a.x * wa[4 * q4] + a.y * wa[4 * q4 + 1] + a.z * wa[4 * q4 + 2] + a.w * wa[4 * q4 + 3]; }
            const float la = logsigmoid_f(s) * (1.f / 16.f); lacc += la; al[tt * 128 + dd] = __expf(la);
            qs[tt * 128 + dd] = bf2f(QA[row * 512 + h * 128 + dd]); ks[tt * 128 + dd] = bf2f(KA[row * 512 + h * 128 + dd]); }
#pragma unroll
        for (int r = 0; r < 8; ++r) { const int idx = tid + 512 * r, tt = idx >> 8, ee = idx & 255; vs[idx] = bf2f(VA[(size_t)(t0 + tt) * D + h * 256 + ee]); }
        __syncthreads();
        for (int tt = 0; tt < 16; ++tt) {
            const float v = vs[tt * 256 + e]; float acc = 0.f;
            const float* alp = al + tt * 128 + d0; const float* kp = ks + tt * 128 + d0; const float* qp = qs + tt * 128 + d0;
#pragma unroll
            for (int i = 0; i < 64; ++i) { S[i] = alp[i] * S[i] + kp[i] * v; if (OUT) acc += qp[i] * S[i]; }
            if (OUT) red[(tt * 2 + dh) * 256 + e] = acc;
        }
        __syncthreads();
        if (OUT) {
#pragma unroll
            for (int r = 0; r < 8; ++r) { const int idx = tid + 512 * r, tt = idx >> 8, ee = idx & 255;
                VA[(size_t)(t0 + tt) * D + h * 256 + ee] = (bf16_t)f2bf(red[(tt * 2) * 256 + ee] + red[(tt * 2 + 1) * 256 + ee]); }
        }
    }
    if (!OUT) {
#pragma unroll
        for (int i = 0; i < 64; ++i) U[(d0 + i) * 256 + e] = S[i];
        lsum[tq * 128 + dd] = lacc; __syncthreads();
        if (tid < 128) ((float*)(p.ws + WS_DEC))[unit * 128 + tid] = __expf(lsum[tid] + lsum[128 + tid] + lsum[256 + tid] + lsum[384 + tid]);
    }
    __syncthreads();
}
DEVI void ph_gla_scan(const Params& p) {
    float* U = (float*)(p.ws + WS_U); const float* dec = (const float*)(p.ws + WS_DEC);
    for (int v = blockIdx.x * 512 + threadIdx.x; v < 8 * 32768; v += gridDim.x * 512) {
        const int bh = v >> 15, de = v & 32767, d = de >> 8; float s = 0.f;
        for (int j = 0; j < 32; ++j) { const int unit = bh * 32 + j; float* q = U + (size_t)unit * 32768 + de; const float u = *q; *q = s; s = dec[unit * 128 + d] * s + u; }
    }
}
DEVI void ph_oa_norm(const Params& p) {
    const int lane = threadIdx.x & 63, gw = blockIdx.x * 8 + (threadIdx.x >> 6), NGW = gridDim.x * 8;
    bf16_t* OA = (bf16_t*)(p.ws + WS_VA); const bf16_t* RA = (const bf16_t*)(p.ws + WS_RA); const float* gg = p.in[I_GGLA];
    for (int m = gw; m < M; m += NGW) {
        bf16_t* op = OA + (size_t)m * D + 16 * lane; const bf16_t* rp = RA + (size_t)m * D + 16 * lane;
        float o[16], r[16]; unpack8(*(const u32x4*)op, o); unpack8(*(const u32x4*)(op + 8), o + 8); unpack8(*(const u32x4*)rp, r); unpack8(*(const u32x4*)(rp + 8), r + 8);
        float ss = 0.f;
#pragma unroll
        for (int i = 0; i < 16; ++i) ss += o[i] * o[i];
        ss += __shfl_xor(ss, 1); ss += __shfl_xor(ss, 2); ss += __shfl_xor(ss, 4); ss += __shfl_xor(ss, 8);
        const float rstd = rsqrtf(ss * (1.f / 256.f) + EPS);
        u32x4 w0, w1; float t[16];
#pragma unroll
        for (int i = 0; i < 16; ++i) t[i] = o[i] * rstd * gg[16 * lane + i] * r[i];
        w0.x = pk2(t[0], t[1]); w0.y = pk2(t[2], t[3]); w0.z = pk2(t[4], t[5]); w0.w = pk2(t[6], t[7]);
        w1.x = pk2(t[8], t[9]); w1.y = pk2(t[10], t[11]); w1.z = pk2(t[12], t[13]); w1.w = pk2(t[14], t[15]);
        *(u32x4*)op = w0; *(u32x4*)(op + 8) = w1;
    }
}

DEVI void attn_simple_unit(const Params& p, unsigned char* lds, int unit) {
    const int qb = 15 - (unit >> 5), bh = unit & 31, b = bh >> 4, hh = bh & 15;
    float* Ks = (float*)lds; float* Vs = Ks + 4096; float* bs = Vs + 4096;
    const int tid = threadIdx.x, t = qb * 512 + tid; const size_t row = (size_t)(b * T + t);
    bf16_t* QB = (bf16_t*)(p.ws + WS_QB); const bf16_t* KB = (const bf16_t*)(p.ws + WS_KB); const bf16_t* VB = (const bf16_t*)(p.ws + WS_VB);
    const float* fc = (const float*)(p.ws + WS_FCUM) + (size_t)bh * T;
    float q[64], o[64];
#pragma unroll
    for (int i = 0; i < 8; ++i) unpack8(*(const u32x4*)(QB + row * D + hh * 64 + 8 * i), q + 8 * i);
#pragma unroll
    for (int i = 0; i < 64; ++i) o[i] = 0.f;
    float mx = -1e30f, l = 0.f; const float Fq0 = fc[qb * 512];
    const int nkt = (qb * 512 + 512) / 64;
    for (int kt = 0; kt < nkt; ++kt) {
        __syncthreads();
        { const int key = tid >> 3, c = (tid & 7) * 8; const size_t g = (size_t)(b * T + kt * 64 + key) * D + hh * 64 + c;
          unpack8(*(const u32x4*)(KB + g), Ks + key * 64 + c); unpack8(*(const u32x4*)(VB + g), Vs + key * 64 + c); }
        if (tid < 64) bs[tid] = (Fq0 - fc[kt * 64 + tid]) * LOG2E;
        __syncthreads();
        const int smax = t - kt * 64;
        for (int s = 0; s < 64; ++s) {
            if (s <= smax) {
                float sc = bs[s]; const float* kr = Ks + s * 64;
#pragma unroll
                for (int i = 0; i < 64; ++i) sc += q[i] * kr[i];
                if (sc > mx + 8.f) { const float f = exp2f(mx - sc); l *= f;
#pragma unroll
                    for (int i = 0; i < 64; ++i) o[i] *= f;
                    mx = sc; }
                const float pr = exp2f(sc - mx); l += pr; const float* vr = Vs + s * 64;
#pragma unroll
                for (int i = 0; i < 64; ++i) o[i] += pr * vr[i];
            }
        }
    }
    const float inv = 1.f / l;
#pragma unroll
    for (int i = 0; i < 8; ++i) { u32x4 w; w.x = pk2(o[8 * i] * inv, o[8 * i + 1] * inv); w.y = pk2(o[8 * i + 2] * inv, o[8 * i + 3] * inv); w.z = pk2(o[8 * i + 4] * inv, o[8 * i + 5] * inv); w.w = pk2(o[8 * i + 6] * inv, o[8 * i + 7] * inv);
        *(u32x4*)(QB + row * D + hh * 64 + 8 * i) = w; }
    __syncthreads();
}

namespace pg8 {
#define PG8_LAS __attribute__((address_space(3)))
typedef unsigned short bf16_t;
typedef short bf16x8 __attribute__((ext_vector_type(8)));
typedef float f32x4 __attribute__((ext_vector_type(4)));
typedef unsigned u32x4 __attribute__((ext_vector_type(4)));
constexpr int BM = 256, BK = 64, HALF = 128, HTB = HALF * BK * 2  , STAGE_BYTES = 8 * HTB, NXCD = 8, WGM = 8;

__host__ __device__ __forceinline__ int lds_byte(int r, int c) { const int st = (r >> 4) * 2 + (c >> 5), rr = r & 15, cc = c & 31, ob = rr * 64 + cc * 2; return st * 1024 + (ob ^ (((ob >> 9) & 1) << 5)); }
__host__ __device__ __forceinline__ void stage_rc(int b, int& R, int& C) { const int st = b / 1024, sb = b % 1024, swz = sb ^ (((sb >> 9) & 1) << 5); R = (st >> 1) * 16 + swz / 64; C = (st & 1) * 32 + (swz % 64) / 2; }
__host__ __device__ __forceinline__ int perm32(int rho) { const int n = rho >> 4, i = rho & 15; return 8 * (i >> 2) + 4 * n + (i & 3); }

struct Unit { int pm, pn; };
struct Gemm { const bf16_t* A; const bf16_t* Bt; int M, N, K; };

struct StaticOrder {
    int nM, nN, nwg, G, c;
    __host__ __device__ void init(int M, int N, int G_, int c_) { nM = M / BM; nN = N / BM; nwg = nM * nN; G = G_; c = c_; }
    __host__ __device__ bool next(int i, Unit& u) const {
        const long L = (long)i * G + c; if (L >= nwg) return false;
        int wgid = (int)L; { const int q = nwg / NXCD, r = nwg % NXCD, xcd = wgid % NXCD, off = wgid / NXCD; wgid = (xcd < r ? xcd * (q + 1) : r * (q + 1) + (xcd - r) * q) + off; }
        const int nig = WGM * nN, gid = wgid / nig, fm = gid * WGM, gsz = (nM - fm) < WGM ? (nM - fm) : WGM;
        u.pm = fm + ((wgid % nig) % gsz); u.pn = (wgid % nig) / gsz; return true;
    }
    __device__ __forceinline__ void a_ready(const Unit&) const {}
    __device__ __forceinline__ void done(const Unit&) const {}
};

__device__ __forceinline__ unsigned cvt_pk_bf16(float lo, float hi) { unsigned r; asm volatile("v_cvt_pk_bf16_f32 %0, %1, %2" : "=v"(r) : "v"(lo), "v"(hi)); return r; }
typedef float f32x2 __attribute__((ext_vector_type(2)));

__device__ __forceinline__ float silu_fast(float x) { return x * __builtin_amdgcn_rcpf(1.f + __expf(-x)); }
__device__ __forceinline__ float sigm_fast(float x) { return __builtin_amdgcn_rcpf(1.f + __expf(-x)); }
__device__ __forceinline__ u32x4 pack8(const f32x4 a, const f32x4 b) { u32x4 w; w.x = cvt_pk_bf16(a[0], a[1]); w.y = cvt_pk_bf16(a[2], a[3]); w.z = cvt_pk_bf16(b[0], b[1]); w.w = cvt_pk_bf16(b[2], b[3]); return w; }
__device__ __forceinline__ void unpack8v(const u32x4 v, f32x4& a, f32x4& b) {
    a[0] = __uint_as_float(v.x << 16); a[1] = __uint_as_float(v.x & 0xffff0000u); a[2] = __uint_as_float(v.y << 16); a[3] = __uint_as_float(v.y & 0xffff0000u);
    b[0] = __uint_as_float(v.z << 16); b[1] = __uint_as_float(v.z & 0xffff0000u); b[2] = __uint_as_float(v.w << 16); b[3] = __uint_as_float(v.w & 0xffff0000u); }
struct EpiSwiglu { static constexpr bool PERM = true, AFTER_DRAIN = false; bf16_t* H; int ldh;
    __device__ __forceinline__ void operator()(const f32x4 (&acc)[2][2][4][2], const Unit& u, int wr, int wc, int fr, int fq) const {
        const int row0 = u.pm * BM + wr * 64 + fr, col0 = u.pn * HALF + wc * 32 + 8 * fq;
#pragma unroll
        for (int ai = 0; ai < 2; ++ai)
#pragma unroll
            for (int m = 0; m < 4; ++m) { f32x4 o0, o1;
#pragma unroll
                for (int i = 0; i < 4; ++i) { o0[i] = silu_fast(acc[ai][0][m][0][i]) * acc[ai][1][m][0][i]; o1[i] = silu_fast(acc[ai][0][m][1][i]) * acc[ai][1][m][1][i]; }
                *(u32x4*)(H + (size_t)(row0 + ai * HALF + m * 16) * ldh + col0) = pack8(o0, o1); }
    }
};
struct Seg { bf16_t* base; int ld, colt, act; float sc; };
struct EpiSeg { static constexpr bool PERM = true, AFTER_DRAIN = false; unsigned char* ws; int which;
    __device__ __forceinline__ Seg seg(int pn) const { Seg s; s.sc = 1.f; s.act = 0;
        if (which == 0) {
            if (pn < 2) { s.base = (bf16_t*)(ws + WS_QA); s.ld = 512; s.colt = pn * 256; s.sc = QA_SCALE; }
            else if (pn < 4) { s.base = (bf16_t*)(ws + WS_KA); s.ld = 512; s.colt = (pn - 2) * 256; }
            else if (pn < 8) { s.base = (bf16_t*)(ws + WS_VA); s.ld = 1024; s.colt = (pn - 4) * 256; }
            else if (pn < 12) { s.base = (bf16_t*)(ws + WS_QB); s.ld = 1024; s.colt = (pn - 8) * 256; s.sc = C2; }
            else if (pn < 16) { s.base = (bf16_t*)(ws + WS_KB); s.ld = 1024; s.colt = (pn - 12) * 256; }
            else { s.base = (bf16_t*)(ws + WS_VB); s.ld = 1024; s.colt = (pn - 16) * 256; }
        } else {
            s.ld = 1024; s.colt = (pn & 3) * 256;
            if (pn < 4) { s.base = (bf16_t*)(ws + WS_RA); s.act = 1; } else if (pn < 8) { s.base = (bf16_t*)(ws + WS_GA); s.act = 2; } else { s.base = (bf16_t*)(ws + WS_GB); s.act = 2; }
        }
        return s; }
    __device__ __forceinline__ void operator()(const f32x4 (&acc)[2][2][4][2], const Unit& u, int wr, int wc, int fr, int fq) const {
        const Seg s = seg(u.pn); const int row0 = u.pm * BM + wr * 64 + fr, col0 = s.colt + wc * 32 + 8 * fq;
#pragma unroll
        for (int ai = 0; ai < 2; ++ai)
#pragma unroll
            for (int m = 0; m < 4; ++m) { bf16_t* rowp = s.base + (size_t)(row0 + ai * HALF + m * 16) * s.ld + col0;
#pragma unroll
                for (int bj = 0; bj < 2; ++bj) { f32x4 v0 = acc[ai][bj][m][0], v1 = acc[ai][bj][m][1];
                    if (s.act == 1) {
#pragma unroll
                        for (int i = 0; i < 4; ++i) { v0[i] = silu_fast(v0[i]); v1[i] = silu_fast(v1[i]); } }
                    else if (s.act == 2) {
#pragma unroll
                        for (int i = 0; i < 4; ++i) { v0[i] = sigm_fast(v0[i]); v1[i] = sigm_fast(v1[i]); } }
                    else { v0 = v0 * s.sc; v1 = v1 * s.sc; }
                    *(u32x4*)(rowp + bj * HALF) = pack8(v0, v1); } }
    }
};
template <int MODE> struct EpiGate { static constexpr bool PERM = true, AFTER_DRAIN = false; bf16_t* G; const bf16_t* Tm;
    __device__ __forceinline__ void operator()(const f32x4 (&acc)[2][2][4][2], const Unit& u, int wr, int wc, int fr, int fq) const {
        const int row0 = u.pm * BM + wr * 64 + fr, col0 = u.pn * BM + wc * 32 + 8 * fq;
#pragma unroll
        for (int ai = 0; ai < 2; ++ai)
#pragma unroll
            for (int m = 0; m < 4; ++m) { const size_t off = (size_t)(row0 + ai * HALF + m * 16) * D + col0;
#pragma unroll
                for (int bj = 0; bj < 2; ++bj) { f32x4 g0, g1; unpack8v(*(const u32x4*)(G + off + bj * HALF), g0, g1);
                    f32x4 v0 = g0 * acc[ai][bj][m][0], v1 = g1 * acc[ai][bj][m][1];
                    if (MODE == 1) { f32x4 t0, t1; unpack8v(*(const u32x4*)(Tm + off + bj * HALF), t0, t1); v0 += t0; v1 += t1; }
                    *(u32x4*)(G + off + bj * HALF) = pack8(v0, v1); } }
    }
};
struct EpiF32 { static constexpr bool PERM = false, AFTER_DRAIN = false; float* Y;
    __device__ __forceinline__ void operator()(const f32x4 (&acc)[2][2][4][2], const Unit& u, int wr, int wc, int fr, int fq) const {
        const int row0 = u.pm * BM + wr * 64 + fr, col0 = u.pn * BM + wc * 32 + 4 * fq;
#pragma unroll
        for (int ai = 0; ai < 2; ++ai)
#pragma unroll
            for (int m = 0; m < 4; ++m) { float* rowp = Y + (size_t)(row0 + ai * HALF + m * 16) * D + col0;
#pragma unroll
                for (int bj = 0; bj < 2; ++bj)
#pragma unroll
                    for (int n = 0; n < 2; ++n) *(f32x4*)(rowp + bj * HALF + n * 16) = acc[ai][bj][m][n]; }
    }
};

template <class Epi, class Sched, bool ALIGN_EPI = false, bool SP2 = false>
__device__ __forceinline__ void gemm_phase(PG8_LAS unsigned char* lds, const Gemm g, const Sched& S, const Epi& E) {
    int tid_ = threadIdx.x; asm volatile("" : "+v"(tid_));
    const int tid = tid_, wid = __builtin_amdgcn_readfirstlane(tid >> 6), lane = tid & 63, wr = wid >> 2, wc = wid & 3, fr = lane & 15, fq = lane >> 4;
    const int K = g.K, nt = K / BK;
    unsigned voffA[2], voffB[2];
#pragma unroll
    for (int i = 0; i < 2; ++i) { int R, C; stage_rc(tid * 16 + i * 8192, R, C); const int Rb = Epi::PERM ? ((R & ~31) + perm32(R & 31)) : R;
        voffA[i] = (unsigned)(R * K + C) * 2u; voffB[i] = (unsigned)(Rb * K + C) * 2u; }
    const size_t kstep = (size_t)(BK * 2);
    const size_t hstep = (size_t)HALF * K * 2;
    const size_t tstep = 2 * hstep;
    const unsigned ldsw = (unsigned)wid * 1024u;
    const int aoff = lds_byte(wr * 64 + fr, fq * 8), boff = lds_byte(wc * 32 + fr, fq * 8);
#define PG8_SA(b, h) (((b) * 2 + (h)) * HTB)
#define PG8_SB(b, h) ((4 + (b) * 2 + (h)) * HTB)
#define PG8_STAGE(bufoff, gbase, voff) do { _Pragma("unroll") for (int _i = 0; _i < 2; ++_i) \
        __builtin_amdgcn_global_load_lds((const unsigned*)((const char*)(gbase) + (voff)[_i]), (PG8_LAS unsigned*)(lds + (bufoff) + ldsw + _i * 8192), 16, 0, 0); } while (0)
#define PG8_LDA(dst, b, h) do { _Pragma("unroll") for (int m = 0; m < 4; ++m) _Pragma("unroll") for (int k = 0; k < 2; ++k) dst[m][k] = *(const PG8_LAS bf16x8*)(lds + PG8_SA(b, h) + aoff + m * 2048 + k * 1024); } while (0)
#define PG8_LDB(dst, b, h) do { _Pragma("unroll") for (int n = 0; n < 2; ++n) _Pragma("unroll") for (int k = 0; k < 2; ++k) dst[n][k] = *(const PG8_LAS bf16x8*)(lds + PG8_SB(b, h) + boff + n * 2048 + k * 1024); } while (0)
#define PG8_MMA(ai, bj, At, Bt) do { __builtin_amdgcn_s_setprio(1); _Pragma("unroll") for (int m = 0; m < 4; ++m) _Pragma("unroll") for (int n = 0; n < 2; ++n) _Pragma("unroll") for (int k = 0; k < 2; ++k) \
        acc[ai][bj][m][n] = __builtin_amdgcn_mfma_f32_16x16x32_bf16(Bt[n][k], At[m][k], acc[ai][bj][m][n], 0, 0, 0); __builtin_amdgcn_s_setprio(0); } while (0)
#define PG8_WAIT_V(n) asm volatile("s_waitcnt vmcnt(" #n ")" ::: "memory")
#define PG8_WAIT_L(n) asm volatile("s_waitcnt lgkmcnt(" #n ")" ::: "memory")
#define PG8_BAR __builtin_amdgcn_s_barrier()
#define PG8_SCHED __builtin_amdgcn_sched_barrier(0)
    Unit cur, nxt; int ui = 0;
    if (!S.next(0, cur)) return;
    f32x4 acc[2][2][4][2];
#pragma unroll
    for (int a = 0; a < 2; ++a)
#pragma unroll
        for (int b = 0; b < 2; ++b)
#pragma unroll
            for (int m = 0; m < 4; ++m)
#pragma unroll
                for (int n = 0; n < 2; ++n) acc[a][b][m][n] = (f32x4){0.f, 0.f, 0.f, 0.f};
    bf16x8 At[4][2], B0[2][2], B1[2][2];
    const char* cA = (const char*)g.A + (size_t)cur.pm * tstep; const char* cB = (const char*)g.Bt + (size_t)cur.pn * tstep;
    S.a_ready(cur);
    if constexpr (SP2) {
        PG8_STAGE(PG8_SB(0, 0), cB, voffB); PG8_STAGE(PG8_SB(0, 1), cB + hstep, voffB); PG8_STAGE(PG8_SA(0, 0), cA, voffA); PG8_STAGE(PG8_SA(0, 1), cA + hstep, voffA);
        if (wr == 1) PG8_BAR;
        PG8_WAIT_V(2); PG8_BAR;
        PG8_STAGE(PG8_SB(1, 0), cB + kstep, voffB); PG8_STAGE(PG8_SA(1, 0), cA + kstep, voffA); PG8_STAGE(PG8_SB(1, 1), cB + hstep + kstep, voffB);
        PG8_WAIT_V(6); PG8_BAR;
    } else {
        PG8_STAGE(PG8_SB(0, 0), cB, voffB); PG8_STAGE(PG8_SA(0, 0), cA, voffA); PG8_STAGE(PG8_SB(0, 1), cB + hstep, voffB); PG8_STAGE(PG8_SA(0, 1), cA + hstep, voffA);
        if (wr == 1) PG8_BAR;
        PG8_WAIT_V(4); PG8_BAR;
        PG8_STAGE(PG8_SB(1, 0), cB + kstep, voffB); PG8_STAGE(PG8_SA(1, 0), cA + kstep, voffA); PG8_STAGE(PG8_SB(1, 1), cB + hstep + kstep, voffB);
        PG8_WAIT_V(6); PG8_BAR;
    }
    for (;;) {
        const bool has_next = S.next(ui + 1, nxt);
        const char* nA = has_next ? (const char*)g.A + (size_t)nxt.pm * tstep : cA; const char* nB = has_next ? (const char*)g.Bt + (size_t)nxt.pn * tstep : cB;
        for (int t = 0; t < nt; t += 2) {
            const bool last = (t == nt - 2);
            const char* a1 = cA + (size_t)(t + 1) * kstep;
            const char* a2 = last ? nA : cA + (size_t)(t + 2) * kstep; const char* b2 = last ? nB : cB + (size_t)(t + 2) * kstep;
            const char* a3 = a2 + kstep; const char* b3 = b2 + kstep;
            if (last && has_next) S.a_ready(nxt);
            if constexpr (SP2) {
            PG8_LDB(B0, 0, 0); PG8_LDB(B1, 0, 1); PG8_SCHED; PG8_LDA(At, 0, 0); PG8_STAGE(PG8_SA(1, 1), a1 + hstep, voffA);
            PG8_WAIT_V(8); PG8_WAIT_L(0); PG8_BAR; PG8_MMA(0, 0, At, B0); PG8_MMA(0, 1, At, B1); PG8_BAR; PG8_SCHED;
            PG8_LDA(At, 0, 1); PG8_STAGE(PG8_SB(0, 0), b2, voffB); PG8_STAGE(PG8_SB(0, 1), b2 + hstep, voffB); PG8_STAGE(PG8_SA(0, 0), a2, voffA);
            PG8_WAIT_V(8); PG8_WAIT_L(0); PG8_BAR; PG8_MMA(1, 0, At, B0); PG8_MMA(1, 1, At, B1); PG8_BAR; PG8_SCHED;
            PG8_LDB(B0, 1, 0); PG8_LDB(B1, 1, 1); PG8_SCHED; PG8_LDA(At, 1, 0); PG8_STAGE(PG8_SA(0, 1), a2 + hstep, voffA);
            PG8_WAIT_V(8); PG8_WAIT_L(0); PG8_BAR; PG8_MMA(0, 0, At, B0); PG8_MMA(0, 1, At, B1); PG8_BAR; PG8_SCHED;
            PG8_LDA(At, 1, 1); PG8_STAGE(PG8_SB(1, 0), b3, voffB); PG8_STAGE(PG8_SB(1, 1), b3 + hstep, voffB); PG8_STAGE(PG8_SA(1, 0), a3, voffA);
            PG8_WAIT_V(8); PG8_WAIT_L(0); PG8_BAR; PG8_MMA(1, 0, At, B0); PG8_MMA(1, 1, At, B1); PG8_BAR; PG8_SCHED;
            } else {
            PG8_LDB(B0, 0, 0); PG8_SCHED; PG8_LDA(At, 0, 0); PG8_STAGE(PG8_SA(1, 1), a1 + hstep, voffA);
            PG8_WAIT_L(8); PG8_BAR; PG8_WAIT_L(0); PG8_MMA(0, 0, At, B0); PG8_BAR; PG8_SCHED;
            PG8_LDB(B1, 0, 1); PG8_STAGE(PG8_SB(0, 0), b2, voffB);
            PG8_BAR; PG8_WAIT_L(0); PG8_MMA(0, 1, At, B1); PG8_BAR;
            PG8_LDA(At, 0, 1); PG8_STAGE(PG8_SA(0, 0), a2, voffA);
            PG8_BAR; PG8_WAIT_L(0); PG8_MMA(1, 0, At, B0); PG8_BAR; PG8_SCHED;
            PG8_STAGE(PG8_SB(0, 1), b2 + hstep, voffB);
            PG8_WAIT_V(6); PG8_BAR; PG8_MMA(1, 1, At, B1); PG8_BAR;
            PG8_LDB(B0, 1, 0); PG8_SCHED; PG8_LDA(At, 1, 0); PG8_STAGE(PG8_SA(0, 1), a2 + hstep, voffA);
            PG8_WAIT_L(8); PG8_BAR; PG8_WAIT_L(0); PG8_MMA(0, 0, At, B0); PG8_BAR; PG8_SCHED;
            PG8_LDB(B1, 1, 1); PG8_STAGE(PG8_SB(1, 0), b3, voffB);
            PG8_BAR; PG8_WAIT_L(0); PG8_MMA(0, 1, At, B1); PG8_BAR;
            PG8_LDA(At, 1, 1); PG8_STAGE(PG8_SA(1, 0), a3, voffA);
            PG8_BAR; PG8_WAIT_L(0); PG8_MMA(1, 0, At, B0); PG8_BAR; PG8_SCHED;
            PG8_STAGE(PG8_SB(1, 1), b3 + hstep, voffB);
            PG8_WAIT_V(6); PG8_BAR; PG8_MMA(1, 1, At, B1); PG8_BAR;
            }
        }
        if constexpr (ALIGN_EPI) { if (wr == 0) PG8_BAR; }
        if constexpr (!Epi::AFTER_DRAIN) { E(acc, cur, wr, wc, fr, fq); S.done(cur); }
        if (!has_next) break;
#pragma unroll
        for (int a = 0; a < 2; ++a)
#pragma unroll
            for (int b = 0; b < 2; ++b)
#pragma unroll
                for (int m = 0; m < 4; ++m)
#pragma unroll
                    for (int n = 0; n < 2; ++n) acc[a][b][m][n] = (f32x4){0.f, 0.f, 0.f, 0.f};
        cur = nxt; cA = nA; cB = nB; ++ui;
        if constexpr (ALIGN_EPI) { if (wr == 1) PG8_BAR; }
    }
    PG8_WAIT_V(0);
    if constexpr (!ALIGN_EPI) { if (wr == 0) PG8_BAR; }
    PG8_BAR;
    if constexpr (Epi::AFTER_DRAIN) { E.fused(acc, cur, wr, wc, fr, fq, lds, wid, lane); S.done(cur); }
#undef PG8_SA
#undef PG8_SB
#undef PG8_STAGE
#undef PG8_LDA
#undef PG8_LDB
#undef PG8_MMA
#undef PG8_WAIT_V
#undef PG8_WAIT_L
#undef PG8_BAR
#undef PG8_SCHED
}
}


template <class Epi, bool ALIGN>
DEVI void run_gemm(unsigned char* lds, const bf16_t* A, const bf16_t* Bt, int Mr, int N, int K, const Epi& E) {
    pg8::Gemm g{A, Bt, Mr, N, K}; pg8::StaticOrder S; S.init(Mr, N, (int)gridDim.x, (int)blockIdx.x);
    pg8::gemm_phase<Epi, pg8::StaticOrder, ALIGN, true>((PG8_LAS unsigned char*)lds, g, S, E);
}
#include <hip/hip_bf16.h>
#include <cmath>
namespace attn_body {
using bf16=__hip_bfloat16;
using bf16x8=__attribute__((ext_vector_type(8)))short;
using s16x4=__attribute__((ext_vector_type(4)))short;
using f32x16=__attribute__((ext_vector_type(16)))float;
using u32x4=__attribute__((ext_vector_type(4)))unsigned;
constexpr int BATCH=2,NHEAD=16,SEQ=8192,D=64,DM=NHEAD*D;
constexpr int NW=8,QBLK=32,QB=QBLK*NW,KVBLK=64,NQB=SEQ/QB;
constexpr int ATTN_PITCH=DM, ATTN_UNIT_ROWS=QB;
__device__ __forceinline__ int crow(int r,int hi){return (r&3)+8*(r>>2)+4*hi;}
#define SBAR() __builtin_amdgcn_sched_barrier(0)
__device__ __forceinline__ void cmask(f32x16&p0,f32x16&p1,int jb,int qrel,int hi){
  const float NEG=-INFINITY; int kb=64*jb+4*hi;
  #pragma unroll
  for(int r=0;r<16;++r){int kv=kb+(r&3)+8*(r>>2); if(kv>qrel)p0[r]=NEG; if(kv+32>qrel)p1[r]=NEG;}
}

constexpr int NSLOT=3, SLOTB=8192;
constexpr int LDS_K=0, LDS_V=NSLOT*SLOTB, LDS_WS=2*NSLOT*SLOTB, LDS_OST=LDS_WS+NW*64*4, LDS_BYTES=LDS_OST+NW*4096;
constexpr float PRUNE_MARGIN=64.f;
constexpr int LDS_FB=LDS_BYTES;
constexpr float C2=0.125f*1.4426950408889634f;
__device__ __forceinline__ void glds16(const void*gsrc,unsigned lds_dst){unsigned keep;
  asm volatile("s_mov_b32 %0, m0\n\ts_mov_b32 m0, %2\n\ts_nop 0\n\tglobal_load_lds_dwordx4 %1, off\n\ts_mov_b32 m0, %0":"=&s"(keep):"v"(gsrc),"s"(lds_dst):"memory");}
__device__ __forceinline__ float max3f(float a,float b,float c){float r;asm("v_max3_f32 %0, %1, %2, %3":"=v"(r):"v"(a),"v"(b),"v"(c));return r;}
__device__ __forceinline__ float max2f(float a,float b){float r;asm("v_max_f32_e32 %0, %1, %2":"=v"(r):"v"(a),"v"(b));return r;}
__device__ __forceinline__ float fadd_s(float a,float b){float r;asm("v_add_f32_e32 %0, %1, %2":"=v"(r):"v"(a),"v"(b));return r;}
__device__ __forceinline__ float fsub_s(float a,float b){float r;asm("v_sub_f32_e32 %0, %1, %2":"=v"(r):"v"(a),"v"(b));return r;}
typedef float f32x2_t __attribute__((ext_vector_type(2))); typedef float f32x4_t __attribute__((ext_vector_type(4))); typedef __bf16 bf16x2_t __attribute__((ext_vector_type(2)));
__device__ __forceinline__ unsigned cvtpk_s(float lo,float hi){f32x2_t v={lo,hi};bf16x2_t b=__builtin_convertvector(v,bf16x2_t);return __builtin_bit_cast(unsigned,b);}
#define WAIT_BAR(N) asm volatile("s_waitcnt vmcnt(" #N ") lgkmcnt(0)\n\ts_barrier":::"memory")

__device__ __forceinline__ void qkt(f32x16&p0,f32x16&p1,const char*Kslot,const bf16x8*qr,int r32,int hi){
  const char*kb=Kslot+hi*1024+r32*16;
  #pragma unroll
  for(int d0=0;d0<4;++d0){
    const bf16x8 b0=*reinterpret_cast<const bf16x8*>(kb+d0*2048);
    const bf16x8 b1=*reinterpret_cast<const bf16x8*>(kb+d0*2048+512);
    {p0=__builtin_amdgcn_mfma_f32_32x32x16_bf16(b0,qr[d0],p0,0,0,0);p1=__builtin_amdgcn_mfma_f32_32x32x16_bf16(b1,qr[d0],p1,0,0,0);}}
}
typedef __attribute__((address_space(3))) const char* lds_cptr;
typedef short v4i16_t __attribute__((ext_vector_type(4)));
__device__ __forceinline__ void kload8(bf16x8*kf,lds_cptr kp){
  kf[0]=*(const __attribute__((address_space(3))) bf16x8*)(kp);      kf[1]=*(const __attribute__((address_space(3))) bf16x8*)(kp+512);
  kf[2]=*(const __attribute__((address_space(3))) bf16x8*)(kp+2048); kf[3]=*(const __attribute__((address_space(3))) bf16x8*)(kp+2560);
  kf[4]=*(const __attribute__((address_space(3))) bf16x8*)(kp+4096); kf[5]=*(const __attribute__((address_space(3))) bf16x8*)(kp+4608);
  kf[6]=*(const __attribute__((address_space(3))) bf16x8*)(kp+6144); kf[7]=*(const __attribute__((address_space(3))) bf16x8*)(kp+6656);
}
__device__ __forceinline__ void kload2(bf16x8*kf,lds_cptr kp,int j){ kf[2*j]=*(const __attribute__((address_space(3))) bf16x8*)(kp+j*2048); kf[2*j+1]=*(const __attribute__((address_space(3))) bf16x8*)(kp+j*2048+512); }
__device__ __forceinline__ s16x4 vtr(lds_cptr p){ return __builtin_bit_cast(s16x4,__builtin_amdgcn_ds_read_tr16_b64_v4i16((__attribute__((address_space(3))) v4i16_t*)p)); }
__device__ __forceinline__ float rowmax(const f32x16&p0,const f32x16&p1){
  float a=max3f(p0[0],p0[1],p1[0]),b=max3f(p0[2],p0[3],p1[1]);a=max3f(a,p1[2],p1[3]);
  #pragma unroll
  for(int r=4;r<16;r+=4){a=max3f(a,p0[r],p0[r+1]);b=max3f(b,p0[r+2],p0[r+3]);a=max3f(a,p1[r],p1[r+1]);b=max3f(b,p1[r+2],p1[r+3]);}
  const float m=max2f(a,b);
  auto rr=__builtin_amdgcn_permlane32_swap(__float_as_uint(m),__float_as_uint(m),false,false);
  return max2f(__uint_as_float(rr[0]),__uint_as_float(rr[1]));
}
__device__ __forceinline__ void pv(f32x16*o,int vb,bf16x8 pa0,bf16x8 pa1,bf16x8 pa2,bf16x8 pa3){
  #pragma unroll
  for(int d0=0;d0<2;++d0){s16x4 lo[4],hi[4];
    #pragma unroll
    for(int ks=0;ks<4;++ks){
      asm volatile("ds_read_b64_tr_b16 %0,%1 offset:%c2":"=&v"(lo[ks]):"v"(vb),"i"(d0*4096+ks*1024):"memory");
      asm volatile("ds_read_b64_tr_b16 %0,%1 offset:%c2":"=&v"(hi[ks]):"v"(vb),"i"(d0*4096+ks*1024+512):"memory");}
    asm volatile("s_waitcnt lgkmcnt(0)":::"memory");SBAR();
    #define PK(k) (bf16x8){lo[k][0],lo[k][1],lo[k][2],lo[k][3],hi[k][0],hi[k][1],hi[k][2],hi[k][3]}
    o[d0]=__builtin_amdgcn_mfma_f32_32x32x16_bf16(pa0,PK(0),o[d0],0,0,0);
    o[d0]=__builtin_amdgcn_mfma_f32_32x32x16_bf16(pa1,PK(1),o[d0],0,0,0);
    o[d0]=__builtin_amdgcn_mfma_f32_32x32x16_bf16(pa2,PK(2),o[d0],0,0,0);
    o[d0]=__builtin_amdgcn_mfma_f32_32x32x16_bf16(pa3,PK(3),o[d0],0,0,0);
    #undef PK
  }
}

#ifndef ATTN_STORE16
#define ATTN_STORE16(p,v) (*(u32x4*)(p)=(v))
#endif
template<int THRL> __device__ __forceinline__ void attn_unit(int b,int h,int qb,const bf16*Q,const bf16*__restrict__ K,const bf16*__restrict__ V,bf16*O,const float*__restrict__ Fc,const unsigned*__restrict__ kmx,const unsigned*__restrict__ qmx,char*shm){
  int tid_=threadIdx.x; asm volatile("":"+v"(tid_)); const int tid=tid_,lane=tid&63,r32=lane&31,hi=lane>>5; const int wid=__builtin_amdgcn_readfirstlane(tid>>6);
  const long rowbase=(long)b*SEQ; const int q0=qb*QB;
  const bf16*Qw=Q+(rowbase+q0+wid*QBLK)*DM+h*D;
  int ts=0; const float fq0=Fc[q0];
  { const int NT0=(q0+QB)/KVBLK; const float qm=__builtin_sqrtf(__uint_as_float(qmx[qb]));
    const float kd=__builtin_sqrtf(__uint_as_float(max(max(kmx[4*qb],kmx[4*qb+1]),max(kmx[4*qb+2],kmx[4*qb+3]))));
    const float thr=-qm*kd-PRUNE_MARGIN; int first=NT0;
    for(int base=0;base<NT0-4;base+=64){ const int kt=base+lane; bool keep=false;
      if(kt<NT0-4){ const float ub=qm*__builtin_sqrtf(__uint_as_float(kmx[kt]))+(fq0-Fc[kt*64+63])*1.4426950408889634f; keep=!(ub<thr); }
      const unsigned long long mk=__ballot(keep); if(mk){ first=base+__builtin_ctzll(mk); break; } }
    ts=min(first,NT0-4)&~1; ts=__builtin_amdgcn_readfirstlane(ts); }
  const bf16*Kh=K+(rowbase+(long)ts*KVBLK)*DM+h*D,*Vh=V+(rowbase+(long)ts*KVBLK)*DM+h*D; Fc+=ts*KVBLK;
  const unsigned lds0=(unsigned)(uintptr_t)shm;
  float*wsf=(float*)(shm+LDS_WS)+wid*64;
  const bf16*ksrc=Kh+(long)lane*DM+wid*8;
  const bf16*vsrc=Vh+(long)(16*(wid&3)+(lane>>2))*DM+(wid>>2)*32+(lane&3)*8;
  const unsigned kdst=lds0+LDS_K+wid*1024, vdst=lds0+LDS_V+wid*1024;
  #define DMA_K(t,slot) glds16(ksrc+(long)(t)*KVBLK*DM,(unsigned)__builtin_amdgcn_readfirstlane(kdst+(slot)))
  #define DMA_V(t,slot) glds16(vsrc+(long)(t)*KVBLK*DM,(unsigned)__builtin_amdgcn_readfirstlane(vdst+(slot)))
  const int vb0=(int)(lds0+LDS_V)+((lane>>4)&1)*32+(lane&3)*8+(4*hi+((lane&15)>>2))*64;
  const char*Kbase=shm+LDS_K; bf16x8 kf[8];
  const lds_cptr shm3=(lds_cptr)shm; const lds_cptr kp0=shm3+LDS_K+hi*1024+r32*16; const lds_cptr vp0=shm3+LDS_V+((lane>>4)&1)*32+(lane&3)*8+(4*hi+((lane&15)>>2))*64;
  const int NT=(q0+QB)/KVBLK-ts;
  DMA_K(0,0);DMA_V(0,0);DMA_K(1,SLOTB);
  bf16x8 qr[4];
  #pragma unroll
  for(int d0=0;d0<4;++d0)qr[d0]=*reinterpret_cast<const bf16x8*>(&Qw[(long)r32*DM+d0*16+hi*8]);
  float mhat=0.f,l_reg=0.f;f32x16 o[2];o[0]=f32x16{};o[1]=f32x16{};
  const int qrel=wid*QBLK+r32;
  #define CMASK(P0,P1,t) do{int jb_=(t)-(NT-4); if(jb_>=0)cmask(P0,P1,jb_,qrel,hi);}while(0)
  bool resc=false;
  #define START(P0,P1) do{ const float rm=rowmax(P0,P1); resc=false; \
    { const float dl=rm; mhat=fadd_s(mhat,dl); \
      _Pragma("unroll") for(int r=0;r<16;++r){P0[r]=fsub_s(P0[r],dl);P1[r]=fsub_s(P1[r],dl);} \
      } \
    _Pragma("unroll") for(int r=0;r<16;++r)P0[r]=__builtin_amdgcn_exp2f(P0[r]); }while(0)
  #define RESC() do{ if(resc){ asm volatile("s_waitcnt lgkmcnt(0)":::"memory"); \
      _Pragma("unroll") for(int d_=0;d_<2;++d_) _Pragma("unroll") for(int r=0;r<16;++r)o[d_][r]*=wsf[crow(r,hi)]; } }while(0)
  f32x16 pA0,pA1,pB0,pB1;
  int sl_prev=0,sl_cur=0,sl_next=SLOTB;
  #define ROT() do{sl_prev=sl_cur;sl_cur=sl_next;sl_next=(sl_next==(NSLOT-1)*SLOTB)?0:sl_next+SLOTB;}while(0)
  DMA_K(2,2*SLOTB);
  typedef __attribute__((address_space(3))) f32x4_t* lds_f4w; typedef const __attribute__((address_space(3))) f32x4_t* lds_f4ptr;
  { const lds_f4w fbw=(lds_f4w)((__attribute__((address_space(3))) char*)shm+LDS_FB); const f32x4_t*fsrc=(const f32x4_t*)Fc;
    for(int i=tid;i<NT*16;i+=NW*64){ const f32x4_t v=fsrc[i]; fbw[i]=(fq0-v)*1.4426950408889634f; } }
  #define FBINIT(X0,X1,tt) do{ const lds_f4ptr fp_=(lds_f4ptr)(shm3+LDS_FB+((tt)*64+4*hi)*4); \
    _Pragma("unroll") for(int g_=0;g_<4;++g_){ const f32x4_t a_=fp_[2*g_],b_=fp_[2*g_+8]; \
      X0[4*g_]=a_[0]-mhat;X0[4*g_+1]=a_[1]-mhat;X0[4*g_+2]=a_[2]-mhat;X0[4*g_+3]=a_[3]-mhat; X1[4*g_]=b_[0]-mhat;X1[4*g_+1]=b_[1]-mhat;X1[4*g_+2]=b_[2]-mhat;X1[4*g_+3]=b_[3]-mhat; } }while(0)
  WAIT_BAR(3);
  FBINIT(pA0,pA1,0); qkt(pA0,pA1,Kbase,qr,r32,hi);asm volatile("s_nop 15\n\ts_nop 7":"+v"(pA0),"+v"(pA1));CMASK(pA0,pA1,0);
  START(pA0,pA1);
  _Pragma("unroll") for(int r=0;r<16;++r)pA1[r]=__builtin_amdgcn_exp2f(pA1[r]);
  WAIT_BAR(0);
  DMA_K(3,0);DMA_V(1,SLOTB);
  ROT();
  kload8(kf,kp0+sl_cur);
  FBINIT(pB0,pB1,1);
  WAIT_BAR(2);
  s16x4 vlo[8],vhi[8]; u32x4 pw0,pw1,pw2,pw3;
  #define PKW(P,B) cvtpk_s(P[B],P[B+1])
  #define PAF(k) __builtin_bit_cast(bf16x8,pw##k)
  #define VFR(i) (bf16x8){vlo[i][0],vlo[i][1],vlo[i][2],vlo[i][3],vhi[i][0],vhi[i][1],vhi[i][2],vhi[i][3]}
  #define PIN(x) asm volatile("":"+v"(x))
  #define MX3(a,b,c) __builtin_fmaxf(__builtin_fmaxf((a),(b)),(c))
  #define GAPA(MF,A0,A1,A2,A3,W0,W1,PW) do{ MF; sacc+=A0; sacc+=A1; sacc+=A2; sacc+=A3; PIN(sacc); W0; W1; PIN(PW); SBAR(); }while(0)
  #define EX(v) __builtin_amdgcn_exp2f(v)
  #define GAPB(MF,X,B,BI) do{ MF; X[B]=EX(X[B]); X[B+1]=EX(X[B+1]); X[B+2]=EX(X[B+2]); X[B+3]=EX(X[B+3]); PIN(X); BI; SBAR(); }while(0)
  #define BINIT(PX,G,bv) do{ PX[4*(G)]=bv[0]-mhat; PX[4*(G)+1]=bv[1]-mhat; PX[4*(G)+2]=bv[2]-mhat; PX[4*(G)+3]=bv[3]-mhat; PIN(PX); }while(0)
  #define VRD(i) do{ vlo[i]=vtr(vp_+(((i)>>2)*4096+((i)&3)*1024)); vhi[i]=vtr(vp_+(((i)>>2)*4096+((i)&3)*1024+512)); }while(0)
  #define KRD(G,j) do{ if(G){ kload2(kf,kp0+sl_next,j); SBAR(); } }while(0)
  #define STEP(C0,C1,P0,P1,t,GK,GV,GL) do{ SBAR(); \
    const lds_cptr vp_=vp0+sl_prev; \
    VRD(0); SBAR(); float sacc=(P0[0]+P0[1]); \
    GAPA(C0=__builtin_amdgcn_mfma_f32_32x32x16_bf16(kf[0],qr[0],C0,0,0,0), P0[2],P0[3],P0[4],P0[5],     pw0[0]=PKW(P0,0), pw0[1]=PKW(P0,2), pw0); \
    VRD(4); SBAR(); GAPA(C1=__builtin_amdgcn_mfma_f32_32x32x16_bf16(kf[1],qr[0],C1,0,0,0), P0[6],P0[7],P0[8],P0[9],     pw0[2]=PKW(P0,4), pw0[3]=PKW(P0,6), pw0); \
    VRD(1); SBAR(); GAPA(C0=__builtin_amdgcn_mfma_f32_32x32x16_bf16(kf[2],qr[1],C0,0,0,0),   P0[10],P0[11],P0[12],P0[13], pw1[0]=PKW(P0,8), pw1[1]=PKW(P0,10), pw1); \
    VRD(5); SBAR(); GAPA(C1=__builtin_amdgcn_mfma_f32_32x32x16_bf16(kf[3],qr[1],C1,0,0,0),   P0[14],P0[15],P1[0],P1[1],   pw1[2]=PKW(P0,12),pw1[3]=PKW(P0,14), pw1); \
    VRD(2); SBAR(); GAPA(C0=__builtin_amdgcn_mfma_f32_32x32x16_bf16(kf[4],qr[2],C0,0,0,0),   P1[2],P1[3],P1[4],P1[5],     pw2[0]=PKW(P1,0), pw2[1]=PKW(P1,2), pw2); \
    VRD(6); SBAR(); GAPA(C1=__builtin_amdgcn_mfma_f32_32x32x16_bf16(kf[5],qr[2],C1,0,0,0),   P1[6],P1[7],P1[8],P1[9],     pw2[2]=PKW(P1,4), pw2[3]=PKW(P1,6), pw2); \
    VRD(3); SBAR(); GAPA(C0=__builtin_amdgcn_mfma_f32_32x32x16_bf16(kf[6],qr[3],C0,0,0,0),   P1[10],P1[11],P1[12],P1[13], pw3[0]=PKW(P1,8), pw3[1]=PKW(P1,10), pw3); \
    VRD(7); SBAR(); GAPA(C1=__builtin_amdgcn_mfma_f32_32x32x16_bf16(kf[7],qr[3],C1,0,0,0),   P1[14],P1[15],0.f,0.f,       pw3[2]=PKW(P1,12),pw3[3]=PKW(P1,14), pw3); \
    l_reg+=sacc; \
    if(GK){DMA_K((t)+3,sl_cur);} if(GV){DMA_V((t)+1,sl_next);} \
    CMASK(C0,C1,t); \
    const lds_f4ptr fbp_=(lds_f4ptr)(shm3+LDS_FB+(((t)+1)*64+4*hi)*4); f32x4_t bvA=fbp_[0]; \
    { float a=MX3(C0[0],C0[1],C1[0]),b=MX3(C0[2],C0[3],C1[1]); a=MX3(a,C1[2],C1[3]); \
      _Pragma("unroll") for(int r=4;r<16;r+=4){a=MX3(a,C0[r],C0[r+1]);b=MX3(b,C0[r+2],C0[r+3]);a=MX3(a,C1[r],C1[r+1]);b=MX3(b,C1[r+2],C1[r+3]);} \
      float rm=__builtin_fmaxf(a,b); { auto rr=__builtin_amdgcn_permlane32_swap(__float_as_uint(rm),__float_as_uint(rm),false,false); rm=__builtin_fmaxf(__uint_as_float(rr[0]),__uint_as_float(rr[1])); } \
      resc=false; \
      if(__builtin_expect(__any(rm>(float)THRL),0)){ const float dl=__builtin_fmaxf(rm,0.f); mhat+=dl; \
        _Pragma("unroll") for(int r=0;r<16;++r){C0[r]-=dl;C1[r]-=dl;} \
        const float f=__builtin_amdgcn_exp2f(-dl); l_reg*=f; if(hi==0)wsf[r32]=f; resc=true; } } \
    SBAR(); \
    GAPB(o[0]=__builtin_amdgcn_mfma_f32_32x32x16_bf16(PAF(0),VFR(0),o[0],0,0,0), C0,0,do{BINIT(P0,0,bvA); bvA=fbp_[2];}while(0)); \
    GAPB(o[1]=__builtin_amdgcn_mfma_f32_32x32x16_bf16(PAF(0),VFR(4),o[1],0,0,0), C0,4,do{BINIT(P0,1,bvA); bvA=fbp_[4];}while(0)); \
    KRD(GL,0); GAPB(o[0]=__builtin_amdgcn_mfma_f32_32x32x16_bf16(PAF(1),VFR(1),o[0],0,0,0), C0,8,do{BINIT(P0,2,bvA); bvA=fbp_[6];}while(0)); \
    KRD(GL,1); GAPB(o[1]=__builtin_amdgcn_mfma_f32_32x32x16_bf16(PAF(1),VFR(5),o[1],0,0,0), C0,12,do{BINIT(P0,3,bvA); bvA=fbp_[8];}while(0)); \
    KRD(GL,2); GAPB(o[0]=__builtin_amdgcn_mfma_f32_32x32x16_bf16(PAF(2),VFR(2),o[0],0,0,0), C1,0,do{BINIT(P1,0,bvA); bvA=fbp_[10];}while(0)); \
    KRD(GL,3); GAPB(o[1]=__builtin_amdgcn_mfma_f32_32x32x16_bf16(PAF(2),VFR(6),o[1],0,0,0), C1,4,do{BINIT(P1,1,bvA); bvA=fbp_[12];}while(0)); \
    GAPB(o[0]=__builtin_amdgcn_mfma_f32_32x32x16_bf16(PAF(3),VFR(3),o[0],0,0,0), C1,8,do{BINIT(P1,2,bvA); bvA=fbp_[14];}while(0)); \
    GAPB(o[1]=__builtin_amdgcn_mfma_f32_32x32x16_bf16(PAF(3),VFR(7),o[1],0,0,0), C1,12,do{BINIT(P1,3,bvA);}while(0)); \
    }while(0)
  int t=1;
  #undef CMASK
  #define CMASK(P0,P1,t) do{}while(0)
  for(;t+5<NT;t+=2){
    STEP(pB0,pB1,pA0,pA1,t,true,true,true);     WAIT_BAR(2); RESC(); ROT();
    STEP(pA0,pA1,pB0,pB1,t+1,true,true,true);   WAIT_BAR(2); RESC(); ROT();
  }
  #undef CMASK
  #define CMASK(P0,P1,t) do{int jb_=(t)-(NT-4); if(jb_>=0)cmask(P0,P1,jb_,qrel,hi);}while(0)
  #define ENDW(tt) do{ if((tt)+3<NT){WAIT_BAR(2);} else if((tt)+2<NT){WAIT_BAR(1);} else {WAIT_BAR(0);} }while(0)
  for(;t+1<NT;t+=2){
    STEP(pB0,pB1,pA0,pA1,t,(t+3<NT),(t+1<NT),(t+1<NT));       ENDW(t);   RESC(); ROT();
    STEP(pA0,pA1,pB0,pB1,t+1,(t+4<NT),(t+2<NT),(t+2<NT));     ENDW(t+1); RESC(); ROT();
  }
  STEP(pB0,pB1,pA0,pA1,NT-1,false,false,false); RESC();
  { float sacc=pB0[0]+pB0[1]; _Pragma("unroll") for(int r=2;r<16;++r)sacc+=pB0[r]; _Pragma("unroll") for(int r=0;r<16;++r)sacc+=pB1[r]; l_reg+=sacc;
    pw0=(u32x4){PKW(pB0,0),PKW(pB0,2),PKW(pB0,4),PKW(pB0,6)};pw1=(u32x4){PKW(pB0,8),PKW(pB0,10),PKW(pB0,12),PKW(pB0,14)};pw2=(u32x4){PKW(pB1,0),PKW(pB1,2),PKW(pB1,4),PKW(pB1,6)};pw3=(u32x4){PKW(pB1,8),PKW(pB1,10),PKW(pB1,12),PKW(pB1,14)};
    SBAR(); pv(o,vb0+sl_cur,PAF(0),PAF(1),PAF(2),PAF(3)); }
  #undef PKW
  #undef PAF
  #undef VFR
  #undef PIN
  #undef MX3
  #undef GAPA
  #undef GAPB
  #undef BINIT
  #undef FBINIT
  #undef EX
  #undef VRD
  #undef KRD
  #undef STEP
  #undef ENDW
  {auto rr=__builtin_amdgcn_permlane32_swap(__float_as_uint(l_reg),__float_as_uint(l_reg),false,false);l_reg=__uint_as_float(rr[0])+__uint_as_float(rr[1]);}
  if(hi==0)wsf[32+r32]=l_reg;asm volatile("s_waitcnt lgkmcnt(0)":::"memory");
  float rli[16];
  #pragma unroll
  for(int r=0;r<16;++r)rli[r]=__builtin_amdgcn_rcpf(wsf[32+crow(r,hi)]);
  bf16*Ow=O+(rowbase+q0+wid*QBLK)*DM+h*D;
  { bf16*stg=(bf16*)(shm+LDS_OST)+wid*2048;
    #pragma unroll
    for(int r=0;r<16;++r){const int orow=crow(r,hi);
      #pragma unroll
      for(int d0=0;d0<2;++d0)stg[orow*64+d0*32+r32]=__float2bfloat16(o[d0][r]*rli[r]);}
    asm volatile("s_waitcnt lgkmcnt(0)":::"memory");
    #pragma unroll
    for(int i=0;i<4;++i){const int row=i*8+(lane>>3),ch=lane&7; const u32x4 v=*(const u32x4*)(stg+row*64+ch*8); ATTN_STORE16(Ow+(long)row*DM+ch*8,v);} }
  asm volatile("s_waitcnt lgkmcnt(0)\n\ts_barrier":::"memory");
  #undef DMA_K
  #undef DMA_V
  #undef CMASK
  #undef START
  #undef RESC
  #undef ROT
}
constexpr int ATTN_LDS_BYTES=LDS_BYTES;
struct AttnTensors { const bf16* Q; const bf16* K; const bf16* V; bf16* O; const float* F; const unsigned* KMAX; const unsigned* QMAX; };
struct AttnUnit { int bh; int qb; };
struct StaticOrder {
  int vcu;
  __device__ __forceinline__ explicit StaticOrder(int grid,int block):vcu((block%8)*(grid/8)+block/8){}
  __device__ __forceinline__ bool next(int i,AttnUnit&u)const{ if(i>=4)return false; const int s=vcu&7; u.bh=vcu>>3; u.qb=(i==0)?s:(i==1)?15-s:(i==2)?16+s:31-s; return true; }
  __device__ __forceinline__ void a_ready(const AttnUnit&)const{}
  __device__ __forceinline__ void done(const AttnUnit&)const{}
};
template<class Sched,int THRL=8> __device__ __forceinline__ void attn_phase(char*lds,const AttnTensors&T,const Sched&S){
  AttnUnit u;
  for(int i=0;S.next(i,u);++i){ S.a_ready(u); attn_unit<THRL>(u.bh/NHEAD,u.bh%NHEAD,u.qb,T.Q,T.K,T.V,T.O,T.F+(size_t)u.bh*SEQ,T.KMAX+u.bh*128,T.QMAX+u.bh*32,lds); S.done(u); }
}
#undef SBAR
#undef WAIT_BAR
}

__global__ void __launch_bounds__(512, 2) mega_fwd(Params p) {
    extern __shared__ __attribute__((aligned(16))) unsigned char lds[];
    cg::grid_group grid = cg::this_grid();
    unsigned char* ws = p.ws;
    bf16_t* XN = (bf16_t*)(ws + WS_XN); bf16_t* HB = (bf16_t*)(ws + WS_H);
    ph_prologue(p, lds); grid.sync();
    ph_mods_xn1(p, lds); grid.sync();
    { pg8::EpiSwiglu E{HB, DFF}; run_gemm<pg8::EpiSwiglu, true>(lds, XN, (const bf16_t*)(ws + WS_WGU), M, 2 * DFF, D, E); } grid.sync();
    { pg8::EpiF32 E{(float*)(ws + WS_Y)}; run_gemm<pg8::EpiF32, false>(lds, HB, (const bf16_t*)(ws + WS_WDN), M, D, DFF, E); } grid.sync();
    ph_norm_res(p, (const float*)(ws + WS_Y), p.in[I_X], p.out, true, 0, 0.5f); grid.sync();
    { pg8::EpiSeg E{ws, 0}; run_gemm<pg8::EpiSeg, true>(lds, XN, (const bf16_t*)(ws + WS_WIN1), M, 5120, D, E); }
    ph_thin_cols(p); grid.sync();
    ph_fcum(p, lds);
    ph_qk_norms(p);
    for (int u = blockIdx.x; u < 256; u += gridDim.x) gla_rec<false>(p, lds, u);
    grid.sync();
    ph_gla_scan(p); grid.sync();
    for (int u = blockIdx.x; u < 256; u += gridDim.x) gla_rec<true>(p, lds, u);
    __syncthreads();
    { const attn_body::AttnTensors AT{(const attn_body::bf16*)(ws + WS_QB), (const attn_body::bf16*)(ws + WS_KB), (const attn_body::bf16*)(ws + WS_VB), (attn_body::bf16*)(ws + WS_QB), (const float*)(ws + WS_FCUM), (const unsigned*)(ws + WS_KMAX), (const unsigned*)(ws + WS_QMAX)};
      const attn_body::StaticOrder S((int)gridDim.x, (int)blockIdx.x); attn_body::attn_phase<attn_body::StaticOrder>((char*)lds, AT, S); }
    grid.sync();
    { pg8::EpiSeg E{ws, 1}; run_gemm<pg8::EpiSeg, true>(lds, XN, (const bf16_t*)(ws + WS_WIN2), M, 3072, D, E); }
    __syncthreads();
    convert_ffn_weights(p, lds, p.in[I_WGU2], p.in[I_WDN2]); grid.sync();
    ph_oa_norm(p); grid.sync();
    { pg8::EpiGate<0> E{(bf16_t*)(ws + WS_GA), nullptr}; run_gemm<pg8::EpiGate<0>, false>(lds, (const bf16_t*)(ws + WS_VA), (const bf16_t*)(ws + WS_WPA), M, D, D, E); } grid.sync();
    { pg8::EpiGate<1> E{(bf16_t*)(ws + WS_GB), (const bf16_t*)(ws + WS_GA)}; run_gemm<pg8::EpiGate<1>, false>(lds, (const bf16_t*)(ws + WS_QB), (const bf16_t*)(ws + WS_WPB), M, D, D, E); } grid.sync();
    { pg8::EpiF32 E{(float*)(ws + WS_Y2)}; run_gemm<pg8::EpiF32, false>(lds, (const bf16_t*)(ws + WS_GB), (const bf16_t*)(ws + WS_WOUT), M, D, D, E); } grid.sync();
    ph_norm_res(p, (const float*)(ws + WS_Y2), p.out, p.out, true, 1, 1.0f); grid.sync();
    { pg8::EpiSwiglu E{HB, DFF}; run_gemm<pg8::EpiSwiglu, true>(lds, XN, (const bf16_t*)(ws + WS_WGU), M, 2 * DFF, D, E); } grid.sync();
    { pg8::EpiF32 E{(float*)(ws + WS_Y)}; run_gemm<pg8::EpiF32, false>(lds, HB, (const bf16_t*)(ws + WS_WDN), M, D, DFF, E); } grid.sync();
    ph_norm_res(p, (const float*)(ws + WS_Y), p.out, p.out, false, 2, 0.5f);
}

extern "C" void kernel_launch(void* const* d_in, const int* in_sizes, int n_in, void* d_out, int out_size, void* d_ws, size_t ws_size, hipStream_t stream) {
    static int grid = 0;
    if (grid == 0) {
        int dev = 0, cus = 0, per_cu = 0;
        hipGetDevice(&dev); hipDeviceGetAttribute(&cus, hipDeviceAttributeMultiprocessorCount, dev);
        if (hipFuncSetAttribute((const void*)mega_fwd, hipFuncAttributeMaxDynamicSharedMemorySize, LDS_BYTES) != hipSuccess) { fprintf(stderr, "hipFuncSetAttribute failed\n"); }
        if (hipOccupancyMaxActiveBlocksPerMultiprocessor(&per_cu, (const void*)mega_fwd, 512, LDS_BYTES) != hipSuccess || per_cu < 1) { fprintf(stderr, "occupancy query: %d\n", per_cu); per_cu = 1; }
        (void)hipGetLastError();
        grid = cus * per_cu;
        if (n_in != 18 || ws_size < 256 * MiB) fprintf(stderr, "unexpected n_in %d / ws %zu\n", n_in, ws_size);
    }
    Params p{};
    for (int i = 0; i < 18; ++i) p.in[i] = (const float*)d_in[i];
    p.out = (float*)d_out; p.ws = (unsigned char*)d_ws;
    void* args[] = {&p};
    hipError_t e = hipLaunchCooperativeKernel((const void*)mega_fwd, dim3(grid), dim3(512), args, LDS_BYTES, stream);
    if (e != hipSuccess) fprintf(stderr, "cooperative launch failed: %s (grid %d)\n", hipGetErrorString(e), grid);
}
```

```cpp
#include <hip/hip_runtime.h>
#include <hip/hip_cooperative_groups.h>
#include <cstdio>
#include <cstdint>
namespace cg = cooperative_groups;

#define DEVI __device__ __forceinline__
typedef unsigned short bf16_t;
typedef float f32x4 __attribute__((ext_vector_type(4)));
typedef unsigned u32x4 __attribute__((ext_vector_type(4)));
typedef unsigned u32x2 __attribute__((ext_vector_type(2)));

constexpr int BATCH = 2, T = 8192, D = 1024, M = BATCH * T, DFF = 2816, NMODS = 9 * D, INC = 8224;
constexpr float EPS = 1e-6f, LOG2E = 1.4426950408889634f;
constexpr float C2 = 0.125f * LOG2E;
constexpr float QA_SCALE = 0.08838834764831845f;

constexpr size_t MiB = 1u << 20;
constexpr size_t WS_CTL = 0;
constexpr size_t WS_WIN1 = 1 * MiB;
constexpr size_t WS_WIN2 = 11 * MiB;
constexpr size_t WS_WPA = 17 * MiB, WS_WPB = 19 * MiB, WS_WOUT = 21 * MiB;
constexpr size_t WS_MODS = 23 * MiB;
constexpr size_t WS_MODP = 23 * MiB + 128 * 1024;
constexpr size_t WS_DEC = 23 * MiB + 768 * 1024;
constexpr size_t WS_KMAX = 23 * MiB + 896 * 1024;
constexpr size_t WS_QMAX = 23 * MiB + 912 * 1024;
constexpr size_t WS_ALOW = 24 * MiB;
constexpr size_t WS_LOGF = 25 * MiB;
constexpr size_t WS_FCUM = 26 * MiB;
constexpr size_t WS_XN = 27 * MiB;
constexpr size_t WS_QA = 59 * MiB, WS_KA = 75 * MiB, WS_VA = 91 * MiB, WS_QB = 123 * MiB, WS_KB = 155 * MiB, WS_VB = 187 * MiB;
constexpr size_t WS_RA = 59 * MiB, WS_GA = 155 * MiB, WS_GB = 187 * MiB;
constexpr size_t WS_H = 59 * MiB;
constexpr size_t WS_Y = 147 * MiB;
constexpr size_t WS_Y2 = 59 * MiB;
constexpr size_t WS_WGU = 219 * MiB;
constexpr size_t WS_WDN = 230 * MiB;
constexpr size_t WS_U = 219 * MiB;
constexpr int LDS_BYTES = 147456;
#ifndef GLA_MFMA
#define GLA_MFMA 1
#endif

struct Params { const float* in[18]; float* out; unsigned char* ws; };
enum { I_X = 0, I_C, I_WADA, I_BADA, I_GPRE, I_GPOST, I_WGU1, I_WDN1, I_WGU2, I_WDN2, I_WIN, I_WA2, I_BA, I_BF, I_GGLA, I_WPA, I_WPB, I_WOUT };

DEVI float bf2f(bf16_t v) { return __uint_as_float((unsigned)v << 16); }
DEVI unsigned f2bf(float f) { unsigned u = __float_as_uint(f); return (u + 0x7fffu + ((u >> 16) & 1u)) >> 16; }
DEVI unsigned pk2(float lo, float hi) { return f2bf(lo) | (f2bf(hi) << 16); }
DEVI float wave_sum(float v) {
#pragma unroll
    for (int o = 1; o < 64; o <<= 1) v += __shfl_xor(v, o);
    return v;
}
DEVI float sigmoid_f(float x) { return 1.f / (1.f + __expf(-x)); }
DEVI float silu_f(float x) { return x / (1.f + __expf(-x)); }
DEVI float logsigmoid_f(float x) { return fminf(x, 0.f) - log1pf(__expf(-fabsf(x))); }
DEVI void unpack8(const u32x4 v, float* f) {
    f[0] = __uint_as_float(v.x << 16); f[1] = __uint_as_float(v.x & 0xffff0000u);
    f[2] = __uint_as_float(v.y << 16); f[3] = __uint_as_float(v.y & 0xffff0000u);
    f[4] = __uint_as_float(v.z << 16); f[5] = __uint_as_float(v.z & 0xffff0000u);
    f[6] = __uint_as_float(v.w << 16); f[7] = __uint_as_float(v.w & 0xffff0000u);
}

DEVI void transpose_item(const float* W, int K, int N, int k0, int srcn0, bf16_t* WT, int dstrow0, float* scr, int lane) {
#pragma unroll 8
    for (int i = 0; i < 32; ++i) { const int kk = 2 * i + (lane >> 5); scr[kk * 33 + (lane & 31)] = W[(size_t)(k0 + kk) * N + srcn0 + (lane & 31)]; }
    __builtin_amdgcn_s_waitcnt(0); __builtin_amdgcn_wave_barrier();
    const int c = lane & 7;
#pragma unroll
    for (int j = 0; j < 4; ++j) { const int n = (lane >> 3) + 8 * j; const float* s = scr + (8 * c) * 33 + n;
        u32x4 o; o.x = pk2(s[0 * 33], s[1 * 33]); o.y = pk2(s[2 * 33], s[3 * 33]); o.z = pk2(s[4 * 33], s[5 * 33]); o.w = pk2(s[6 * 33], s[7 * 33]);
        *(u32x4*)(WT + (size_t)(dstrow0 + n) * K + k0 + 8 * c) = o; }
    __builtin_amdgcn_s_waitcnt(0); __builtin_amdgcn_wave_barrier();
}
DEVI int src_win1(int r) { return r < 2048 ? r : r + 1040; }
DEVI int src_win2(int r) { return r < 1024 ? r + 2064 : r + 5152; }
DEVI int src_gu(int r) { const int t = r >> 8, w = r & 255; return w < 128 ? 128 * t + w : DFF + 128 * t + (w - 128); }

DEVI void convert_ffn_weights(const Params& p, unsigned char* lds, const float* wgu, const float* wdn) {
    const int lane = threadIdx.x & 63, wave = threadIdx.x >> 6;
    float* scr = (float*)(lds + wave * 16384);
    const int gw = blockIdx.x * 8 + wave, NGW = gridDim.x * 8;
    bf16_t* WGU = (bf16_t*)(p.ws + WS_WGU); bf16_t* WDN = (bf16_t*)(p.ws + WS_WDN);
    constexpr int I_GU = 16 * 176, I_DN = 44 * 32;
    for (int it = gw; it < I_GU + I_DN; it += NGW) {
        if (it < I_GU) { const int kb = it / 176, nb = it % 176; transpose_item(wgu, D, 2 * DFF, 64 * kb, src_gu(32 * nb), WGU, 32 * nb, scr, lane); }
        else { const int r = it - I_GU, kb = r / 32, nb = r % 32; transpose_item(wdn, DFF, D, 64 * kb, 32 * nb, WDN, 32 * nb, scr, lane); }
    }
}

DEVI void ph_prologue(const Params& p, unsigned char* lds) {
    const int tid = threadIdx.x, lane = tid & 63, wave = tid >> 6;
    float* sc = (float*)lds;
    for (int v = tid; v < 2 * D; v += 512) sc[v] = silu_f(p.in[I_C][v]);
    __syncthreads();
    {
        const int g = blockIdx.x * 512 + tid;
        if (g < 8 * NMODS) {
            const int ks = g / NMODS, j = g % NMODS; const float* w = p.in[I_WADA] + (size_t)(ks * 128) * NMODS + j;
            float s0 = 0.f, s1 = 0.f;
#pragma unroll 8
            for (int i = 0; i < 128; ++i) { const float wv = w[(size_t)i * NMODS]; s0 += sc[ks * 128 + i] * wv; s1 += sc[D + ks * 128 + i] * wv; }
            float* mp = (float*)(p.ws + WS_MODP);
            mp[(ks * 2 + 0) * NMODS + j] = s0; mp[(ks * 2 + 1) * NMODS + j] = s1;
        }
    }
    __syncthreads();
    for (int v = blockIdx.x * 512 + tid; v < 32 * 128 + 32 * 32; v += gridDim.x * 512) ((unsigned*)(p.ws + WS_KMAX))[v] = 0u;
    float* scr = (float*)(lds + wave * 16384);
    const int gw = blockIdx.x * 8 + wave, NGW = gridDim.x * 8;
    constexpr int I_W1 = 16 * 160, I_W2 = 16 * 96, I_P = 16 * 32;
    const float* win = p.in[I_WIN];
    for (int it = gw; it < I_W1 + I_W2 + 3 * I_P; it += NGW) {
        int r = it;
        if (r < I_W1) { const int kb = r / 160, nb = r % 160; transpose_item(win, D, INC, 64 * kb, src_win1(32 * nb), (bf16_t*)(p.ws + WS_WIN1), 32 * nb, scr, lane); continue; } r -= I_W1;
        if (r < I_W2) { const int kb = r / 96, nb = r % 96; transpose_item(win, D, INC, 64 * kb, src_win2(32 * nb), (bf16_t*)(p.ws + WS_WIN2), 32 * nb, scr, lane); continue; } r -= I_W2;
        const int w = r / I_P, q = r % I_P, kb = q / 32, nb = q % 32;
        const float* src = p.in[w == 0 ? I_WPA : (w == 1 ? I_WPB : I_WOUT)]; bf16_t* dst = (bf16_t*)(p.ws + (w == 0 ? WS_WPA : (w == 1 ? WS_WPB : WS_WOUT)));
        transpose_item(src, D, D, 64 * kb, 32 * nb, dst, 32 * nb, scr, lane);
    }
    convert_ffn_weights(p, lds, p.in[I_WGU1], p.in[I_WDN1]);
}

DEVI void ph_mods_xn1(const Params& p, unsigned char* lds) {
    const int tid = threadIdx.x, lane = tid & 63, wave = tid >> 6;
    const float* mp = (const float*)(p.ws + WS_MODP); float* mods = (float*)(p.ws + WS_MODS); const float* bada = p.in[I_BADA];
    for (int v = blockIdx.x * 512 + tid; v < 2 * NMODS; v += gridDim.x * 512) { const int b = v / NMODS, j = v % NMODS; float s = bada[j];
#pragma unroll
        for (int ks = 0; ks < 8; ++ks) s += mp[(ks * 2 + b) * NMODS + j];
        mods[v] = s; }
    float* lm = (float*)lds;
    for (int v = tid; v < 4096; v += 512) { const int b = v >> 11, j = v & 2047; float s = bada[j];
#pragma unroll
        for (int ks = 0; ks < 8; ++ks) s += mp[(ks * 2 + b) * NMODS + j];
        lm[v] = s; }
    __syncthreads();
    const int gw = blockIdx.x * 8 + wave, NGW = gridDim.x * 8;
    const float* gpre = p.in[I_GPRE]; bf16_t* XN = (bf16_t*)(p.ws + WS_XN);
    for (int m = gw; m < M; m += NGW) {
        const int b = m >> 13; const f32x4* xr = (const f32x4*)(p.in[I_X] + (size_t)m * D) + lane;
        f32x4 v[4]; float ss = 0.f;
#pragma unroll
        for (int j = 0; j < 4; ++j) { v[j] = xr[64 * j]; ss += (v[j].x * v[j].x + v[j].y * v[j].y) + (v[j].z * v[j].z + v[j].w * v[j].w); }
        const float rstd = rsqrtf(wave_sum(ss) * (1.f / D) + EPS);
        u32x2* o8 = (u32x2*)(XN + (size_t)m * D) + lane;
#pragma unroll
        for (int j = 0; j < 4; ++j) { const int col = 4 * lane + 256 * j; const f32x4 g = *(const f32x4*)(gpre + col);
            const f32x4 sh = *(const f32x4*)(lm + b * 2048 + col), s1 = *(const f32x4*)(lm + b * 2048 + 1024 + col);
            const f32x4 h = v[j] * rstd * g * (1.f + s1) + sh; u32x2 w; w.x = pk2(h.x, h.y); w.y = pk2(h.z, h.w); o8[64 * j] = w; }
    }
}

DEVI void ph_norm_res(const Params& p, const float* Y, const float* xin, float* xout, bool mk_xn, int sub  , float gs) {
    const int tid = threadIdx.x, lane = tid & 63, wave = tid >> 6;
    const int gw = blockIdx.x * 8 + wave, NGW = gridDim.x * 8;
    const float* mods = (const float*)(p.ws + WS_MODS); const float* gpost = p.in[I_GPOST] + sub * D; const float* gpre = p.in[I_GPRE] + (sub + 1) * D;
    bf16_t* XN = (bf16_t*)(p.ws + WS_XN);
    for (int m = gw; m < M; m += NGW) {
        const int b = m >> 13; const float* mb = mods + b * NMODS;
        const f32x4* yr = (const f32x4*)(Y + (size_t)m * D) + lane; const f32x4* xr = (const f32x4*)(xin + (size_t)m * D) + lane; f32x4* xo = (f32x4*)(xout + (size_t)m * D) + lane;
        f32x4 y[4]; float ss = 0.f;
#pragma unroll
        for (int j = 0; j < 4; ++j) { y[j] = yr[64 * j]; ss += (y[j].x * y[j].x + y[j].y * y[j].y) + (y[j].z * y[j].z + y[j].w * y[j].w); }
        const float rstd = rsqrtf(wave_sum(ss) * (1.f / D) + EPS); float s2 = 0.f;
#pragma unroll
        for (int j = 0; j < 4; ++j) { const int col = 4 * lane + 256 * j; const f32x4 g = *(const f32x4*)(gpost + col), gt = *(const f32x4*)(mb + (3 * sub + 2) * D + col);
            const f32x4 xn = xr[64 * j] + gs * gt * (y[j] * rstd * g); xo[64 * j] = xn; y[j] = xn; s2 += (xn.x * xn.x + xn.y * xn.y) + (xn.z * xn.z + xn.w * xn.w); }
        if (mk_xn) {
            const float r2 = rsqrtf(wave_sum(s2) * (1.f / D) + EPS); u32x2* o8 = (u32x2*)(XN + (size_t)m * D) + lane;
#pragma unroll
            for (int j = 0; j < 4; ++j) { const int col = 4 * lane + 256 * j; const f32x4 g = *(const f32x4*)(gpre + col);
                const f32x4 sh = *(const f32x4*)(mb + (3 * sub + 3) * D + col), s1 = *(const f32x4*)(mb + (3 * sub + 4) * D + col);
                const f32x4 h = y[j] * r2 * g * (1.f + s1) + sh; u32x2 w; w.x = pk2(h.x, h.y); w.y = pk2(h.z, h.w); o8[64 * j] = w; }
        }
    }
}

template <bool DUAL, class Epi>
DEVI void gemm_simple(unsigned char* lds, const bf16_t* A, const bf16_t* Bt, int Mrows, int Nlog, int K, const Epi& E) {
    float* As = (float*)lds; float* Bs = As + 32 * 132;
    const int tid = threadIdx.x, ty = tid >> 4, tx = tid & 15;
    const int LC = DUAL ? 64 : 128, ntn = Nlog / LC, ntiles = (Mrows / 128) * ntn;
    for (int tile = blockIdx.x; tile < ntiles; tile += gridDim.x) {
        const int tm = tile / ntn, tn = tile % ntn;
        float acc[4][8];
#pragma unroll
        for (int i = 0; i < 4; ++i)
#pragma unroll
            for (int j = 0; j < 8; ++j) acc[i][j] = 0.f;
        const int lr = tid >> 2, kc = (tid & 3) * 8;
        const int brow = DUAL ? ((tn >> 1) * 256 + (lr >= 64 ? 128 : 0) + (tn & 1) * 64 + (lr & 63)) : tn * 128 + lr;
        const bf16_t* ap = A + (size_t)(tm * 128 + lr) * K + kc; const bf16_t* bp = Bt + (size_t)brow * K + kc;
        for (int k0 = 0; k0 < K; k0 += 32) {
            float fa[8], fb[8]; unpack8(*(const u32x4*)(ap + k0), fa); unpack8(*(const u32x4*)(bp + k0), fb);
            __syncthreads();
#pragma unroll
            for (int i = 0; i < 8; ++i) { As[(kc + i) * 132 + lr] = fa[i]; Bs[(kc + i) * 132 + lr] = fb[i]; }
            __syncthreads();
#pragma unroll 8
            for (int kk = 0; kk < 32; ++kk) {
                const f32x4 a = *(const f32x4*)(As + kk * 132 + 4 * ty), b0 = *(const f32x4*)(Bs + kk * 132 + 4 * tx), b1 = *(const f32x4*)(Bs + kk * 132 + 64 + 4 * tx);
#pragma unroll
                for (int i = 0; i < 4; ++i) { acc[i][0] += a[i] * b0[0]; acc[i][1] += a[i] * b0[1]; acc[i][2] += a[i] * b0[2]; acc[i][3] += a[i] * b0[3];
                    acc[i][4] += a[i] * b1[0]; acc[i][5] += a[i] * b1[1]; acc[i][6] += a[i] * b1[2]; acc[i][7] += a[i] * b1[3]; }
            }
        }
#pragma unroll
        for (int i = 0; i < 4; ++i) { const int row = tm * 128 + 4 * ty + i;
            const f32x4 v0 = {acc[i][0], acc[i][1], acc[i][2], acc[i][3]}, v1 = {acc[i][4], acc[i][5], acc[i][6], acc[i][7]};
            if (DUAL) E(row, tn * 64 + 4 * tx, v0, v1);
            else { E(row, tn * 128 + 4 * tx, v0, v0); E(row, tn * 128 + 64 + 4 * tx, v1, v1); } }
    }
}

DEVI void st_bf4(bf16_t* p, f32x4 v) { u32x2 w; w.x = pk2(v.x, v.y); w.y = pk2(v.z, v.w); *(u32x2*)p = w; }
DEVI f32x4 ld_bf4(const bf16_t* p) { const u32x2 w = *(const u32x2*)p; return (f32x4){__uint_as_float(w.x << 16), __uint_as_float(w.x & 0xffff0000u), __uint_as_float(w.y << 16), __uint_as_float(w.y & 0xffff0000u)}; }
struct EpSwiglu { bf16_t* H; DEVI void operator()(int row, int col, f32x4 g, f32x4 u) const {
    f32x4 o; o.x = silu_f(g.x) * u.x; o.y = silu_f(g.y) * u.y; o.z = silu_f(g.z) * u.z; o.w = silu_f(g.w) * u.w; st_bf4(H + (size_t)row * DFF + col, o); } };
struct EpF32 { float* Y; DEVI void operator()(int row, int col, f32x4 v, f32x4) const { *(f32x4*)(Y + (size_t)row * D + col) = v; } };
struct EpWin1 { unsigned char* ws; DEVI void operator()(int row, int col, f32x4 v, f32x4) const {
    if (col < 512) st_bf4((bf16_t*)(ws + WS_QA) + (size_t)row * 512 + col, v * QA_SCALE);
    else if (col < 1024) st_bf4((bf16_t*)(ws + WS_KA) + (size_t)row * 512 + (col - 512), v);
    else if (col < 2048) st_bf4((bf16_t*)(ws + WS_VA) + (size_t)row * D + (col - 1024), v);
    else if (col < 3072) st_bf4((bf16_t*)(ws + WS_QB) + (size_t)row * D + (col - 2048), v * C2);
    else if (col < 4096) st_bf4((bf16_t*)(ws + WS_KB) + (size_t)row * D + (col - 3072), v);
    else st_bf4((bf16_t*)(ws + WS_VB) + (size_t)row * D + (col - 4096), v); } };
struct EpWin2 { unsigned char* ws; DEVI void operator()(int row, int col, f32x4 v, f32x4) const {
    if (col < 1024) { f32x4 o = {silu_f(v.x), silu_f(v.y), silu_f(v.z), silu_f(v.w)}; st_bf4((bf16_t*)(ws + WS_RA) + (size_t)row * D + col, o); }
    else { f32x4 o = {sigmoid_f(v.x), sigmoid_f(v.y), sigmoid_f(v.z), sigmoid_f(v.w)}; st_bf4((bf16_t*)(ws + (col < 2048 ? WS_GA : WS_GB)) + (size_t)row * D + (col & 1023), o); } } };
struct EpPa { bf16_t* GA; DEVI void operator()(int row, int col, f32x4 v, f32x4) const { bf16_t* q = GA + (size_t)row * D + col; st_bf4(q, ld_bf4(q) * v); } };
struct EpPb { const bf16_t* Tm; bf16_t* GB; DEVI void operator()(int row, int col, f32x4 v, f32x4) const { bf16_t* q = GB + (size_t)row * D + col; st_bf4(q, ld_bf4(Tm + (size_t)row * D + col) + ld_bf4(q) * v); } };

DEVI void ph_thin_cols(const Params& p) {
    const bf16_t* XN = (const bf16_t*)(p.ws + WS_XN); const float* win = p.in[I_WIN]; const float* bf = p.in[I_BF];
    float* alow = (float*)(p.ws + WS_ALOW); float* logf = (float*)(p.ws + WS_LOGF);
    for (int v = blockIdx.x * 512 + threadIdx.x; v < M * 32; v += gridDim.x * 512) {
        const int m = v >> 5, j = v & 31, col = j < 16 ? 2048 + j : 6160 + (j - 16);
        const bf16_t* xr = XN + (size_t)m * D; const float* w = win + col; float s = 0.f;
        for (int k = 0; k < D; k += 8) { float f[8]; unpack8(*(const u32x4*)(xr + k), f);
#pragma unroll
            for (int i = 0; i < 8; ++i) s += f[i] * w[(size_t)(k + i) * INC]; }
        if (j < 16) alow[m * 16 + j] = s; else logf[(size_t)((m >> 13) * 16 + (j - 16)) * T + (m & (T - 1))] = logsigmoid_f(s + bf[j - 16]);
    }
}
DEVI void ph_fcum(const Params& p, unsigned char* lds) {
    const int tid = threadIdx.x, lane = tid & 63, wave = tid >> 6;
    double* wt = (double*)lds;
    for (int bh = blockIdx.x; bh < 32; bh += gridDim.x) {
        const float* lf = (const float*)(p.ws + WS_LOGF) + (size_t)bh * T + tid * 16; float* fc = (float*)(p.ws + WS_FCUM) + (size_t)bh * T + tid * 16;
        f32x4 v[4]; double s = 0.0;
#pragma unroll
        for (int i = 0; i < 4; ++i) { v[i] = ((const f32x4*)lf)[i]; s += ((double)v[i].x + (double)v[i].y) + ((double)v[i].z + (double)v[i].w); }
        double incl = s;
#pragma unroll
        for (int o = 1; o < 64; o <<= 1) { const double t = __shfl_up(incl, o); if (lane >= o) incl += t; }
        __syncthreads();
        if (lane == 63) wt[wave] = incl;
        __syncthreads();
        double run = incl - s;
        for (int w = 0; w < wave; ++w) run += wt[w];
#pragma unroll
        for (int i = 0; i < 4; ++i) { f32x4 o; run += (double)v[i].x; o.x = (float)run; run += (double)v[i].y; o.y = (float)run; run += (double)v[i].z; o.z = (float)run; run += (double)v[i].w; o.w = (float)run; ((f32x4*)fc)[i] = o; }
    }
    __syncthreads();
}
DEVI void ph_qk_norms(const Params& p) {
    const int lane = threadIdx.x & 63, gw = blockIdx.x * 8 + (threadIdx.x >> 6), NGW = gridDim.x * 8;
    const bf16_t* QB = (const bf16_t*)(p.ws + WS_QB); const bf16_t* KB = (const bf16_t*)(p.ws + WS_KB);
    unsigned* kmax = (unsigned*)(p.ws + WS_KMAX); unsigned* qmax = (unsigned*)(p.ws + WS_QMAX);
    for (int g = gw; g < M / 8; g += NGW) {
        float qm = 0.f, km = 0.f;
        for (int r = 0; r < 8; ++r) { const size_t off = (size_t)(g * 8 + r) * D + 16 * lane; float f[16];
            unpack8(*(const u32x4*)(QB + off), f); unpack8(*(const u32x4*)(QB + off + 8), f + 8); float sq = 0.f;
#pragma unroll
            for (int i = 0; i < 16; ++i) sq += f[i] * f[i];
            unpack8(*(const u32x4*)(KB + off), f); unpack8(*(const u32x4*)(KB + off + 8), f + 8); float sk = 0.f;
#pragma unroll
            for (int i = 0; i < 16; ++i) sk += f[i] * f[i];
            sq += __shfl_xor(sq, 1); sq += __shfl_xor(sq, 2); sk += __shfl_xor(sk, 1); sk += __shfl_xor(sk, 2);
            qm = fmaxf(qm, sq); km = fmaxf(km, sk); }
        if ((lane & 3) == 0) { const int row0 = g * 8, b = row0 >> 13, t = row0 & (T - 1), bh = b * 16 + (lane >> 2);
            atomicMax(kmax + bh * 128 + (t >> 6), __float_as_uint(km)); atomicMax(qmax + bh * 32 + (t >> 8), __float_as_uint(qm)); }
    }
}

template <bool OUT>
DEVI void gla_rec(const Params& p, unsigned char* lds, int unit) {
    const int j = unit & 31, bh = unit >> 5, h = bh & 3, b = bh >> 2;
    const int tid = threadIdx.x, e = tid & 255, dh = tid >> 8, d0 = dh * 64;
    float* qs = (float*)lds; float* ks = qs + 2048; float* al = ks + 2048; float* vs = al + 2048; float* red = vs + 4096; float* lsum = red + 8192;
    float* U = (float*)(p.ws + WS_U) + (size_t)unit * 32768;
    const bf16_t* QA = (const bf16_t*)(p.ws + WS_QA); const bf16_t* KA = (const bf16_t*)(p.ws + WS_KA); bf16_t* VA = (bf16_t*)(p.ws + WS_VA);
    const float* alow = (const float*)(p.ws + WS_ALOW);
    float S[64];
#pragma unroll
    for (int i = 0; i < 64; ++i) S[i] = OUT ? U[(d0 + i) * 256 + e] : 0.f;
    const int dd = tid & 127, tq = tid >> 7;
    float wa[16];
#pragma unroll
    for (int r = 0; r < 16; ++r) wa[r] = p.in[I_WA2][r * 512 + h * 128 + dd];
    const float ba = p.in[I_BA][h * 128 + dd];
    float lacc = 0.f;
    for (int sb = 0; sb < 16; ++sb) {
        const int t0 = b * T + j * 256 + sb * 16;
#pragma unroll
        for (int r = 0; r < 4; ++r) { const int tt = tq + 4 * r; const size_t row = (size_t)(t0 + tt);
            const f32x4* ar = (const f32x4*)(alow + row * 16); float s = ba;
#pragma unroll
            for (int q4 = 0; q4 < 4; ++q4) { const f32x4 a = ar[q4]; s += a.x * wa[4 * q4] + a.y * wa[4 * q4 + 1] + a.z * wa[4 * q4 + 2] + a.w * wa[4 * q4 + 3]; }
            const float la = logsigmoid_f(s) * (1.f / 16.f); lacc += la; al[tt * 128 + dd] = __expf(la);
            qs[tt * 128 + dd] = bf2f(QA[row * 512 + h * 128 + dd]); ks[tt * 128 + dd] = bf2f(KA[row * 512 + h * 128 + dd]); }
#pragma unroll
        for (int r = 0; r < 8; ++r) { const int idx = tid + 512 * r, tt = idx >> 8, ee = idx & 255; vs[idx] = bf2f(VA[(size_t)(t0 + tt) * D + h * 256 + ee]); }
        __syncthreads();
        for (int tt = 0; tt < 16; ++tt) {
            const float v = vs[tt * 256 + e]; float acc = 0.f;
            const float* alp = al + tt * 128 + d0; const float* kp = ks + tt * 128 + d0; const float* qp = qs + tt * 128 + d0;
#pragma unroll
            for (int i = 0; i < 64; ++i) { S[i] = alp[i] * S[i] + kp[i] * v; if (OUT) acc += qp[i] * S[i]; }
            if (OUT) red[(tt * 2 + dh) * 256 + e] = acc;
        }
        __syncthreads();
        if (OUT) {
#pragma unroll
            for (int r = 0; r < 8; ++r) { const int idx = tid + 512 * r, tt = idx >> 8, ee = idx & 255;
                VA[(size_t)(t0 + tt) * D + h * 256 + ee] = (bf16_t)f2bf(red[(tt * 2) * 256 + ee] + red[(tt * 2 + 1) * 256 + ee]); }
        }
    }
    if (!OUT) {
#pragma unroll
        for (int i = 0; i < 64; ++i) U[(d0 + i) * 256 + e] = S[i];
        lsum[tq * 128 + dd] = lacc; __syncthreads();
        if (tid < 128) ((float*)(p.ws + WS_DEC))[unit * 128 + tid] = __expf(lsum[tid] + lsum[128 + tid] + lsum[256 + tid] + lsum[384 + tid]);
    }
    __syncthreads();
}

#define LAS3 __attribute__((address_space(3)))
typedef short v4i16_t __attribute__((ext_vector_type(4)));
typedef short bf16x8_t __attribute__((ext_vector_type(8)));
typedef float f32x16_t __attribute__((ext_vector_type(16)));
constexpr size_t WS_E127 = 23 * MiB + 640 * 1024;
DEVI bf16x8_t tr_pair(const LAS3 char* p0, const LAS3 char* p1) {
    const v4i16_t a = __builtin_amdgcn_ds_read_tr16_b64_v4i16((LAS3 v4i16_t*)p0), b = __builtin_amdgcn_ds_read_tr16_b64_v4i16((LAS3 v4i16_t*)p1);
    return (bf16x8_t){a[0], a[1], a[2], a[3], b[0], b[1], b[2], b[3]};
}
DEVI int crow16(int r, int hi) { return (r & 3) + 8 * (r >> 2) + 4 * hi; }
DEVI float exp_cl(float x) { return __expf(fminf(x, 80.f)); }

DEVI void gla_passA(const Params& p, unsigned char* ldsg, int unit) {
    constexpr int KEP = 320, VP = 576, LV = 256 * KEP, LX = LV + 64 * VP;
    const int j = unit & 31, bh = unit >> 5, h = bh & 3, b = bh >> 2;
    int tid_ = threadIdx.x; asm volatile("" : "+v"(tid_));
    const int tid = tid_, lane = tid & 63, wave = __builtin_amdgcn_readfirstlane(tid >> 6), hi = lane >> 5;
    LAS3 char* lds = (LAS3 char*)ldsg; LAS3 float* tot = (LAS3 float*)(lds + LX); LAS3 float* scl = tot + 512;
    const size_t row0 = (size_t)b * T + j * 256;
    bf16_t* QA = (bf16_t*)(p.ws + WS_QA); bf16_t* KA = (bf16_t*)(p.ws + WS_KA); const bf16_t* VA = (const bf16_t*)(p.ws + WS_VA);
    const float* alow = (const float*)(p.ws + WS_ALOW);
    {
        const int dd = tid & 127, tq = tid >> 7;
        float wa[16];
#pragma unroll
        for (int r = 0; r < 16; ++r) wa[r] = p.in[I_WA2][r * 512 + h * 128 + dd];
        const float ba = p.in[I_BA][h * 128 + dd];
        float la[64]; float cum = 0.f;
#pragma unroll
        for (int i = 0; i < 64; ++i) { const f32x4* ar = (const f32x4*)(alow + (row0 + 64 * tq + i) * 16); float s = ba;
#pragma unroll
            for (int q4 = 0; q4 < 4; ++q4) { const f32x4 a = ar[q4]; s += a.x * wa[4 * q4] + a.y * wa[4 * q4 + 1] + a.z * wa[4 * q4 + 2] + a.w * wa[4 * q4 + 3]; }
            cum += logsigmoid_f(s) * (1.f / 16.f); la[i] = cum; }
        tot[tq * 128 + dd] = cum;
        __syncthreads();
        const float t0 = tot[dd], t1 = tot[128 + dd], t2 = tot[256 + dd], t3 = tot[384 + dd];
        const float off = tq == 0 ? 0.f : (tq == 1 ? t0 : (tq == 2 ? t0 + t1 : t0 + t1 + t2)), b127 = t0 + t1, b255 = b127 + t2 + t3;
#pragma unroll
        for (int i = 0; i < 64; ++i) { const float bt = off + la[i]; const size_t g = (row0 + 64 * tq + i) * 512 + h * 128 + dd;
            const unsigned qe = f2bf(bf2f(QA[g]) * exp_cl(bt - b127)), ke = f2bf(bf2f(KA[g]) * exp_cl(b127 - bt));
            QA[g] = (bf16_t)qe; KA[g] = (bf16_t)ke; *(LAS3 bf16_t*)(lds + (64 * tq + i) * KEP + dd * 2) = (bf16_t)ke; }
        if (tq == 0) { ((float*)(p.ws + WS_E127))[unit * 128 + dd] = __expf(b127); ((float*)(p.ws + WS_DEC))[unit * 128 + dd] = __expf(b255); scl[dd] = __expf(b255 - b127); }
    }
    const int db = wave & 3, eb0 = 4 * (wave >> 2), q4l = (lane & 15) >> 2, pl = lane & 3, chl = (lane >> 4) & 1;
    f32x16_t acc[4];
#pragma unroll
    for (int i = 0; i < 4; ++i) acc[i] = f32x16_t{};
    for (int R = 0; R < 4; ++R) {
        __syncthreads();
#pragma unroll
        for (int i = 0; i < 4; ++i) { const int c = tid + 512 * i, row = c >> 5, ch = c & 31;
            *(LAS3 u32x4*)(lds + LV + row * VP + ch * 16) = *(const u32x4*)(VA + (row0 + 64 * R + row) * D + h * 256 + 8 * ch); }
        __syncthreads();
#pragma unroll
        for (int g = 0; g < 4; ++g) {
            const LAS3 char* ka = lds + (64 * R + 16 * g + 8 * hi + q4l) * KEP + (32 * db + 16 * chl + 4 * pl) * 2;
            const bf16x8_t A = tr_pair(ka, ka + 4 * KEP);
            const LAS3 char* va = lds + LV + (16 * g + 8 * hi + q4l) * VP + (16 * chl + 4 * pl) * 2;
#pragma unroll
            for (int e4 = 0; e4 < 4; ++e4) { const bf16x8_t B = tr_pair(va + (eb0 + e4) * 64, va + (eb0 + e4) * 64 + 4 * VP);
                acc[e4] = __builtin_amdgcn_mfma_f32_32x32x16_bf16(A, B, acc[e4], 0, 0, 0); }
        }
    }
    float* U = (float*)(p.ws + WS_U) + (size_t)unit * 32768;
#pragma unroll
    for (int e4 = 0; e4 < 4; ++e4)
#pragma unroll
        for (int r = 0; r < 16; ++r) { const int d = 32 * db + crow16(r, hi); U[d * 256 + 32 * (eb0 + e4) + (lane & 31)] = scl[d] * acc[e4][r]; }
    __syncthreads();
}

DEVI void gla_passC(const Params& p, unsigned char* ldsg, int unit) {
    constexpr int SP = 272, VP = 576, KEO = 128 * VP, KEP = 272;
    const int j = unit & 31, bh = unit >> 5, h = bh & 3, b = bh >> 2;
    int tid_ = threadIdx.x; asm volatile("" : "+v"(tid_));
    const int tid = tid_, lane = tid & 63, wave = __builtin_amdgcn_readfirstlane(tid >> 6), hi = lane >> 5, l31 = lane & 31;
    LAS3 char* lds = (LAS3 char*)ldsg;
    const size_t row0 = (size_t)b * T + j * 256;
    const bf16_t* QA = (const bf16_t*)(p.ws + WS_QA); const bf16_t* KA = (const bf16_t*)(p.ws + WS_KA); bf16_t* VA = (bf16_t*)(p.ws + WS_VA);
#pragma unroll
    for (int i = 0; i < 8; ++i) { const int c = tid + 512 * i, row = c >> 4, ch = c & 15;
        *(LAS3 u32x4*)(lds + KEO + row * KEP + ch * 16) = *(const u32x4*)(KA + (row0 + row) * 512 + h * 128 + 8 * ch); }
    { const float* S = (const float*)(p.ws + WS_U) + (size_t)unit * 32768; const float* e127 = (const float*)(p.ws + WS_E127) + unit * 128;
#pragma unroll
      for (int i = 0; i < 8; ++i) { const int it = tid + 512 * i, e = it & 255, d0 = (it >> 8) * 8; float v[8];
#pragma unroll
          for (int q = 0; q < 8; ++q) v[q] = S[(d0 + q) * 256 + e] * e127[d0 + q];
          u32x4 w; w.x = pk2(v[0], v[1]); w.y = pk2(v[2], v[3]); w.z = pk2(v[4], v[5]); w.w = pk2(v[6], v[7]);
          *(LAS3 u32x4*)(lds + e * SP + d0 * 2) = w; } }
    const int tb = wave < 4 ? wave : 11 - wave;
    bf16x8_t qf[8];
#pragma unroll
    for (int g = 0; g < 8; ++g) qf[g] = *(const bf16x8_t*)(QA + (row0 + 32 * tb + l31) * 512 + h * 128 + 16 * g + 8 * hi);
    f32x16_t o[8];
#pragma unroll
    for (int i = 0; i < 8; ++i) o[i] = f32x16_t{};
    __syncthreads();
#pragma unroll
    for (int eb = 0; eb < 8; ++eb)
#pragma unroll
        for (int g = 0; g < 8; ++g) { const bf16x8_t B = *(const LAS3 bf16x8_t*)(lds + (32 * eb + l31) * SP + (16 * g + 8 * hi) * 2);
            o[eb] = __builtin_amdgcn_mfma_f32_32x32x16_bf16(qf[g], B, o[eb], 0, 0, 0); }
    const int q4l = (lane & 15) >> 2, pl = lane & 3, chl = (lane >> 4) & 1;
    for (int R = 0; R < 2; ++R) {
        __syncthreads();
#pragma unroll
        for (int i = 0; i < 8; ++i) { const int c = tid + 512 * i, row = c >> 5, ch = c & 31;
            *(LAS3 u32x4*)(lds + row * VP + ch * 16) = *(const u32x4*)(VA + (row0 + 128 * R + row) * D + h * 256 + 8 * ch); }
        __syncthreads();
        if (tb >= 4 * R) {
            const int sbe = tb < 4 * R + 3 ? tb : 4 * R + 3;
            for (int sb = 4 * R; sb <= sbe; ++sb) {
                f32x16_t st = f32x16_t{};
#pragma unroll
                for (int g = 0; g < 8; ++g) { const bf16x8_t A = *(const LAS3 bf16x8_t*)(lds + KEO + (32 * sb + l31) * KEP + (16 * g + 8 * hi) * 2);
                    st = __builtin_amdgcn_mfma_f32_32x32x16_bf16(A, qf[g], st, 0, 0, 0); }
                if (sb == tb) {
#pragma unroll
                    for (int r = 0; r < 16; ++r) if (crow16(r, hi) > l31) st[r] = 0.f;
                }
                u32x4 w0, w1;
                w0.x = pk2(st[0], st[1]); w0.y = pk2(st[2], st[3]); w0.z = pk2(st[4], st[5]); w0.w = pk2(st[6], st[7]);
                w1.x = pk2(st[8], st[9]); w1.y = pk2(st[10], st[11]); w1.z = pk2(st[12], st[13]); w1.w = pk2(st[14], st[15]);
                const bf16x8_t pa0 = __builtin_bit_cast(bf16x8_t, w0), pa1 = __builtin_bit_cast(bf16x8_t, w1);
                const LAS3 char* vb = lds + ((32 * sb - 128 * R) + 4 * hi + q4l) * VP + (16 * chl + 4 * pl) * 2;
#pragma unroll
                for (int eb = 0; eb < 8; ++eb) {
                    const bf16x8_t B0 = tr_pair(vb + eb * 64, vb + eb * 64 + 8 * VP), B1 = tr_pair(vb + eb * 64 + 16 * VP, vb + eb * 64 + 24 * VP);
                    o[eb] = __builtin_amdgcn_mfma_f32_32x32x16_bf16(pa0, B0, o[eb], 0, 0, 0);
                    o[eb] = __builtin_amdgcn_mfma_f32_32x32x16_bf16(pa1, B1, o[eb], 0, 0, 0); }
            }
        }
    }
    __syncthreads();
    const float* gg = p.in[I_GGLA] + h * 256;
    float gv[8];
#pragma unroll
    for (int eb = 0; eb < 8; ++eb) gv[eb] = gg[32 * eb + l31];
#pragma unroll
    for (int r = 0; r < 16; ++r) { float ss = 0.f;
#pragma unroll
        for (int eb = 0; eb < 8; ++eb) ss += o[eb][r] * o[eb][r];
        ss += __shfl_xor(ss, 1); ss += __shfl_xor(ss, 2); ss += __shfl_xor(ss, 4); ss += __shfl_xor(ss, 8); ss += __shfl_xor(ss, 16);
        const float rstd = rsqrtf(ss * (1.f / 256.f) + EPS); bf16_t* op = VA + (row0 + 32 * tb + crow16(r, hi)) * D + h * 256 + l31;
#pragma unroll
        for (int eb = 0; eb < 8; ++eb) op[32 * eb] = (bf16_t)f2bf(o[eb][r] * rstd * gv[eb]); }
    __syncthreads();
}
DEVI void ph_gla_scan(const Params& p) {
    float* U = (float*)(p.ws + WS_U); const float* dec = (const float*)(p.ws + WS_DEC);
    for (int v = blockIdx.x * 512 + threadIdx.x; v < 8 * 32768; v += gridDim.x * 512) {
        const int bh = v >> 15, de = v & 32767, d = de >> 8; float s = 0.f;
        for (int j = 0; j < 32; ++j) { const int unit = bh * 32 + j; float* q = U + (size_t)unit * 32768 + de; const float u = *q; *q = s; s = dec[unit * 128 + d] * s + u; }
    }
}
DEVI void ph_oa_norm(const Params& p) {
    const int lane = threadIdx.x & 63, gw = blockIdx.x * 8 + (threadIdx.x >> 6), NGW = gridDim.x * 8;
    bf16_t* OA = (bf16_t*)(p.ws + WS_VA); const bf16_t* RA = (const bf16_t*)(p.ws + WS_RA); const float* gg = p.in[I_GGLA];
    for (int m = gw; m < M; m += NGW) {
        bf16_t* op = OA + (size_t)m * D + 16 * lane; const bf16_t* rp = RA + (size_t)m * D + 16 * lane;
        float o[16], r[16]; unpack8(*(const u32x4*)op, o); unpack8(*(const u32x4*)(op + 8), o + 8); unpack8(*(const u32x4*)rp, r); unpack8(*(const u32x4*)(rp + 8), r + 8);
        float ss = 0.f;
#pragma unroll
        for (int i = 0; i < 16; ++i) ss += o[i] * o[i];
        ss += __shfl_xor(ss, 1); ss += __shfl_xor(ss, 2); ss += __shfl_xor(ss, 4); ss += __shfl_xor(ss, 8);
        const float rstd = rsqrtf(ss * (1.f / 256.f) + EPS);
        u32x4 w0, w1; float t[16];
#pragma unroll
        for (int i = 0; i < 16; ++i) t[i] = o[i] * rstd * gg[16 * lane + i] * r[i];
        w0.x = pk2(t[0], t[1]); w0.y = pk2(t[2], t[3]); w0.z = pk2(t[4], t[5]); w0.w = pk2(t[6], t[7]);
        w1.x = pk2(t[8], t[9]); w1.y = pk2(t[10], t[11]); w1.z = pk2(t[12], t[13]); w1.w = pk2(t[14], t[15]);
        *(u32x4*)op = w0; *(u32x4*)(op + 8) = w1;
    }
}

DEVI void attn_simple_unit(const Params& p, unsigned char* lds, int unit) {
    const int qb = 15 - (unit >> 5), bh = unit & 31, b = bh >> 4, hh = bh & 15;
    float* Ks = (float*)lds; float* Vs = Ks + 4096; float* bs = Vs + 4096;
    const int tid = threadIdx.x, t = qb * 512 + tid; const size_t row = (size_t)(b * T + t);
    bf16_t* QB = (bf16_t*)(p.ws + WS_QB); const bf16_t* KB = (const bf16_t*)(p.ws + WS_KB); const bf16_t* VB = (const bf16_t*)(p.ws + WS_VB);
    const float* fc = (const float*)(p.ws + WS_FCUM) + (size_t)bh * T;
    float q[64], o[64];
#pragma unroll
    for (int i = 0; i < 8; ++i) unpack8(*(const u32x4*)(QB + row * D + hh * 64 + 8 * i), q + 8 * i);
#pragma unroll
    for (int i = 0; i < 64; ++i) o[i] = 0.f;
    float mx = -1e30f, l = 0.f; const float Fq0 = fc[qb * 512];
    const int nkt = (qb * 512 + 512) / 64;
    for (int kt = 0; kt < nkt; ++kt) {
        __syncthreads();
        { const int key = tid >> 3, c = (tid & 7) * 8; const size_t g = (size_t)(b * T + kt * 64 + key) * D + hh * 64 + c;
          unpack8(*(const u32x4*)(KB + g), Ks + key * 64 + c); unpack8(*(const u32x4*)(VB + g), Vs + key * 64 + c); }
        if (tid < 64) bs[tid] = (Fq0 - fc[kt * 64 + tid]) * LOG2E;
        __syncthreads();
        const int smax = t - kt * 64;
        for (int s = 0; s < 64; ++s) {
            if (s <= smax) {
                float sc = bs[s]; const float* kr = Ks + s * 64;
#pragma unroll
                for (int i = 0; i < 64; ++i) sc += q[i] * kr[i];
                if (sc > mx + 8.f) { const float f = exp2f(mx - sc); l *= f;
#pragma unroll
                    for (int i = 0; i < 64; ++i) o[i] *= f;
                    mx = sc; }
                const float pr = exp2f(sc - mx); l += pr; const float* vr = Vs + s * 64;
#pragma unroll
                for (int i = 0; i < 64; ++i) o[i] += pr * vr[i];
            }
        }
    }
    const float inv = 1.f / l;
#pragma unroll
    for (int i = 0; i < 8; ++i) { u32x4 w; w.x = pk2(o[8 * i] * inv, o[8 * i + 1] * inv); w.y = pk2(o[8 * i + 2] * inv, o[8 * i + 3] * inv); w.z = pk2(o[8 * i + 4] * inv, o[8 * i + 5] * inv); w.w = pk2(o[8 * i + 6] * inv, o[8 * i + 7] * inv);
        *(u32x4*)(QB + row * D + hh * 64 + 8 * i) = w; }
    __syncthreads();
}

namespace pg8 {
#define PG8_LAS __attribute__((address_space(3)))
typedef unsigned short bf16_t;
typedef short bf16x8 __attribute__((ext_vector_type(8)));
typedef float f32x4 __attribute__((ext_vector_type(4)));
typedef unsigned u32x4 __attribute__((ext_vector_type(4)));
constexpr int BM = 256, BK = 64, HALF = 128, HTB = HALF * BK * 2  , STAGE_BYTES = 8 * HTB, NXCD = 8, WGM = 8;

__host__ __device__ __forceinline__ int lds_byte(int r, int c) { const int st = (r >> 4) * 2 + (c >> 5), rr = r & 15, cc = c & 31, ob = rr * 64 + cc * 2; return st * 1024 + (ob ^ (((ob >> 9) & 1) << 5)); }
__host__ __device__ __forceinline__ void stage_rc(int b, int& R, int& C) { const int st = b / 1024, sb = b % 1024, swz = sb ^ (((sb >> 9) & 1) << 5); R = (st >> 1) * 16 + swz / 64; C = (st & 1) * 32 + (swz % 64) / 2; }
__host__ __device__ __forceinline__ int perm32(int rho) { const int n = rho >> 4, i = rho & 15; return 8 * (i >> 2) + 4 * n + (i & 3); }

struct Unit { int pm, pn; };
struct Gemm { const bf16_t* A; const bf16_t* Bt; int M, N, K; };

struct StaticOrder {
    int nM, nN, nwg, G, c;
    __host__ __device__ void init(int M, int N, int G_, int c_) { nM = M / BM; nN = N / BM; nwg = nM * nN; G = G_; c = c_; }
    __host__ __device__ bool next(int i, Unit& u) const {
        const long L = (long)i * G + c; if (L >= nwg) return false;
        int wgid = (int)L; { const int q = nwg / NXCD, r = nwg % NXCD, xcd = wgid % NXCD, off = wgid / NXCD; wgid = (xcd < r ? xcd * (q + 1) : r * (q + 1) + (xcd - r) * q) + off; }
        const int nig = WGM * nN, gid = wgid / nig, fm = gid * WGM, gsz = (nM - fm) < WGM ? (nM - fm) : WGM;
        u.pm = fm + ((wgid % nig) % gsz); u.pn = (wgid % nig) / gsz; return true;
    }
    __device__ __forceinline__ void a_ready(const Unit&) const {}
    __device__ __forceinline__ void done(const Unit&) const {}
};

__device__ __forceinline__ unsigned cvt_pk_bf16(float lo, float hi) { unsigned r; asm volatile("v_cvt_pk_bf16_f32 %0, %1, %2" : "=v"(r) : "v"(lo), "v"(hi)); return r; }
typedef float f32x2 __attribute__((ext_vector_type(2)));

__device__ __forceinline__ float silu_fast(float x) { return x * __builtin_amdgcn_rcpf(1.f + __expf(-x)); }
__device__ __forceinline__ float sigm_fast(float x) { return __builtin_amdgcn_rcpf(1.f + __expf(-x)); }
__device__ __forceinline__ u32x4 pack8(const f32x4 a, const f32x4 b) { u32x4 w; w.x = cvt_pk_bf16(a[0], a[1]); w.y = cvt_pk_bf16(a[2], a[3]); w.z = cvt_pk_bf16(b[0], b[1]); w.w = cvt_pk_bf16(b[2], b[3]); return w; }
__device__ __forceinline__ void unpack8v(const u32x4 v, f32x4& a, f32x4& b) {
    a[0] = __uint_as_float(v.x << 16); a[1] = __uint_as_float(v.x & 0xffff0000u); a[2] = __uint_as_float(v.y << 16); a[3] = __uint_as_float(v.y & 0xffff0000u);
    b[0] = __uint_as_float(v.z << 16); b[1] = __uint_as_float(v.z & 0xffff0000u); b[2] = __uint_as_float(v.w << 16); b[3] = __uint_as_float(v.w & 0xffff0000u); }
struct EpiSwiglu { static constexpr bool PERM = true, AFTER_DRAIN = false; bf16_t* H; int ldh;
    __device__ __forceinline__ void operator()(const f32x4 (&acc)[2][2][4][2], const Unit& u, int wr, int wc, int fr, int fq) const {
        const int row0 = u.pm * BM + wr * 64 + fr, col0 = u.pn * HALF + wc * 32 + 8 * fq;
#pragma unroll
        for (int ai = 0; ai < 2; ++ai)
#pragma unroll
            for (int m = 0; m < 4; ++m) { f32x4 o0, o1;
#pragma unroll
                for (int i = 0; i < 4; ++i) { o0[i] = silu_fast(acc[ai][0][m][0][i]) * acc[ai][1][m][0][i]; o1[i] = silu_fast(acc[ai][0][m][1][i]) * acc[ai][1][m][1][i]; }
                *(u32x4*)(H + (size_t)(row0 + ai * HALF + m * 16) * ldh + col0) = pack8(o0, o1); }
    }
};
struct Seg { bf16_t* base; int ld, colt, act; float sc; };
struct EpiSeg { static constexpr bool PERM = true, AFTER_DRAIN = false; unsigned char* ws; int which;
    __device__ __forceinline__ Seg seg(int pn) const { Seg s; s.sc = 1.f; s.act = 0;
        if (which == 0) {
            if (pn < 2) { s.base = (bf16_t*)(ws + WS_QA); s.ld = 512; s.colt = pn * 256; s.sc = QA_SCALE; }
            else if (pn < 4) { s.base = (bf16_t*)(ws + WS_KA); s.ld = 512; s.colt = (pn - 2) * 256; }
            else if (pn < 8) { s.base = (bf16_t*)(ws + WS_VA); s.ld = 1024; s.colt = (pn - 4) * 256; }
            else if (pn < 12) { s.base = (bf16_t*)(ws + WS_QB); s.ld = 1024; s.colt = (pn - 8) * 256; s.sc = C2; }
            else if (pn < 16) { s.base = (bf16_t*)(ws + WS_KB); s.ld = 1024; s.colt = (pn - 12) * 256; }
            else { s.base = (bf16_t*)(ws + WS_VB); s.ld = 1024; s.colt = (pn - 16) * 256; }
        } else {
            s.ld = 1024; s.colt = (pn & 3) * 256;
            if (pn < 4) { s.base = (bf16_t*)(ws + (which == 2 ? WS_VA : WS_RA)); s.act = which == 2 ? 3 : 1; } else if (pn < 8) { s.base = (bf16_t*)(ws + WS_GA); s.act = 2; } else { s.base = (bf16_t*)(ws + WS_GB); s.act = 2; }
        }
        return s; }
    __device__ __forceinline__ void operator()(const f32x4 (&acc)[2][2][4][2], const Unit& u, int wr, int wc, int fr, int fq) const {
        const Seg s = seg(u.pn); const int row0 = u.pm * BM + wr * 64 + fr, col0 = s.colt + wc * 32 + 8 * fq;
#pragma unroll
        for (int ai = 0; ai < 2; ++ai)
#pragma unroll
            for (int m = 0; m < 4; ++m) { bf16_t* rowp = s.base + (size_t)(row0 + ai * HALF + m * 16) * s.ld + col0;
#pragma unroll
                for (int bj = 0; bj < 2; ++bj) { f32x4 v0 = acc[ai][bj][m][0], v1 = acc[ai][bj][m][1];
                    if (s.act == 1) {
#pragma unroll
                        for (int i = 0; i < 4; ++i) { v0[i] = silu_fast(v0[i]); v1[i] = silu_fast(v1[i]); } }
                    else if (s.act == 2) {
#pragma unroll
                        for (int i = 0; i < 4; ++i) { v0[i] = sigm_fast(v0[i]); v1[i] = sigm_fast(v1[i]); } }
                    else if (s.act == 3) { f32x4 a0, a1; unpack8v(*(const u32x4*)(rowp + bj * HALF), a0, a1);
#pragma unroll
                        for (int i = 0; i < 4; ++i) { v0[i] = a0[i] * silu_fast(v0[i]); v1[i] = a1[i] * silu_fast(v1[i]); } }
                    else { v0 = v0 * s.sc; v1 = v1 * s.sc; }
                    *(u32x4*)(rowp + bj * HALF) = pack8(v0, v1); } }
    }
};
template <int MODE> struct EpiGate { static constexpr bool PERM = true, AFTER_DRAIN = false; bf16_t* G; const bf16_t* Tm;
    __device__ __forceinline__ void operator()(const f32x4 (&acc)[2][2][4][2], const Unit& u, int wr, int wc, int fr, int fq) const {
        const int row0 = u.pm * BM + wr * 64 + fr, col0 = u.pn * BM + wc * 32 + 8 * fq;
#pragma unroll
        for (int ai = 0; ai < 2; ++ai)
#pragma unroll
            for (int m = 0; m < 4; ++m) { const size_t off = (size_t)(row0 + ai * HALF + m * 16) * D + col0;
#pragma unroll
                for (int bj = 0; bj < 2; ++bj) { f32x4 g0, g1; unpack8v(*(const u32x4*)(G + off + bj * HALF), g0, g1);
                    f32x4 v0 = g0 * acc[ai][bj][m][0], v1 = g1 * acc[ai][bj][m][1];
                    if (MODE == 1) { f32x4 t0, t1; unpack8v(*(const u32x4*)(Tm + off + bj * HALF), t0, t1); v0 += t0; v1 += t1; }
                    *(u32x4*)(G + off + bj * HALF) = pack8(v0, v1); } }
    }
};
struct EpiF32 { static constexpr bool PERM = false, AFTER_DRAIN = false; float* Y;
    __device__ __forceinline__ void operator()(const f32x4 (&acc)[2][2][4][2], const Unit& u, int wr, int wc, int fr, int fq) const {
        const int row0 = u.pm * BM + wr * 64 + fr, col0 = u.pn * BM + wc * 32 + 4 * fq;
#pragma unroll
        for (int ai = 0; ai < 2; ++ai)
#pragma unroll
            for (int m = 0; m < 4; ++m) { float* rowp = Y + (size_t)(row0 + ai * HALF + m * 16) * D + col0;
#pragma unroll
                for (int bj = 0; bj < 2; ++bj)
#pragma unroll
                    for (int n = 0; n < 2; ++n) *(f32x4*)(rowp + bj * HALF + n * 16) = acc[ai][bj][m][n]; }
    }
};

template <class Epi, class Sched, bool ALIGN_EPI = false, bool SP2 = false>
__device__ __forceinline__ void gemm_phase(PG8_LAS unsigned char* lds, const Gemm g, const Sched& S, const Epi& E) {
    int tid_ = threadIdx.x; asm volatile("" : "+v"(tid_));
    const int tid = tid_, wid = __builtin_amdgcn_readfirstlane(tid >> 6), lane = tid & 63, wr = wid >> 2, wc = wid & 3, fr = lane & 15, fq = lane >> 4;
    const int K = g.K, nt = K / BK;
    unsigned voffA[2], voffB[2];
#pragma unroll
    for (int i = 0; i < 2; ++i) { int R, C; stage_rc(tid * 16 + i * 8192, R, C); const int Rb = Epi::PERM ? ((R & ~31) + perm32(R & 31)) : R;
        voffA[i] = (unsigned)(R * K + C) * 2u; voffB[i] = (unsigned)(Rb * K + C) * 2u; }
    const size_t kstep = (size_t)(BK * 2);
    const size_t hstep = (size_t)HALF * K * 2;
    const size_t tstep = 2 * hstep;
    const unsigned ldsw = (unsigned)wid * 1024u;
    const int aoff = lds_byte(wr * 64 + fr, fq * 8), boff = lds_byte(wc * 32 + fr, fq * 8);
#define PG8_SA(b, h) (((b) * 2 + (h)) * HTB)
#define PG8_SB(b, h) ((4 + (b) * 2 + (h)) * HTB)
#define PG8_STAGE(bufoff, gbase, voff) do { _Pragma("unroll") for (int _i = 0; _i < 2; ++_i) \
        __builtin_amdgcn_global_load_lds((const unsigned*)((const char*)(gbase) + (voff)[_i]), (PG8_LAS unsigned*)(lds + (bufoff) + ldsw + _i * 8192), 16, 0, 0); } while (0)
#define PG8_LDA(dst, b, h) do { _Pragma("unroll") for (int m = 0; m < 4; ++m) _Pragma("unroll") for (int k = 0; k < 2; ++k) dst[m][k] = *(const PG8_LAS bf16x8*)(lds + PG8_SA(b, h) + aoff + m * 2048 + k * 1024); } while (0)
#define PG8_LDB(dst, b, h) do { _Pragma("unroll") for (int n = 0; n < 2; ++n) _Pragma("unroll") for (int k = 0; k < 2; ++k) dst[n][k] = *(const PG8_LAS bf16x8*)(lds + PG8_SB(b, h) + boff + n * 2048 + k * 1024); } while (0)
#define PG8_MMA(ai, bj, At, Bt) do { __builtin_amdgcn_s_setprio(1); _Pragma("unroll") for (int m = 0; m < 4; ++m) _Pragma("unroll") for (int n = 0; n < 2; ++n) _Pragma("unroll") for (int k = 0; k < 2; ++k) \
        acc[ai][bj][m][n] = __builtin_amdgcn_mfma_f32_16x16x32_bf16(Bt[n][k], At[m][k], acc[ai][bj][m][n], 0, 0, 0); __builtin_amdgcn_s_setprio(0); } while (0)
#define PG8_WAIT_V(n) asm volatile("s_waitcnt vmcnt(" #n ")" ::: "memory")
#define PG8_WAIT_L(n) asm volatile("s_waitcnt lgkmcnt(" #n ")" ::: "memory")
#define PG8_BAR __builtin_amdgcn_s_barrier()
#define PG8_SCHED __builtin_amdgcn_sched_barrier(0)
    Unit cur, nxt; int ui = 0;
    if (!S.next(0, cur)) return;
    f32x4 acc[2][2][4][2];
#pragma unroll
    for (int a = 0; a < 2; ++a)
#pragma unroll
        for (int b = 0; b < 2; ++b)
#pragma unroll
            for (int m = 0; m < 4; ++m)
#pragma unroll
                for (int n = 0; n < 2; ++n) acc[a][b][m][n] = (f32x4){0.f, 0.f, 0.f, 0.f};
    bf16x8 At[4][2], B0[2][2], B1[2][2];
    const char* cA = (const char*)g.A + (size_t)cur.pm * tstep; const char* cB = (const char*)g.Bt + (size_t)cur.pn * tstep;
    S.a_ready(cur);
    if constexpr (SP2) {
        PG8_STAGE(PG8_SB(0, 0), cB, voffB); PG8_STAGE(PG8_SB(0, 1), cB + hstep, voffB); PG8_STAGE(PG8_SA(0, 0), cA, voffA); PG8_STAGE(PG8_SA(0, 1), cA + hstep, voffA);
        if (wr == 1) PG8_BAR;
        PG8_WAIT_V(2); PG8_BAR;
        PG8_STAGE(PG8_SB(1, 0), cB + kstep, voffB); PG8_STAGE(PG8_SA(1, 0), cA + kstep, voffA); PG8_STAGE(PG8_SB(1, 1), cB + hstep + kstep, voffB);
        PG8_WAIT_V(6); PG8_BAR;
    } else {
        PG8_STAGE(PG8_SB(0, 0), cB, voffB); PG8_STAGE(PG8_SA(0, 0), cA, voffA); PG8_STAGE(PG8_SB(0, 1), cB + hstep, voffB); PG8_STAGE(PG8_SA(0, 1), cA + hstep, voffA);
        if (wr == 1) PG8_BAR;
        PG8_WAIT_V(4); PG8_BAR;
        PG8_STAGE(PG8_SB(1, 0), cB + kstep, voffB); PG8_STAGE(PG8_SA(1, 0), cA + kstep, voffA); PG8_STAGE(PG8_SB(1, 1), cB + hstep + kstep, voffB);
        PG8_WAIT_V(6); PG8_BAR;
    }
    for (;;) {
        const bool has_next = S.next(ui + 1, nxt);
        const char* nA = has_next ? (const char*)g.A + (size_t)nxt.pm * tstep : cA; const char* nB = has_next ? (const char*)g.Bt + (size_t)nxt.pn * tstep : cB;
        for (int t = 0; t < nt; t += 2) {
            const bool last = (t == nt - 2);
            const char* a1 = cA + (size_t)(t + 1) * kstep;
            const char* a2 = last ? nA : cA + (size_t)(t + 2) * kstep; const char* b2 = last ? nB : cB + (size_t)(t + 2) * kstep;
            const char* a3 = a2 + kstep; const char* b3 = b2 + kstep;
            if (last && has_next) S.a_ready(nxt);
            if constexpr (SP2) {
            PG8_LDB(B0, 0, 0); PG8_LDB(B1, 0, 1); PG8_SCHED; PG8_LDA(At, 0, 0); PG8_STAGE(PG8_SA(1, 1), a1 + hstep, voffA);
            PG8_WAIT_V(8); PG8_WAIT_L(0); PG8_BAR; PG8_MMA(0, 0, At, B0); PG8_MMA(0, 1, At, B1); PG8_BAR; PG8_SCHED;
            PG8_LDA(At, 0, 1); PG8_STAGE(PG8_SB(0, 0), b2, voffB); PG8_STAGE(PG8_SB(0, 1), b2 + hstep, voffB); PG8_STAGE(PG8_SA(0, 0), a2, voffA);
            PG8_WAIT_V(8); PG8_WAIT_L(0); PG8_BAR; PG8_MMA(1, 0, At, B0); PG8_MMA(1, 1, At, B1); PG8_BAR; PG8_SCHED;
            PG8_LDB(B0, 1, 0); PG8_LDB(B1, 1, 1); PG8_SCHED; PG8_LDA(At, 1, 0); PG8_STAGE(PG8_SA(0, 1), a2 + hstep, voffA);
            PG8_WAIT_V(8); PG8_WAIT_L(0); PG8_BAR; PG8_MMA(0, 0, At, B0); PG8_MMA(0, 1, At, B1); PG8_BAR; PG8_SCHED;
            PG8_LDA(At, 1, 1); PG8_STAGE(PG8_SB(1, 0), b3, voffB); PG8_STAGE(PG8_SB(1, 1), b3 + hstep, voffB); PG8_STAGE(PG8_SA(1, 0), a3, voffA);
            PG8_WAIT_V(8); PG8_WAIT_L(0); PG8_BAR; PG8_MMA(1, 0, At, B0); PG8_MMA(1, 1, At, B1); PG8_BAR; PG8_SCHED;
            } else {
            PG8_LDB(B0, 0, 0); PG8_SCHED; PG8_LDA(At, 0, 0); PG8_STAGE(PG8_SA(1, 1), a1 + hstep, voffA);
            PG8_WAIT_L(8); PG8_BAR; PG8_WAIT_L(0); PG8_MMA(0, 0, At, B0); PG8_BAR; PG8_SCHED;
            PG8_LDB(B1, 0, 1); PG8_STAGE(PG8_SB(0, 0), b2, voffB);
            PG8_BAR; PG8_WAIT_L(0); PG8_MMA(0, 1, At, B1); PG8_BAR;
            PG8_LDA(At, 0, 1); PG8_STAGE(PG8_SA(0, 0), a2, voffA);
            PG8_BAR; PG8_WAIT_L(0); PG8_MMA(1, 0, At, B0); PG8_BAR; PG8_SCHED;
            PG8_STAGE(PG8_SB(0, 1), b2 + hstep, voffB);
            PG8_WAIT_V(6); PG8_BAR; PG8_MMA(1, 1, At, B1); PG8_BAR;
            PG8_LDB(B0, 1, 0); PG8_SCHED; PG8_LDA(At, 1, 0); PG8_STAGE(PG8_SA(0, 1), a2 + hstep, voffA);
            PG8_WAIT_L(8); PG8_BAR; PG8_WAIT_L(0); PG8_MMA(0, 0, At, B0); PG8_BAR; PG8_SCHED;
            PG8_LDB(B1, 1, 1); PG8_STAGE(PG8_SB(1, 0), b3, voffB);
            PG8_BAR; PG8_WAIT_L(0); PG8_MMA(0, 1, At, B1); PG8_BAR;
            PG8_LDA(At, 1, 1); PG8_STAGE(PG8_SA(1, 0), a3, voffA);
            PG8_BAR; PG8_WAIT_L(0); PG8_MMA(1, 0, At, B0); PG8_BAR; PG8_SCHED;
            PG8_STAGE(PG8_SB(1, 1), b3 + hstep, voffB);
            PG8_WAIT_V(6); PG8_BAR; PG8_MMA(1, 1, At, B1); PG8_BAR;
            }
        }
        if constexpr (ALIGN_EPI) { if (wr == 0) PG8_BAR; }
        if constexpr (!Epi::AFTER_DRAIN) { E(acc, cur, wr, wc, fr, fq); S.done(cur); }
        if (!has_next) break;
#pragma unroll
        for (int a = 0; a < 2; ++a)
#pragma unroll
            for (int b = 0; b < 2; ++b)
#pragma unroll
                for (int m = 0; m < 4; ++m)
#pragma unroll
                    for (int n = 0; n < 2; ++n) acc[a][b][m][n] = (f32x4){0.f, 0.f, 0.f, 0.f};
        cur = nxt; cA = nA; cB = nB; ++ui;
        if constexpr (ALIGN_EPI) { if (wr == 1) PG8_BAR; }
    }
    PG8_WAIT_V(0);
    if constexpr (!ALIGN_EPI) { if (wr == 0) PG8_BAR; }
    PG8_BAR;
    if constexpr (Epi::AFTER_DRAIN) { E.fused(acc, cur, wr, wc, fr, fq, lds, wid, lane); S.done(cur); }
#undef PG8_SA
#undef PG8_SB
#undef PG8_STAGE
#undef PG8_LDA
#undef PG8_LDB
#undef PG8_MMA
#undef PG8_WAIT_V
#undef PG8_WAIT_L
#undef PG8_BAR
#undef PG8_SCHED
}
}


template <class Epi, bool ALIGN>
DEVI void run_gemm(unsigned char* lds, const bf16_t* A, const bf16_t* Bt, int Mr, int N, int K, const Epi& E) {
    pg8::Gemm g{A, Bt, Mr, N, K}; pg8::StaticOrder S; S.init(Mr, N, (int)gridDim.x, (int)blockIdx.x);
    pg8::gemm_phase<Epi, pg8::StaticOrder, ALIGN, true>((PG8_LAS unsigned char*)lds, g, S, E);
}
#include <hip/hip_bf16.h>
#include <cmath>
namespace attn_body {
using bf16=__hip_bfloat16;
using bf16x8=__attribute__((ext_vector_type(8)))short;
using s16x4=__attribute__((ext_vector_type(4)))short;
using f32x16=__attribute__((ext_vector_type(16)))float;
using u32x4=__attribute__((ext_vector_type(4)))unsigned;
constexpr int BATCH=2,NHEAD=16,SEQ=8192,D=64,DM=NHEAD*D;
constexpr int NW=8,QBLK=32,QB=QBLK*NW,KVBLK=64,NQB=SEQ/QB;
constexpr int ATTN_PITCH=DM, ATTN_UNIT_ROWS=QB;
__device__ __forceinline__ int crow(int r,int hi){return (r&3)+8*(r>>2)+4*hi;}
#define SBAR() __builtin_amdgcn_sched_barrier(0)
__device__ __forceinline__ void cmask(f32x16&p0,f32x16&p1,int jb,int qrel,int hi){
  const float NEG=-INFINITY; int kb=64*jb+4*hi;
  #pragma unroll
  for(int r=0;r<16;++r){int kv=kb+(r&3)+8*(r>>2); if(kv>qrel)p0[r]=NEG; if(kv+32>qrel)p1[r]=NEG;}
}

constexpr int NSLOT=3, SLOTB=8192;
constexpr int LDS_K=0, LDS_V=NSLOT*SLOTB, LDS_WS=2*NSLOT*SLOTB, LDS_OST=LDS_WS+NW*64*4, LDS_BYTES=LDS_OST+NW*4096;
constexpr float PRUNE_MARGIN=64.f;
constexpr int LDS_FB=LDS_BYTES;
constexpr float C2=0.125f*1.4426950408889634f;
__device__ __forceinline__ void glds16(const void*gsrc,unsigned lds_dst){unsigned keep;
  asm volatile("s_mov_b32 %0, m0\n\ts_mov_b32 m0, %2\n\ts_nop 0\n\tglobal_load_lds_dwordx4 %1, off\n\ts_mov_b32 m0, %0":"=&s"(keep):"v"(gsrc),"s"(lds_dst):"memory");}
__device__ __forceinline__ float max3f(float a,float b,float c){float r;asm("v_max3_f32 %0, %1, %2, %3":"=v"(r):"v"(a),"v"(b),"v"(c));return r;}
__device__ __forceinline__ float max2f(float a,float b){float r;asm("v_max_f32_e32 %0, %1, %2":"=v"(r):"v"(a),"v"(b));return r;}
__device__ __forceinline__ float fadd_s(float a,float b){float r;asm("v_add_f32_e32 %0, %1, %2":"=v"(r):"v"(a),"v"(b));return r;}
__device__ __forceinline__ float fsub_s(float a,float b){float r;asm("v_sub_f32_e32 %0, %1, %2":"=v"(r):"v"(a),"v"(b));return r;}
typedef float f32x2_t __attribute__((ext_vector_type(2))); typedef float f32x4_t __attribute__((ext_vector_type(4))); typedef __bf16 bf16x2_t __attribute__((ext_vector_type(2)));
__device__ __forceinline__ unsigned cvtpk_s(float lo,float hi){f32x2_t v={lo,hi};bf16x2_t b=__builtin_convertvector(v,bf16x2_t);return __builtin_bit_cast(unsigned,b);}
#define WAIT_BAR(N) asm volatile("s_waitcnt vmcnt(" #N ") lgkmcnt(0)\n\ts_barrier":::"memory")

__device__ __forceinline__ void qkt(f32x16&p0,f32x16&p1,const char*Kslot,const bf16x8*qr,int r32,int hi){
  const char*kb=Kslot+hi*1024+r32*16;
  #pragma unroll
  for(int d0=0;d0<4;++d0){
    const bf16x8 b0=*reinterpret_cast<const bf16x8*>(kb+d0*2048);
    const bf16x8 b1=*reinterpret_cast<const bf16x8*>(kb+d0*2048+512);
    {p0=__builtin_amdgcn_mfma_f32_32x32x16_bf16(b0,qr[d0],p0,0,0,0);p1=__builtin_amdgcn_mfma_f32_32x32x16_bf16(b1,qr[d0],p1,0,0,0);}}
}
typedef __attribute__((address_space(3))) const char* lds_cptr;
typedef short v4i16_t __attribute__((ext_vector_type(4)));
__device__ __forceinline__ void kload8(bf16x8*kf,lds_cptr kp){
  kf[0]=*(const __attribute__((address_space(3))) bf16x8*)(kp);      kf[1]=*(const __attribute__((address_space(3))) bf16x8*)(kp+512);
  kf[2]=*(const __attribute__((address_space(3))) bf16x8*)(kp+2048); kf[3]=*(const __attribute__((address_space(3))) bf16x8*)(kp+2560);
  kf[4]=*(const __attribute__((address_space(3))) bf16x8*)(kp+4096); kf[5]=*(const __attribute__((address_space(3))) bf16x8*)(kp+4608);
  kf[6]=*(const __attribute__((address_space(3))) bf16x8*)(kp+6144); kf[7]=*(const __attribute__((address_space(3))) bf16x8*)(kp+6656);
}
__device__ __forceinline__ void kload2(bf16x8*kf,lds_cptr kp,int j){ kf[2*j]=*(const __attribute__((address_space(3))) bf16x8*)(kp+j*2048); kf[2*j+1]=*(const __attribute__((address_space(3))) bf16x8*)(kp+j*2048+512); }
__device__ __forceinline__ s16x4 vtr(lds_cptr p){ return __builtin_bit_cast(s16x4,__builtin_amdgcn_ds_read_tr16_b64_v4i16((__attribute__((address_space(3))) v4i16_t*)p)); }
__device__ __forceinline__ float rowmax(const f32x16&p0,const f32x16&p1){
  float a=max3f(p0[0],p0[1],p1[0]),b=max3f(p0[2],p0[3],p1[1]);a=max3f(a,p1[2],p1[3]);
  #pragma unroll
  for(int r=4;r<16;r+=4){a=max3f(a,p0[r],p0[r+1]);b=max3f(b,p0[r+2],p0[r+3]);a=max3f(a,p1[r],p1[r+1]);b=max3f(b,p1[r+2],p1[r+3]);}
  const float m=max2f(a,b);
  auto rr=__builtin_amdgcn_permlane32_swap(__float_as_uint(m),__float_as_uint(m),false,false);
  return max2f(__uint_as_float(rr[0]),__uint_as_float(rr[1]));
}
__device__ __forceinline__ void pv(f32x16*o,int vb,bf16x8 pa0,bf16x8 pa1,bf16x8 pa2,bf16x8 pa3){
  #pragma unroll
  for(int d0=0;d0<2;++d0){s16x4 lo[4],hi[4];
    #pragma unroll
    for(int ks=0;ks<4;++ks){
      asm volatile("ds_read_b64_tr_b16 %0,%1 offset:%c2":"=&v"(lo[ks]):"v"(vb),"i"(d0*4096+ks*1024):"memory");
      asm volatile("ds_read_b64_tr_b16 %0,%1 offset:%c2":"=&v"(hi[ks]):"v"(vb),"i"(d0*4096+ks*1024+512):"memory");}
    asm volatile("s_waitcnt lgkmcnt(0)":::"memory");SBAR();
    #define PK(k) (bf16x8){lo[k][0],lo[k][1],lo[k][2],lo[k][3],hi[k][0],hi[k][1],hi[k][2],hi[k][3]}
    o[d0]=__builtin_amdgcn_mfma_f32_32x32x16_bf16(pa0,PK(0),o[d0],0,0,0);
    o[d0]=__builtin_amdgcn_mfma_f32_32x32x16_bf16(pa1,PK(1),o[d0],0,0,0);
    o[d0]=__builtin_amdgcn_mfma_f32_32x32x16_bf16(pa2,PK(2),o[d0],0,0,0);
    o[d0]=__builtin_amdgcn_mfma_f32_32x32x16_bf16(pa3,PK(3),o[d0],0,0,0);
    #undef PK
  }
}

#ifndef ATTN_STORE16
#define ATTN_STORE16(p,v) (*(u32x4*)(p)=(v))
#endif
template<int THRL> __device__ __forceinline__ void attn_unit(int b,int h,int qb,const bf16*Q,const bf16*__restrict__ K,const bf16*__restrict__ V,bf16*O,const float*__restrict__ Fc,const unsigned*__restrict__ kmx,const unsigned*__restrict__ qmx,char*shm){
  int tid_=threadIdx.x; asm volatile("":"+v"(tid_)); const int tid=tid_,lane=tid&63,r32=lane&31,hi=lane>>5; const int wid=__builtin_amdgcn_readfirstlane(tid>>6);
  const long rowbase=(long)b*SEQ; const int q0=qb*QB;
  const bf16*Qw=Q+(rowbase+q0+wid*QBLK)*DM+h*D;
  int ts=0; const float fq0=Fc[q0];
  { const int NT0=(q0+QB)/KVBLK; const float qm=__builtin_sqrtf(__uint_as_float(qmx[qb]));
    const float kd=__builtin_sqrtf(__uint_as_float(max(max(kmx[4*qb],kmx[4*qb+1]),max(kmx[4*qb+2],kmx[4*qb+3]))));
    const float thr=-qm*kd-PRUNE_MARGIN; int first=NT0;
    for(int base=0;base<NT0-4;base+=64){ const int kt=base+lane; bool keep=false;
      if(kt<NT0-4){ const float ub=qm*__builtin_sqrtf(__uint_as_float(kmx[kt]))+(fq0-Fc[kt*64+63])*1.4426950408889634f; keep=!(ub<thr); }
      const unsigned long long mk=__ballot(keep); if(mk){ first=base+__builtin_ctzll(mk); break; } }
    ts=min(first,NT0-4)&~1; ts=__builtin_amdgcn_readfirstlane(ts); }
  const bf16*Kh=K+(rowbase+(long)ts*KVBLK)*DM+h*D,*Vh=V+(rowbase+(long)ts*KVBLK)*DM+h*D; Fc+=ts*KVBLK;
  const unsigned lds0=(unsigned)(uintptr_t)shm;
  float*wsf=(float*)(shm+LDS_WS)+wid*64;
  const bf16*ksrc=Kh+(long)lane*DM+wid*8;
  const bf16*vsrc=Vh+(long)(16*(wid&3)+(lane>>2))*DM+(wid>>2)*32+(lane&3)*8;
  const unsigned kdst=lds0+LDS_K+wid*1024, vdst=lds0+LDS_V+wid*1024;
  #define DMA_K(t,slot) glds16(ksrc+(long)(t)*KVBLK*DM,(unsigned)__builtin_amdgcn_readfirstlane(kdst+(slot)))
  #define DMA_V(t,slot) glds16(vsrc+(long)(t)*KVBLK*DM,(unsigned)__builtin_amdgcn_readfirstlane(vdst+(slot)))
  const int vb0=(int)(lds0+LDS_V)+((lane>>4)&1)*32+(lane&3)*8+(4*hi+((lane&15)>>2))*64;
  const char*Kbase=shm+LDS_K; bf16x8 kf[8];
  const lds_cptr shm3=(lds_cptr)shm; const lds_cptr kp0=shm3+LDS_K+hi*1024+r32*16; const lds_cptr vp0=shm3+LDS_V+((lane>>4)&1)*32+(lane&3)*8+(4*hi+((lane&15)>>2))*64;
  const int NT=(q0+QB)/KVBLK-ts;
  DMA_K(0,0);DMA_V(0,0);DMA_K(1,SLOTB);
  bf16x8 qr[4];
  #pragma unroll
  for(int d0=0;d0<4;++d0)qr[d0]=*reinterpret_cast<const bf16x8*>(&Qw[(long)r32*DM+d0*16+hi*8]);
  float mhat=0.f,l_reg=0.f;f32x16 o[2];o[0]=f32x16{};o[1]=f32x16{};
  const int qrel=wid*QBLK+r32;
  #define CMASK(P0,P1,t) do{int jb_=(t)-(NT-4); if(jb_>=0)cmask(P0,P1,jb_,qrel,hi);}while(0)
  bool resc=false;
  #define START(P0,P1) do{ const float rm=rowmax(P0,P1); resc=false; \
    { const float dl=rm; mhat=fadd_s(mhat,dl); \
      _Pragma("unroll") for(int r=0;r<16;++r){P0[r]=fsub_s(P0[r],dl);P1[r]=fsub_s(P1[r],dl);} \
      } \
    _Pragma("unroll") for(int r=0;r<16;++r)P0[r]=__builtin_amdgcn_exp2f(P0[r]); }while(0)
  #define RESC() do{ if(resc){ asm volatile("s_waitcnt lgkmcnt(0)":::"memory"); \
      _Pragma("unroll") for(int d_=0;d_<2;++d_) _Pragma("unroll") for(int r=0;r<16;++r)o[d_][r]*=wsf[crow(r,hi)]; } }while(0)
  f32x16 pA0,pA1,pB0,pB1;
  int sl_prev=0,sl_cur=0,sl_next=SLOTB;
  #define ROT() do{sl_prev=sl_cur;sl_cur=sl_next;sl_next=(sl_next==(NSLOT-1)*SLOTB)?0:sl_next+SLOTB;}while(0)
  DMA_K(2,2*SLOTB);
  typedef __attribute__((address_space(3))) f32x4_t* lds_f4w; typedef const __attribute__((address_space(3))) f32x4_t* lds_f4ptr;
  { const lds_f4w fbw=(lds_f4w)((__attribute__((address_space(3))) char*)shm+LDS_FB); const f32x4_t*fsrc=(const f32x4_t*)Fc;
    for(int i=tid;i<NT*16;i+=NW*64){ const f32x4_t v=fsrc[i]; fbw[i]=(fq0-v)*1.4426950408889634f; } }
  #define FBINIT(X0,X1,tt) do{ const lds_f4ptr fp_=(lds_f4ptr)(shm3+LDS_FB+((tt)*64+4*hi)*4); \
    _Pragma("unroll") for(int g_=0;g_<4;++g_){ const f32x4_t a_=fp_[2*g_],b_=fp_[2*g_+8]; \
      X0[4*g_]=a_[0]-mhat;X0[4*g_+1]=a_[1]-mhat;X0[4*g_+2]=a_[2]-mhat;X0[4*g_+3]=a_[3]-mhat; X1[4*g_]=b_[0]-mhat;X1[4*g_+1]=b_[1]-mhat;X1[4*g_+2]=b_[2]-mhat;X1[4*g_+3]=b_[3]-mhat; } }while(0)
  WAIT_BAR(3);
  FBINIT(pA0,pA1,0); qkt(pA0,pA1,Kbase,qr,r32,hi);asm volatile("s_nop 15\n\ts_nop 7":"+v"(pA0),"+v"(pA1));CMASK(pA0,pA1,0);
  START(pA0,pA1);
  _Pragma("unroll") for(int r=0;r<16;++r)pA1[r]=__builtin_amdgcn_exp2f(pA1[r]);
  WAIT_BAR(0);
  DMA_K(3,0);DMA_V(1,SLOTB);
  ROT();
  kload8(kf,kp0+sl_cur);
  FBINIT(pB0,pB1,1);
  WAIT_BAR(2);
  s16x4 vlo[8],vhi[8]; u32x4 pw0,pw1,pw2,pw3;
  #define PKW(P,B) cvtpk_s(P[B],P[B+1])
  #define PAF(k) __builtin_bit_cast(bf16x8,pw##k)
  #define VFR(i) (bf16x8){vlo[i][0],vlo[i][1],vlo[i][2],vlo[i][3],vhi[i][0],vhi[i][1],vhi[i][2],vhi[i][3]}
  #define PIN(x) asm volatile("":"+v"(x))
  #define MX3(a,b,c) __builtin_fmaxf(__builtin_fmaxf((a),(b)),(c))
  #define GAPA(MF,A0,A1,A2,A3,W0,W1,PW) do{ MF; sacc+=A0; sacc+=A1; sacc+=A2; sacc+=A3; PIN(sacc); W0; W1; PIN(PW); SBAR(); }while(0)
  #define EX(v) __builtin_amdgcn_exp2f(v)
  #define GAPB(MF,X,B,BI) do{ MF; X[B]=EX(X[B]); X[B+1]=EX(X[B+1]); X[B+2]=EX(X[B+2]); X[B+3]=EX(X[B+3]); PIN(X); BI; SBAR(); }while(0)
  #define BINIT(PX,G,bv) do{ PX[4*(G)]=bv[0]-mhat; PX[4*(G)+1]=bv[1]-mhat; PX[4*(G)+2]=bv[2]-mhat; PX[4*(G)+3]=bv[3]-mhat; PIN(PX); }while(0)
  #define VRD(i) do{ vlo[i]=vtr(vp_+(((i)>>2)*4096+((i)&3)*1024)); vhi[i]=vtr(vp_+(((i)>>2)*4096+((i)&3)*1024+512)); }while(0)
  #define KRD(G,j) do{ if(G){ kload2(kf,kp0+sl_next,j); SBAR(); } }while(0)
  #define STEP(C0,C1,P0,P1,t,GK,GV,GL) do{ SBAR(); \
    const lds_cptr vp_=vp0+sl_prev; \
    VRD(0); SBAR(); float sacc=(P0[0]+P0[1]); \
    GAPA(C0=__builtin_amdgcn_mfma_f32_32x32x16_bf16(kf[0],qr[0],C0,0,0,0), P0[2],P0[3],P0[4],P0[5],     pw0[0]=PKW(P0,0), pw0[1]=PKW(P0,2), pw0); \
    VRD(4); SBAR(); GAPA(C1=__builtin_amdgcn_mfma_f32_32x32x16_bf16(kf[1],qr[0],C1,0,0,0), P0[6],P0[7],P0[8],P0[9],     pw0[2]=PKW(P0,4), pw0[3]=PKW(P0,6), pw0); \
    VRD(1); SBAR(); GAPA(C0=__builtin_amdgcn_mfma_f32_32x32x16_bf16(kf[2],qr[1],C0,0,0,0),   P0[10],P0[11],P0[12],P0[13], pw1[0]=PKW(P0,8), pw1[1]=PKW(P0,10), pw1); \
    VRD(5); SBAR(); GAPA(C1=__builtin_amdgcn_mfma_f32_32x32x16_bf16(kf[3],qr[1],C1,0,0,0),   P0[14],P0[15],P1[0],P1[1],   pw1[2]=PKW(P0,12),pw1[3]=PKW(P0,14), pw1); \
    VRD(2); SBAR(); GAPA(C0=__builtin_amdgcn_mfma_f32_32x32x16_bf16(kf[4],qr[2],C0,0,0,0),   P1[2],P1[3],P1[4],P1[5],     pw2[0]=PKW(P1,0), pw2[1]=PKW(P1,2), pw2); \
    VRD(6); SBAR(); GAPA(C1=__builtin_amdgcn_mfma_f32_32x32x16_bf16(kf[5],qr[2],C1,0,0,0),   P1[6],P1[7],P1[8],P1[9],     pw2[2]=PKW(P1,4), pw2[3]=PKW(P1,6), pw2); \
    VRD(3); SBAR(); GAPA(C0=__builtin_amdgcn_mfma_f32_32x32x16_bf16(kf[6],qr[3],C0,0,0,0),   P1[10],P1[11],P1[12],P1[13], pw3[0]=PKW(P1,8), pw3[1]=PKW(P1,10), pw3); \
    VRD(7); SBAR(); GAPA(C1=__builtin_amdgcn_mfma_f32_32x32x16_bf16(kf[7],qr[3],C1,0,0,0),   P1[14],P1[15],0.f,0.f,       pw3[2]=PKW(P1,12),pw3[3]=PKW(P1,14), pw3); \
    l_reg+=sacc; \
    if(GK){DMA_K((t)+3,sl_cur);} if(GV){DMA_V((t)+1,sl_next);} \
    CMASK(C0,C1,t); \
    const lds_f4ptr fbp_=(lds_f4ptr)(shm3+LDS_FB+(((t)+1)*64+4*hi)*4); f32x4_t bvA=fbp_[0]; \
    { float a=MX3(C0[0],C0[1],C1[0]),b=MX3(C0[2],C0[3],C1[1]); a=MX3(a,C1[2],C1[3]); \
      _Pragma("unroll") for(int r=4;r<16;r+=4){a=MX3(a,C0[r],C0[r+1]);b=MX3(b,C0[r+2],C0[r+3]);a=MX3(a,C1[r],C1[r+1]);b=MX3(b,C1[r+2],C1[r+3]);} \
      float rm=__builtin_fmaxf(a,b); { auto rr=__builtin_amdgcn_permlane32_swap(__float_as_uint(rm),__float_as_uint(rm),false,false); rm=__builtin_fmaxf(__uint_as_float(rr[0]),__uint_as_float(rr[1])); } \
      resc=false; \
      if(__builtin_expect(__any(rm>(float)THRL),0)){ const float dl=__builtin_fmaxf(rm,0.f); mhat+=dl; \
        _Pragma("unroll") for(int r=0;r<16;++r){C0[r]-=dl;C1[r]-=dl;} \
        const float f=__builtin_amdgcn_exp2f(-dl); l_reg*=f; if(hi==0)wsf[r32]=f; resc=true; } } \
    SBAR(); \
    GAPB(o[0]=__builtin_amdgcn_mfma_f32_32x32x16_bf16(PAF(0),VFR(0),o[0],0,0,0), C0,0,do{BINIT(P0,0,bvA); bvA=fbp_[2];}while(0)); \
    GAPB(o[1]=__builtin_amdgcn_mfma_f32_32x32x16_bf16(PAF(0),VFR(4),o[1],0,0,0), C0,4,do{BINIT(P0,1,bvA); bvA=fbp_[4];}while(0)); \
    KRD(GL,0); GAPB(o[0]=__builtin_amdgcn_mfma_f32_32x32x16_bf16(PAF(1),VFR(1),o[0],0,0,0), C0,8,do{BINIT(P0,2,bvA); bvA=fbp_[6];}while(0)); \
    KRD(GL,1); GAPB(o[1]=__builtin_amdgcn_mfma_f32_32x32x16_bf16(PAF(1),VFR(5),o[1],0,0,0), C0,12,do{BINIT(P0,3,bvA); bvA=fbp_[8];}while(0)); \
    KRD(GL,2); GAPB(o[0]=__builtin_amdgcn_mfma_f32_32x32x16_bf16(PAF(2),VFR(2),o[0],0,0,0), C1,0,do{BINIT(P1,0,bvA); bvA=fbp_[10];}while(0)); \
    KRD(GL,3); GAPB(o[1]=__builtin_amdgcn_mfma_f32_32x32x16_bf16(PAF(2),VFR(6),o[1],0,0,0), C1,4,do{BINIT(P1,1,bvA); bvA=fbp_[12];}while(0)); \
    GAPB(o[0]=__builtin_amdgcn_mfma_f32_32x32x16_bf16(PAF(3),VFR(3),o[0],0,0,0), C1,8,do{BINIT(P1,2,bvA); bvA=fbp_[14];}while(0)); \
    GAPB(o[1]=__builtin_amdgcn_mfma_f32_32x32x16_bf16(PAF(3),VFR(7),o[1],0,0,0), C1,12,do{BINIT(P1,3,bvA);}while(0)); \
    }while(0)
  int t=1;
  #undef CMASK
  #define CMASK(P0,P1,t) do{}while(0)
  for(;t+5<NT;t+=2){
    STEP(pB0,pB1,pA0,pA1,t,true,true,true);     WAIT_BAR(2); RESC(); ROT();
    STEP(pA0,pA1,pB0,pB1,t+1,true,true,true);   WAIT_BAR(2); RESC(); ROT();
  }
  #undef CMASK
  #define CMASK(P0,P1,t) do{int jb_=(t)-(NT-4); if(jb_>=0)cmask(P0,P1,jb_,qrel,hi);}while(0)
  #define ENDW(tt) do{ if((tt)+3<NT){WAIT_BAR(2);} else if((tt)+2<NT){WAIT_BAR(1);} else {WAIT_BAR(0);} }while(0)
  for(;t+1<NT;t+=2){
    STEP(pB0,pB1,pA0,pA1,t,(t+3<NT),(t+1<NT),(t+1<NT));       ENDW(t);   RESC(); ROT();
    STEP(pA0,pA1,pB0,pB1,t+1,(t+4<NT),(t+2<NT),(t+2<NT));     ENDW(t+1); RESC(); ROT();
  }
  STEP(pB0,pB1,pA0,pA1,NT-1,false,false,false); RESC();
  { float sacc=pB0[0]+pB0[1]; _Pragma("unroll") for(int r=2;r<16;++r)sacc+=pB0[r]; _Pragma("unroll") for(int r=0;r<16;++r)sacc+=pB1[r]; l_reg+=sacc;
    pw0=(u32x4){PKW(pB0,0),PKW(pB0,2),PKW(pB0,4),PKW(pB0,6)};pw1=(u32x4){PKW(pB0,8),PKW(pB0,10),PKW(pB0,12),PKW(pB0,14)};pw2=(u32x4){PKW(pB1,0),PKW(pB1,2),PKW(pB1,4),PKW(pB1,6)};pw3=(u32x4){PKW(pB1,8),PKW(pB1,10),PKW(pB1,12),PKW(pB1,14)};
    SBAR(); pv(o,vb0+sl_cur,PAF(0),PAF(1),PAF(2),PAF(3)); }
  #undef PKW
  #undef PAF
  #undef VFR
  #undef PIN
  #undef MX3
  #undef GAPA
  #undef GAPB
  #undef BINIT
  #undef FBINIT
  #undef EX
  #undef VRD
  #undef KRD
  #undef STEP
  #undef ENDW
  {auto rr=__builtin_amdgcn_permlane32_swap(__float_as_uint(l_reg),__float_as_uint(l_reg),false,false);l_reg=__uint_as_float(rr[0])+__uint_as_float(rr[1]);}
  if(hi==0)wsf[32+r32]=l_reg;asm volatile("s_waitcnt lgkmcnt(0)":::"memory");
  float rli[16];
  #pragma unroll
  for(int r=0;r<16;++r)rli[r]=__builtin_amdgcn_rcpf(wsf[32+crow(r,hi)]);
  bf16*Ow=O+(rowbase+q0+wid*QBLK)*DM+h*D;
  { bf16*stg=(bf16*)(shm+LDS_OST)+wid*2048;
    #pragma unroll
    for(int r=0;r<16;++r){const int orow=crow(r,hi);
      #pragma unroll
      for(int d0=0;d0<2;++d0)stg[orow*64+d0*32+r32]=__float2bfloat16(o[d0][r]*rli[r]);}
    asm volatile("s_waitcnt lgkmcnt(0)":::"memory");
    #pragma unroll
    for(int i=0;i<4;++i){const int row=i*8+(lane>>3),ch=lane&7; const u32x4 v=*(const u32x4*)(stg+row*64+ch*8); ATTN_STORE16(Ow+(long)row*DM+ch*8,v);} }
  asm volatile("s_waitcnt lgkmcnt(0)\n\ts_barrier":::"memory");
  #undef DMA_K
  #undef DMA_V
  #undef CMASK
  #undef START
  #undef RESC
  #undef ROT
}
constexpr int ATTN_LDS_BYTES=LDS_BYTES;
struct AttnTensors { const bf16* Q; const bf16* K; const bf16* V; bf16* O; const float* F; const unsigned* KMAX; const unsigned* QMAX; };
struct AttnUnit { int bh; int qb; };
struct StaticOrder {
  int vcu;
  __device__ __forceinline__ explicit StaticOrder(int grid,int block):vcu((block%8)*(grid/8)+block/8){}
  __device__ __forceinline__ bool next(int i,AttnUnit&u)const{ if(i>=4)return false; const int s=vcu&7; u.bh=vcu>>3; u.qb=(i==0)?s:(i==1)?15-s:(i==2)?16+s:31-s; return true; }
  __device__ __forceinline__ void a_ready(const AttnUnit&)const{}
  __device__ __forceinline__ void done(const AttnUnit&)const{}
};
template<class Sched,int THRL=8> __device__ __forceinline__ void attn_phase(char*lds,const AttnTensors&T,const Sched&S){
  AttnUnit u;
  for(int i=0;S.next(i,u);++i){ S.a_ready(u); attn_unit<THRL>(u.bh/NHEAD,u.bh%NHEAD,u.qb,T.Q,T.K,T.V,T.O,T.F+(size_t)u.bh*SEQ,T.KMAX+u.bh*128,T.QMAX+u.bh*32,lds); S.done(u); }
}
#undef SBAR
#undef WAIT_BAR
}

__global__ void __launch_bounds__(512, 2) mega_fwd(Params p) {
    extern __shared__ __attribute__((aligned(16))) unsigned char lds[];
    cg::grid_group grid = cg::this_grid();
    unsigned char* ws = p.ws;
    bf16_t* XN = (bf16_t*)(ws + WS_XN); bf16_t* HB = (bf16_t*)(ws + WS_H);
    ph_prologue(p, lds); grid.sync();
    ph_mods_xn1(p, lds); grid.sync();
    { pg8::EpiSwiglu E{HB, DFF}; run_gemm<pg8::EpiSwiglu, true>(lds, XN, (const bf16_t*)(ws + WS_WGU), M, 2 * DFF, D, E); } grid.sync();
    { pg8::EpiF32 E{(float*)(ws + WS_Y)}; run_gemm<pg8::EpiF32, false>(lds, HB, (const bf16_t*)(ws + WS_WDN), M, D, DFF, E); } grid.sync();
    ph_norm_res(p, (const float*)(ws + WS_Y), p.in[I_X], p.out, true, 0, 0.5f); grid.sync();
    { pg8::EpiSeg E{ws, 0}; run_gemm<pg8::EpiSeg, true>(lds, XN, (const bf16_t*)(ws + WS_WIN1), M, 5120, D, E); }
    ph_thin_cols(p); grid.sync();
    ph_fcum(p, lds);
    ph_qk_norms(p);
#if GLA_MFMA
    for (int u = blockIdx.x; u < 256; u += gridDim.x) gla_passA(p, lds, u);
#else
    for (int u = blockIdx.x; u < 256; u += gridDim.x) gla_rec<false>(p, lds, u);
#endif
    grid.sync();
    ph_gla_scan(p); grid.sync();
#if GLA_MFMA
    for (int u = blockIdx.x; u < 256; u += gridDim.x) gla_passC(p, lds, u);
#else
    for (int u = blockIdx.x; u < 256; u += gridDim.x) gla_rec<true>(p, lds, u);
#endif
    __syncthreads();
    { const attn_body::AttnTensors AT{(const attn_body::bf16*)(ws + WS_QB), (const attn_body::bf16*)(ws + WS_KB), (const attn_body::bf16*)(ws + WS_VB), (attn_body::bf16*)(ws + WS_QB), (const float*)(ws + WS_FCUM), (const unsigned*)(ws + WS_KMAX), (const unsigned*)(ws + WS_QMAX)};
      const attn_body::StaticOrder S((int)gridDim.x, (int)blockIdx.x); attn_body::attn_phase<attn_body::StaticOrder>((char*)lds, AT, S); }
    grid.sync();
    { pg8::EpiSeg E{ws, 1 + GLA_MFMA}; run_gemm<pg8::EpiSeg, true>(lds, XN, (const bf16_t*)(ws + WS_WIN2), M, 3072, D, E); }
    __syncthreads();
    convert_ffn_weights(p, lds, p.in[I_WGU2], p.in[I_WDN2]); grid.sync();
#if !GLA_MFMA
    ph_oa_norm(p); grid.sync();
#endif
    { pg8::EpiGate<0> E{(bf16_t*)(ws + WS_GA), nullptr}; run_gemm<pg8::EpiGate<0>, false>(lds, (const bf16_t*)(ws + WS_VA), (const bf16_t*)(ws + WS_WPA), M, D, D, E); } grid.sync();
    { pg8::EpiGate<1> E{(bf16_t*)(ws + WS_GB), (const bf16_t*)(ws + WS_GA)}; run_gemm<pg8::EpiGate<1>, false>(lds, (const bf16_t*)(ws + WS_QB), (const bf16_t*)(ws + WS_WPB), M, D, D, E); } grid.sync();
    { pg8::EpiF32 E{(float*)(ws + WS_Y2)}; run_gemm<pg8::EpiF32, false>(lds, (const bf16_t*)(ws + WS_GB), (const bf16_t*)(ws + WS_WOUT), M, D, D, E); } grid.sync();
    ph_norm_res(p, (const float*)(ws + WS_Y2), p.out, p.out, true, 1, 1.0f); grid.sync();
    { pg8::EpiSwiglu E{HB, DFF}; run_gemm<pg8::EpiSwiglu, true>(lds, XN, (const bf16_t*)(ws + WS_WGU), M, 2 * DFF, D, E); } grid.sync();
    { pg8::EpiF32 E{(float*)(ws + WS_Y)}; run_gemm<pg8::EpiF32, false>(lds, HB, (const bf16_t*)(ws + WS_WDN), M, D, DFF, E); } grid.sync();
    ph_norm_res(p, (const float*)(ws + WS_Y), p.out, p.out, false, 2, 0.5f);
}

extern "C" void kernel_launch(void* const* d_in, const int* in_sizes, int n_in, void* d_out, int out_size, void* d_ws, size_t ws_size, hipStream_t stream) {
    static int grid = 0;
    if (grid == 0) {
        int dev = 0, cus = 0, per_cu = 0;
        hipGetDevice(&dev); hipDeviceGetAttribute(&cus, hipDeviceAttributeMultiprocessorCount, dev);
        if (hipFuncSetAttribute((const void*)mega_fwd, hipFuncAttributeMaxDynamicSharedMemorySize, LDS_BYTES) != hipSuccess) { fprintf(stderr, "hipFuncSetAttribute failed\n"); }
        if (hipOccupancyMaxActiveBlocksPerMultiprocessor(&per_cu, (const void*)mega_fwd, 512, LDS_BYTES) != hipSuccess || per_cu < 1) { fprintf(stderr, "occupancy query: %d\n", per_cu); per_cu = 1; }
        (void)hipGetLastError();
        grid = cus * per_cu;
        if (n_in != 18 || ws_size < 256 * MiB) fprintf(stderr, "unexpected n_in %d / ws %zu\n", n_in, ws_size);
    }
    Params p{};
    for (int i = 0; i < 18; ++i) p.in[i] = (const float*)d_in[i];
    p.out = (float*)d_out; p.ws = (unsigned char*)d_ws;
    void* args[] = {&p};
    hipError_t e = hipLaunchCooperativeKernel((const void*)mega_fwd, dim3(grid), dim3(512), args, LDS_BYTES, stream);
    if (e != hipSuccess) fprintf(stderr, "cooperative launch failed: %s (grid %d)\n", hipGetErrorString(e), grid);
}
```

```cpp
#include <hip/hip_runtime.h>
#include <hip/hip_cooperative_groups.h>
#include <cstdio>
#include <cstdint>
namespace cg = cooperative_groups;

#define DEVI __device__ __forceinline__
typedef unsigned short bf16_t;
typedef float f32x4 __attribute__((ext_vector_type(4)));
typedef unsigned u32x4 __attribute__((ext_vector_type(4)));
typedef unsigned u32x2 __attribute__((ext_vector_type(2)));

constexpr int BATCH = 2, T = 8192, D = 1024, M = BATCH * T, DFF = 2816, NMODS = 9 * D, INC = 8224;
constexpr float EPS = 1e-6f, LOG2E = 1.4426950408889634f;
constexpr float C2 = 0.125f * LOG2E;
constexpr float QA_SCALE = 0.08838834764831845f;

constexpr size_t MiB = 1u << 20;
constexpr size_t WS_CTL = 0;
constexpr size_t WS_WIN1 = 1 * MiB;
constexpr size_t WS_WIN2 = 11 * MiB;
constexpr size_t WS_WPA = 17 * MiB, WS_WPB = 19 * MiB, WS_WOUT = 21 * MiB;
constexpr size_t WS_MODS = 23 * MiB;
constexpr size_t WS_MODP = 23 * MiB + 128 * 1024;
constexpr size_t WS_DEC = 23 * MiB + 768 * 1024;
constexpr size_t WS_KMAX = 23 * MiB + 896 * 1024;
constexpr size_t WS_QMAX = 23 * MiB + 912 * 1024;
constexpr size_t WS_ALOW = 24 * MiB;
constexpr size_t WS_LOGF = 25 * MiB;
constexpr size_t WS_FCUM = 26 * MiB;
constexpr size_t WS_XN = 27 * MiB;
constexpr size_t WS_QA = 59 * MiB, WS_KA = 75 * MiB, WS_VA = 91 * MiB, WS_QB = 123 * MiB, WS_KB = 155 * MiB, WS_VB = 187 * MiB;
constexpr size_t WS_RA = 59 * MiB, WS_GA = 155 * MiB, WS_GB = 187 * MiB;
constexpr size_t WS_H = 59 * MiB;
constexpr size_t WS_Y = 147 * MiB;
constexpr size_t WS_Y2 = 59 * MiB;
constexpr size_t WS_WGU = 219 * MiB;
constexpr size_t WS_WDN = 230 * MiB;
constexpr size_t WS_U = 219 * MiB;
constexpr int LDS_BYTES = 147456, MISC_OFF = 147392;
#ifndef GLA_MFMA
#define GLA_MFMA 1
#endif

struct Params { const float* in[18]; float* out; unsigned char* ws; };
enum { I_X = 0, I_C, I_WADA, I_BADA, I_GPRE, I_GPOST, I_WGU1, I_WDN1, I_WGU2, I_WDN2, I_WIN, I_WA2, I_BA, I_BF, I_GGLA, I_WPA, I_WPB, I_WOUT };

DEVI float bf2f(bf16_t v) { return __uint_as_float((unsigned)v << 16); }
DEVI unsigned f2bf(float f) { unsigned u = __float_as_uint(f); return (u + 0x7fffu + ((u >> 16) & 1u)) >> 16; }
DEVI unsigned pk2(float lo, float hi) { return f2bf(lo) | (f2bf(hi) << 16); }
DEVI float wave_sum(float v) {
#pragma unroll
    for (int o = 1; o < 64; o <<= 1) v += __shfl_xor(v, o);
    return v;
}
DEVI float sigmoid_f(float x) { return 1.f / (1.f + __expf(-x)); }
DEVI float silu_f(float x) { return x / (1.f + __expf(-x)); }
DEVI float logsigmoid_f(float x) { return fminf(x, 0.f) - log1pf(__expf(-fabsf(x))); }
DEVI void unpack8(const u32x4 v, float* f) {
    f[0] = __uint_as_float(v.x << 16); f[1] = __uint_as_float(v.x & 0xffff0000u);
    f[2] = __uint_as_float(v.y << 16); f[3] = __uint_as_float(v.y & 0xffff0000u);
    f[4] = __uint_as_float(v.z << 16); f[5] = __uint_as_float(v.z & 0xffff0000u);
    f[6] = __uint_as_float(v.w << 16); f[7] = __uint_as_float(v.w & 0xffff0000u);
}

DEVI void transpose_item(const float* W, int K, int N, int k0, int srcn0, bf16_t* WT, int dstrow0, float* scr, int lane) {
#pragma unroll 8
    for (int i = 0; i < 32; ++i) { const int kk = 2 * i + (lane >> 5); scr[kk * 33 + (lane & 31)] = W[(size_t)(k0 + kk) * N + srcn0 + (lane & 31)]; }
    __builtin_amdgcn_s_waitcnt(0); __builtin_amdgcn_wave_barrier();
    const int c = lane & 7;
#pragma unroll
    for (int j = 0; j < 4; ++j) { const int n = (lane >> 3) + 8 * j; const float* s = scr + (8 * c) * 33 + n;
        u32x4 o; o.x = pk2(s[0 * 33], s[1 * 33]); o.y = pk2(s[2 * 33], s[3 * 33]); o.z = pk2(s[4 * 33], s[5 * 33]); o.w = pk2(s[6 * 33], s[7 * 33]);
        *(u32x4*)(WT + (size_t)(dstrow0 + n) * K + k0 + 8 * c) = o; }
    __builtin_amdgcn_s_waitcnt(0); __builtin_amdgcn_wave_barrier();
}
DEVI int src_win1(int r) { return r < 2048 ? r : r + 1040; }
DEVI int src_win2(int r) { return r < 1024 ? r + 2064 : r + 5152; }
DEVI int src_gu(int r) { const int t = r >> 8, w = r & 255; return w < 128 ? 128 * t + w : DFF + 128 * t + (w - 128); }

DEVI void convert_ffn_weights(const Params& p, unsigned char* lds, const float* wgu, const float* wdn) {
    const int lane = threadIdx.x & 63, wave = threadIdx.x >> 6;
    float* scr = (float*)(lds + wave * 16384);
    const int gw = blockIdx.x * 8 + wave, NGW = gridDim.x * 8;
    bf16_t* WGU = (bf16_t*)(p.ws + WS_WGU); bf16_t* WDN = (bf16_t*)(p.ws + WS_WDN);
    constexpr int I_GU = 16 * 176, I_DN = 44 * 32;
    for (int it = gw; it < I_GU + I_DN; it += NGW) {
        if (it < I_GU) { const int kb = it / 176, nb = it % 176; transpose_item(wgu, D, 2 * DFF, 64 * kb, src_gu(32 * nb), WGU, 32 * nb, scr, lane); }
        else { const int r = it - I_GU, kb = r / 32, nb = r % 32; transpose_item(wdn, DFF, D, 64 * kb, 32 * nb, WDN, 32 * nb, scr, lane); }
    }
}

DEVI void ph_prologue(const Params& p, unsigned char* lds) {
    const int tid = threadIdx.x, lane = tid & 63, wave = tid >> 6;
    float* sc = (float*)lds;
    for (int v = tid; v < 2 * D; v += 512) sc[v] = silu_f(p.in[I_C][v]);
    __syncthreads();
    {
        const int g = blockIdx.x * 512 + tid;
        if (g < 8 * NMODS) {
            const int ks = g / NMODS, j = g % NMODS; const float* w = p.in[I_WADA] + (size_t)(ks * 128) * NMODS + j;
            float s0 = 0.f, s1 = 0.f;
#pragma unroll 8
            for (int i = 0; i < 128; ++i) { const float wv = w[(size_t)i * NMODS]; s0 += sc[ks * 128 + i] * wv; s1 += sc[D + ks * 128 + i] * wv; }
            float* mp = (float*)(p.ws + WS_MODP);
            mp[(ks * 2 + 0) * NMODS + j] = s0; mp[(ks * 2 + 1) * NMODS + j] = s1;
        }
    }
    __syncthreads();
    for (int v = blockIdx.x * 512 + tid; v < 32 * 128 + 32 * 32; v += gridDim.x * 512) ((unsigned*)(p.ws + WS_KMAX))[v] = 0u;
    float* scr = (float*)(lds + wave * 16384);
    const int gw = blockIdx.x * 8 + wave, NGW = gridDim.x * 8;
    constexpr int I_W1 = 16 * 160, I_W2 = 16 * 96, I_P = 16 * 32;
    const float* win = p.in[I_WIN];
    for (int it = gw; it < I_W1 + I_W2 + 3 * I_P; it += NGW) {
        int r = it;
        if (r < I_W1) { const int kb = r / 160, nb = r % 160; transpose_item(win, D, INC, 64 * kb, src_win1(32 * nb), (bf16_t*)(p.ws + WS_WIN1), 32 * nb, scr, lane); continue; } r -= I_W1;
        if (r < I_W2) { const int kb = r / 96, nb = r % 96; transpose_item(win, D, INC, 64 * kb, src_win2(32 * nb), (bf16_t*)(p.ws + WS_WIN2), 32 * nb, scr, lane); continue; } r -= I_W2;
        const int w = r / I_P, q = r % I_P, kb = q / 32, nb = q % 32;
        const float* src = p.in[w == 0 ? I_WPA : (w == 1 ? I_WPB : I_WOUT)]; bf16_t* dst = (bf16_t*)(p.ws + (w == 0 ? WS_WPA : (w == 1 ? WS_WPB : WS_WOUT)));
        transpose_item(src, D, D, 64 * kb, 32 * nb, dst, 32 * nb, scr, lane);
    }
    convert_ffn_weights(p, lds, p.in[I_WGU1], p.in[I_WDN1]);
}

DEVI void ph_mods_xn1(const Params& p, unsigned char* lds) {
    const int tid = threadIdx.x, lane = tid & 63, wave = tid >> 6;
    const float* mp = (const float*)(p.ws + WS_MODP); float* mods = (float*)(p.ws + WS_MODS); const float* bada = p.in[I_BADA];
    for (int v = blockIdx.x * 512 + tid; v < 2 * NMODS; v += gridDim.x * 512) { const int b = v / NMODS, j = v % NMODS; float s = bada[j];
#pragma unroll
        for (int ks = 0; ks < 8; ++ks) s += mp[(ks * 2 + b) * NMODS + j];
        mods[v] = s; }
    float* lm = (float*)lds;
    for (int v = tid; v < 4096; v += 512) { const int b = v >> 11, j = v & 2047; float s = bada[j];
#pragma unroll
        for (int ks = 0; ks < 8; ++ks) s += mp[(ks * 2 + b) * NMODS + j];
        lm[v] = s; }
    __syncthreads();
    const int gw = blockIdx.x * 8 + wave, NGW = gridDim.x * 8;
    const float* gpre = p.in[I_GPRE]; bf16_t* XN = (bf16_t*)(p.ws + WS_XN);
    for (int m = gw; m < M; m += NGW) {
        const int b = m >> 13; const f32x4* xr = (const f32x4*)(p.in[I_X] + (size_t)m * D) + lane;
        f32x4 v[4]; float ss = 0.f;
#pragma unroll
        for (int j = 0; j < 4; ++j) { v[j] = xr[64 * j]; ss += (v[j].x * v[j].x + v[j].y * v[j].y) + (v[j].z * v[j].z + v[j].w * v[j].w); }
        const float rstd = rsqrtf(wave_sum(ss) * (1.f / D) + EPS);
        u32x2* o8 = (u32x2*)(XN + (size_t)m * D) + lane;
#pragma unroll
        for (int j = 0; j < 4; ++j) { const int col = 4 * lane + 256 * j; const f32x4 g = *(const f32x4*)(gpre + col);
            const f32x4 sh = *(const f32x4*)(lm + b * 2048 + col), s1 = *(const f32x4*)(lm + b * 2048 + 1024 + col);
            const f32x4 h = v[j] * rstd * g * (1.f + s1) + sh; u32x2 w; w.x = pk2(h.x, h.y); w.y = pk2(h.z, h.w); o8[64 * j] = w; }
    }
}

DEVI void ph_norm_res(const Params& p, const float* Y, const float* xin, float* xout, bool mk_xn, int sub  , float gs) {
    const int tid = threadIdx.x, lane = tid & 63, wave = tid >> 6;
    const int gw = blockIdx.x * 8 + wave, NGW = gridDim.x * 8;
    const float* mods = (const float*)(p.ws + WS_MODS); const float* gpost = p.in[I_GPOST] + sub * D; const float* gpre = p.in[I_GPRE] + (sub + 1) * D;
    bf16_t* XN = (bf16_t*)(p.ws + WS_XN);
    for (int m = gw; m < M; m += NGW) {
        const int b = m >> 13; const float* mb = mods + b * NMODS;
        const f32x4* yr = (const f32x4*)(Y + (size_t)m * D) + lane; const f32x4* xr = (const f32x4*)(xin + (size_t)m * D) + lane; f32x4* xo = (f32x4*)(xout + (size_t)m * D) + lane;
        f32x4 y[4]; float ss = 0.f;
#pragma unroll
        for (int j = 0; j < 4; ++j) { y[j] = yr[64 * j]; ss += (y[j].x * y[j].x + y[j].y * y[j].y) + (y[j].z * y[j].z + y[j].w * y[j].w); }
        const float rstd = rsqrtf(wave_sum(ss) * (1.f / D) + EPS); float s2 = 0.f;
#pragma unroll
        for (int j = 0; j < 4; ++j) { const int col = 4 * lane + 256 * j; const f32x4 g = *(const f32x4*)(gpost + col), gt = *(const f32x4*)(mb + (3 * sub + 2) * D + col);
            const f32x4 xn = xr[64 * j] + gs * gt * (y[j] * rstd * g); xo[64 * j] = xn; y[j] = xn; s2 += (xn.x * xn.x + xn.y * xn.y) + (xn.z * xn.z + xn.w * xn.w); }
        if (mk_xn) {
            const float r2 = rsqrtf(wave_sum(s2) * (1.f / D) + EPS); u32x2* o8 = (u32x2*)(XN + (size_t)m * D) + lane;
#pragma unroll
            for (int j = 0; j < 4; ++j) { const int col = 4 * lane + 256 * j; const f32x4 g = *(const f32x4*)(gpre + col);
                const f32x4 sh = *(const f32x4*)(mb + (3 * sub + 3) * D + col), s1 = *(const f32x4*)(mb + (3 * sub + 4) * D + col);
                const f32x4 h = y[j] * r2 * g * (1.f + s1) + sh; u32x2 w; w.x = pk2(h.x, h.y); w.y = pk2(h.z, h.w); o8[64 * j] = w; }
        }
    }
}

template <bool DUAL, class Epi>
DEVI void gemm_simple(unsigned char* lds, const bf16_t* A, const bf16_t* Bt, int Mrows, int Nlog, int K, const Epi& E) {
    float* As = (float*)lds; float* Bs = As + 32 * 132;
    const int tid = threadIdx.x, ty = tid >> 4, tx = tid & 15;
    const int LC = DUAL ? 64 : 128, ntn = Nlog / LC, ntiles = (Mrows / 128) * ntn;
    for (int tile = blockIdx.x; tile < ntiles; tile += gridDim.x) {
        const int tm = tile / ntn, tn = tile % ntn;
        float acc[4][8];
#pragma unroll
        for (int i = 0; i < 4; ++i)
#pragma unroll
            for (int j = 0; j < 8; ++j) acc[i][j] = 0.f;
        const int lr = tid >> 2, kc = (tid & 3) * 8;
        const int brow = DUAL ? ((tn >> 1) * 256 + (lr >= 64 ? 128 : 0) + (tn & 1) * 64 + (lr & 63)) : tn * 128 + lr;
        const bf16_t* ap = A + (size_t)(tm * 128 + lr) * K + kc; const bf16_t* bp = Bt + (size_t)brow * K + kc;
        for (int k0 = 0; k0 < K; k0 += 32) {
            float fa[8], fb[8]; unpack8(*(const u32x4*)(ap + k0), fa); unpack8(*(const u32x4*)(bp + k0), fb);
            __syncthreads();
#pragma unroll
            for (int i = 0; i < 8; ++i) { As[(kc + i) * 132 + lr] = fa[i]; Bs[(kc + i) * 132 + lr] = fb[i]; }
            __syncthreads();
#pragma unroll 8
            for (int kk = 0; kk < 32; ++kk) {
                const f32x4 a = *(const f32x4*)(As + kk * 132 + 4 * ty), b0 = *(const f32x4*)(Bs + kk * 132 + 4 * tx), b1 = *(const f32x4*)(Bs + kk * 132 + 64 + 4 * tx);
#pragma unroll
                for (int i = 0; i < 4; ++i) { acc[i][0] += a[i] * b0[0]; acc[i][1] += a[i] * b0[1]; acc[i][2] += a[i] * b0[2]; acc[i][3] += a[i] * b0[3];
                    acc[i][4] += a[i] * b1[0]; acc[i][5] += a[i] * b1[1]; acc[i][6] += a[i] * b1[2]; acc[i][7] += a[i] * b1[3]; }
            }
        }
#pragma unroll
        for (int i = 0; i < 4; ++i) { const int row = tm * 128 + 4 * ty + i;
            const f32x4 v0 = {acc[i][0], acc[i][1], acc[i][2], acc[i][3]}, v1 = {acc[i][4], acc[i][5], acc[i][6], acc[i][7]};
            if (DUAL) E(row, tn * 64 + 4 * tx, v0, v1);
            else { E(row, tn * 128 + 4 * tx, v0, v0); E(row, tn * 128 + 64 + 4 * tx, v1, v1); } }
    }
}

DEVI void st_bf4(bf16_t* p, f32x4 v) { u32x2 w; w.x = pk2(v.x, v.y); w.y = pk2(v.z, v.w); *(u32x2*)p = w; }
DEVI f32x4 ld_bf4(const bf16_t* p) { const u32x2 w = *(const u32x2*)p; return (f32x4){__uint_as_float(w.x << 16), __uint_as_float(w.x & 0xffff0000u), __uint_as_float(w.y << 16), __uint_as_float(w.y & 0xffff0000u)}; }
struct EpSwiglu { bf16_t* H; DEVI void operator()(int row, int col, f32x4 g, f32x4 u) const {
    f32x4 o; o.x = silu_f(g.x) * u.x; o.y = silu_f(g.y) * u.y; o.z = silu_f(g.z) * u.z; o.w = silu_f(g.w) * u.w; st_bf4(H + (size_t)row * DFF + col, o); } };
struct EpF32 { float* Y; DEVI void operator()(int row, int col, f32x4 v, f32x4) const { *(f32x4*)(Y + (size_t)row * D + col) = v; } };
struct EpWin1 { unsigned char* ws; DEVI void operator()(int row, int col, f32x4 v, f32x4) const {
    if (col < 512) st_bf4((bf16_t*)(ws + WS_QA) + (size_t)row * 512 + col, v * QA_SCALE);
    else if (col < 1024) st_bf4((bf16_t*)(ws + WS_KA) + (size_t)row * 512 + (col - 512), v);
    else if (col < 2048) st_bf4((bf16_t*)(ws + WS_VA) + (size_t)row * D + (col - 1024), v);
    else if (col < 3072) st_bf4((bf16_t*)(ws + WS_QB) + (size_t)row * D + (col - 2048), v * C2);
    else if (col < 4096) st_bf4((bf16_t*)(ws + WS_KB) + (size_t)row * D + (col - 3072), v);
    else st_bf4((bf16_t*)(ws + WS_VB) + (size_t)row * D + (col - 4096), v); } };
struct EpWin2 { unsigned char* ws; DEVI void operator()(int row, int col, f32x4 v, f32x4) const {
    if (col < 1024) { f32x4 o = {silu_f(v.x), silu_f(v.y), silu_f(v.z), silu_f(v.w)}; st_bf4((bf16_t*)(ws + WS_RA) + (size_t)row * D + col, o); }
    else { f32x4 o = {sigmoid_f(v.x), sigmoid_f(v.y), sigmoid_f(v.z), sigmoid_f(v.w)}; st_bf4((bf16_t*)(ws + (col < 2048 ? WS_GA : WS_GB)) + (size_t)row * D + (col & 1023), o); } } };
struct EpPa { bf16_t* GA; DEVI void operator()(int row, int col, f32x4 v, f32x4) const { bf16_t* q = GA + (size_t)row * D + col; st_bf4(q, ld_bf4(q) * v); } };
struct EpPb { const bf16_t* Tm; bf16_t* GB; DEVI void operator()(int row, int col, f32x4 v, f32x4) const { bf16_t* q = GB + (size_t)row * D + col; st_bf4(q, ld_bf4(Tm + (size_t)row * D + col) + ld_bf4(q) * v); } };

DEVI void ph_thin_cols(const Params& p) {
    const bf16_t* XN = (const bf16_t*)(p.ws + WS_XN); const float* win = p.in[I_WIN]; const float* bf = p.in[I_BF];
    float* alow = (float*)(p.ws + WS_ALOW); float* logf = (float*)(p.ws + WS_LOGF);
    for (int v = blockIdx.x * 512 + threadIdx.x; v < M * 32; v += gridDim.x * 512) {
        const int m = v >> 5, j = v & 31, col = j < 16 ? 2048 + j : 6160 + (j - 16);
        const bf16_t* xr = XN + (size_t)m * D; const float* w = win + col; float s = 0.f;
        for (int k = 0; k < D; k += 8) { float f[8]; unpack8(*(const u32x4*)(xr + k), f);
#pragma unroll
            for (int i = 0; i < 8; ++i) s += f[i] * w[(size_t)(k + i) * INC]; }
        if (j < 16) alow[m * 16 + j] = s; else logf[(size_t)((m >> 13) * 16 + (j - 16)) * T + (m & (T - 1))] = logsigmoid_f(s + bf[j - 16]);
    }
}
DEVI void ph_fcum(const Params& p, unsigned char* lds) {
    const int tid = threadIdx.x, lane = tid & 63, wave = tid >> 6;
    double* wt = (double*)lds;
    for (int bh = blockIdx.x; bh < 32; bh += gridDim.x) {
        const float* lf = (const float*)(p.ws + WS_LOGF) + (size_t)bh * T + tid * 16; float* fc = (float*)(p.ws + WS_FCUM) + (size_t)bh * T + tid * 16;
        f32x4 v[4]; double s = 0.0;
#pragma unroll
        for (int i = 0; i < 4; ++i) { v[i] = ((const f32x4*)lf)[i]; s += ((double)v[i].x + (double)v[i].y) + ((double)v[i].z + (double)v[i].w); }
        double incl = s;
#pragma unroll
        for (int o = 1; o < 64; o <<= 1) { const double t = __shfl_up(incl, o); if (lane >= o) incl += t; }
        __syncthreads();
        if (lane == 63) wt[wave] = incl;
        __syncthreads();
        double run = incl - s;
        for (int w = 0; w < wave; ++w) run += wt[w];
#pragma unroll
        for (int i = 0; i < 4; ++i) { f32x4 o; run += (double)v[i].x; o.x = (float)run; run += (double)v[i].y; o.y = (float)run; run += (double)v[i].z; o.z = (float)run; run += (double)v[i].w; o.w = (float)run; ((f32x4*)fc)[i] = o; }
    }
    __syncthreads();
}
DEVI void ph_qk_norms(const Params& p) {
    const int lane = threadIdx.x & 63, gw = blockIdx.x * 8 + (threadIdx.x >> 6), NGW = gridDim.x * 8;
    const bf16_t* QB = (const bf16_t*)(p.ws + WS_QB); const bf16_t* KB = (const bf16_t*)(p.ws + WS_KB);
    unsigned* kmax = (unsigned*)(p.ws + WS_KMAX); unsigned* qmax = (unsigned*)(p.ws + WS_QMAX);
    for (int g = gw; g < M / 8; g += NGW) {
        float qm = 0.f, km = 0.f;
        for (int r = 0; r < 8; ++r) { const size_t off = (size_t)(g * 8 + r) * D + 16 * lane; float f[16];
            unpack8(*(const u32x4*)(QB + off), f); unpack8(*(const u32x4*)(QB + off + 8), f + 8); float sq = 0.f;
#pragma unroll
            for (int i = 0; i < 16; ++i) sq += f[i] * f[i];
            unpack8(*(const u32x4*)(KB + off), f); unpack8(*(const u32x4*)(KB + off + 8), f + 8); float sk = 0.f;
#pragma unroll
            for (int i = 0; i < 16; ++i) sk += f[i] * f[i];
            sq += __shfl_xor(sq, 1); sq += __shfl_xor(sq, 2); sk += __shfl_xor(sk, 1); sk += __shfl_xor(sk, 2);
            qm = fmaxf(qm, sq); km = fmaxf(km, sk); }
        if ((lane & 3) == 0) { const int row0 = g * 8, b = row0 >> 13, t = row0 & (T - 1), bh = b * 16 + (lane >> 2);
            atomicMax(kmax + bh * 128 + (t >> 6), __float_as_uint(km)); atomicMax(qmax + bh * 32 + (t >> 8), __float_as_uint(qm)); }
    }
}

template <bool OUT>
DEVI void gla_rec(const Params& p, unsigned char* lds, int unit) {
    const int j = unit & 31, bh = unit >> 5, h = bh & 3, b = bh >> 2;
    const int tid = threadIdx.x, e = tid & 255, dh = tid >> 8, d0 = dh * 64;
    float* qs = (float*)lds; float* ks = qs + 2048; float* al = ks + 2048; float* vs = al + 2048; float* red = vs + 4096; float* lsum = red + 8192;
    float* U = (float*)(p.ws + WS_U) + (size_t)unit * 32768;
    const bf16_t* QA = (const bf16_t*)(p.ws + WS_QA); const bf16_t* KA = (const bf16_t*)(p.ws + WS_KA); bf16_t* VA = (bf16_t*)(p.ws + WS_VA);
    const float* alow = (const float*)(p.ws + WS_ALOW);
    float S[64];
#pragma unroll
    for (int i = 0; i < 64; ++i) S[i] = OUT ? U[(d0 + i) * 256 + e] : 0.f;
    const int dd = tid & 127, tq = tid >> 7;
    float wa[16];
#pragma unroll
    for (int r = 0; r < 16; ++r) wa[r] = p.in[I_WA2][r * 512 + h * 128 + dd];
    const float ba = p.in[I_BA][h * 128 + dd];
    float lacc = 0.f;
    for (int sb = 0; sb < 16; ++sb) {
        const int t0 = b * T + j * 256 + sb * 16;
#pragma unroll
        for (int r = 0; r < 4; ++r) { const int tt = tq + 4 * r; const size_t row = (size_t)(t0 + tt);
            const f32x4* ar = (const f32x4*)(alow + row * 16); float s = ba;
#pragma unroll
            for (int q4 = 0; q4 < 4; ++q4) { const f32x4 a = ar[q4]; s += a.x * wa[4 * q4] + a.y * wa[4 * q4 + 1] + a.z * wa[4 * q4 + 2] + a.w * wa[4 * q4 + 3]; }
            const float la = logsigmoid_f(s) * (1.f / 16.f); lacc += la; al[tt * 128 + dd] = __expf(la);
            qs[tt * 128 + dd] = bf2f(QA[row * 512 + h * 128 + dd]); ks[tt * 128 + dd] = bf2f(KA[row * 512 + h * 128 + dd]); }
#pragma unroll
        for (int r = 0; r < 8; ++r) { const int idx = tid + 512 * r, tt = idx >> 8, ee = idx & 255; vs[idx] = bf2f(VA[(size_t)(t0 + tt) * D + h * 256 + ee]); }
        __syncthreads();
        for (int tt = 0; tt < 16; ++tt) {
            const float v = vs[tt * 256 + e]; float acc = 0.f;
            const float* alp = al + tt * 128 + d0; const float* kp = ks + tt * 128 + d0; const float* qp = qs + tt * 128 + d0;
#pragma unroll
            for (int i = 0; i < 64; ++i) { S[i] = alp[i] * S[i] + kp[i] * v; if (OUT) acc += qp[i] * S[i]; }
            if (OUT) red[(tt * 2 + dh) * 256 + e] = acc;
        }
        __syncthreads();
        if (OUT) {
#pragma unroll
            for (int r = 0; r < 8; ++r) { const int idx = tid + 512 * r, tt = idx >> 8, ee = idx & 255;
                VA[(size_t)(t0 + tt) * D + h * 256 + ee] = (bf16_t)f2bf(red[(tt * 2) * 256 + ee] + red[(tt * 2 + 1) * 256 + ee]); }
        }
    }
    if (!OUT) {
#pragma unroll
        for (int i = 0; i < 64; ++i) U[(d0 + i) * 256 + e] = S[i];
        lsum[tq * 128 + dd] = lacc; __syncthreads();
        if (tid < 128) ((float*)(p.ws + WS_DEC))[unit * 128 + tid] = __expf(lsum[tid] + lsum[128 + tid] + lsum[256 + tid] + lsum[384 + tid]);
    }
    __syncthreads();
}

#define LAS3 __attribute__((address_space(3)))
typedef short v4i16_t __attribute__((ext_vector_type(4)));
typedef short bf16x8_t __attribute__((ext_vector_type(8)));
typedef float f32x16_t __attribute__((ext_vector_type(16)));
constexpr size_t WS_E127 = 23 * MiB + 640 * 1024;
DEVI bf16x8_t tr_pair(const LAS3 char* p0, const LAS3 char* p1) {
    const v4i16_t a = __builtin_amdgcn_ds_read_tr16_b64_v4i16((LAS3 v4i16_t*)p0), b = __builtin_amdgcn_ds_read_tr16_b64_v4i16((LAS3 v4i16_t*)p1);
    return (bf16x8_t){a[0], a[1], a[2], a[3], b[0], b[1], b[2], b[3]};
}
DEVI int crow16(int r, int hi) { return (r & 3) + 8 * (r >> 2) + 4 * hi; }
DEVI float exp_cl(float x) { return __expf(fminf(x, 80.f)); }

DEVI void gla_passA(const Params& p, unsigned char* ldsg, int unit) {
    constexpr int KEP = 320, VP = 576, LV = 256 * KEP, LX = LV + 64 * VP;
    const int j = unit & 31, bh = unit >> 5, h = bh & 3, b = bh >> 2;
    int tid_ = threadIdx.x; asm volatile("" : "+v"(tid_));
    const int tid = tid_, lane = tid & 63, wave = __builtin_amdgcn_readfirstlane(tid >> 6), hi = lane >> 5;
    LAS3 char* lds = (LAS3 char*)ldsg; LAS3 float* tot = (LAS3 float*)(lds + LX); LAS3 float* scl = tot + 512;
    const size_t row0 = (size_t)b * T + j * 256;
    bf16_t* QA = (bf16_t*)(p.ws + WS_QA); bf16_t* KA = (bf16_t*)(p.ws + WS_KA); const bf16_t* VA = (const bf16_t*)(p.ws + WS_VA);
    const float* alow = (const float*)(p.ws + WS_ALOW);
    {
        const int dd = tid & 127, tq = tid >> 7;
        float wa[16];
#pragma unroll
        for (int r = 0; r < 16; ++r) wa[r] = p.in[I_WA2][r * 512 + h * 128 + dd];
        const float ba = p.in[I_BA][h * 128 + dd];
        float la[64]; float cum = 0.f;
#pragma unroll
        for (int i = 0; i < 64; ++i) { const f32x4* ar = (const f32x4*)(alow + (row0 + 64 * tq + i) * 16); float s = ba;
#pragma unroll
            for (int q4 = 0; q4 < 4; ++q4) { const f32x4 a = ar[q4]; s += a.x * wa[4 * q4] + a.y * wa[4 * q4 + 1] + a.z * wa[4 * q4 + 2] + a.w * wa[4 * q4 + 3]; }
            cum += logsigmoid_f(s) * (1.f / 16.f); la[i] = cum; }
        tot[tq * 128 + dd] = cum;
        __syncthreads();
        const float t0 = tot[dd], t1 = tot[128 + dd], t2 = tot[256 + dd], t3 = tot[384 + dd];
        const float off = tq == 0 ? 0.f : (tq == 1 ? t0 : (tq == 2 ? t0 + t1 : t0 + t1 + t2)), b127 = t0 + t1, b255 = b127 + t2 + t3;
#pragma unroll
        for (int i = 0; i < 64; ++i) { const float bt = off + la[i]; const size_t g = (row0 + 64 * tq + i) * 512 + h * 128 + dd;
            const unsigned qe = f2bf(bf2f(QA[g]) * exp_cl(bt - b127)), ke = f2bf(bf2f(KA[g]) * exp_cl(b127 - bt));
            QA[g] = (bf16_t)qe; KA[g] = (bf16_t)ke; *(LAS3 bf16_t*)(lds + (64 * tq + i) * KEP + dd * 2) = (bf16_t)ke; }
        if (tq == 0) { ((float*)(p.ws + WS_E127))[unit * 128 + dd] = __expf(b127); ((float*)(p.ws + WS_DEC))[unit * 128 + dd] = __expf(b255); scl[dd] = __expf(b255 - b127); }
    }
    const int db = wave & 3, eb0 = 4 * (wave >> 2), q4l = (lane & 15) >> 2, pl = lane & 3, chl = (lane >> 4) & 1;
    f32x16_t acc[4];
#pragma unroll
    for (int i = 0; i < 4; ++i) acc[i] = f32x16_t{};
    for (int R = 0; R < 4; ++R) {
        __syncthreads();
#pragma unroll
        for (int i = 0; i < 4; ++i) { const int c = tid + 512 * i, row = c >> 5, ch = c & 31;
            *(LAS3 u32x4*)(lds + LV + row * VP + ch * 16) = *(const u32x4*)(VA + (row0 + 64 * R + row) * D + h * 256 + 8 * ch); }
        __syncthreads();
#pragma unroll
        for (int g = 0; g < 4; ++g) {
            const LAS3 char* ka = lds + (64 * R + 16 * g + 8 * hi + q4l) * KEP + (32 * db + 16 * chl + 4 * pl) * 2;
            const bf16x8_t A = tr_pair(ka, ka + 4 * KEP);
            const LAS3 char* va = lds + LV + (16 * g + 8 * hi + q4l) * VP + (16 * chl + 4 * pl) * 2;
#pragma unroll
            for (int e4 = 0; e4 < 4; ++e4) { const bf16x8_t B = tr_pair(va + (eb0 + e4) * 64, va + (eb0 + e4) * 64 + 4 * VP);
                acc[e4] = __builtin_amdgcn_mfma_f32_32x32x16_bf16(A, B, acc[e4], 0, 0, 0); }
        }
    }
    float* U = (float*)(p.ws + WS_U) + (size_t)unit * 32768;
#pragma unroll
    for (int e4 = 0; e4 < 4; ++e4)
#pragma unroll
        for (int r = 0; r < 16; ++r) { const int d = 32 * db + crow16(r, hi); U[d * 256 + 32 * (eb0 + e4) + (lane & 31)] = scl[d] * acc[e4][r]; }
    __syncthreads();
}

DEVI void gla_passC(const Params& p, unsigned char* ldsg, int unit) {
    constexpr int SP = 272, VP = 576, KEO = 128 * VP, KEP = 272;
    const int j = unit & 31, bh = unit >> 5, h = bh & 3, b = bh >> 2;
    int tid_ = threadIdx.x; asm volatile("" : "+v"(tid_));
    const int tid = tid_, lane = tid & 63, wave = __builtin_amdgcn_readfirstlane(tid >> 6), hi = lane >> 5, l31 = lane & 31;
    LAS3 char* lds = (LAS3 char*)ldsg;
    const size_t row0 = (size_t)b * T + j * 256;
    const bf16_t* QA = (const bf16_t*)(p.ws + WS_QA); const bf16_t* KA = (const bf16_t*)(p.ws + WS_KA); bf16_t* VA = (bf16_t*)(p.ws + WS_VA);
#pragma unroll
    for (int i = 0; i < 8; ++i) { const int c = tid + 512 * i, row = c >> 4, ch = c & 15;
        *(LAS3 u32x4*)(lds + KEO + row * KEP + ch * 16) = *(const u32x4*)(KA + (row0 + row) * 512 + h * 128 + 8 * ch); }
    { const float* S = (const float*)(p.ws + WS_U) + (size_t)unit * 32768; const float* e127 = (const float*)(p.ws + WS_E127) + unit * 128;
#pragma unroll
      for (int i = 0; i < 8; ++i) { const int it = tid + 512 * i, e = it & 255, d0 = (it >> 8) * 8; float v[8];
#pragma unroll
          for (int q = 0; q < 8; ++q) v[q] = S[(d0 + q) * 256 + e] * e127[d0 + q];
          u32x4 w; w.x = pk2(v[0], v[1]); w.y = pk2(v[2], v[3]); w.z = pk2(v[4], v[5]); w.w = pk2(v[6], v[7]);
          *(LAS3 u32x4*)(lds + e * SP + d0 * 2) = w; } }
    const int tb = wave < 4 ? wave : 11 - wave;
    bf16x8_t qf[8];
#pragma unroll
    for (int g = 0; g < 8; ++g) qf[g] = *(const bf16x8_t*)(QA + (row0 + 32 * tb + l31) * 512 + h * 128 + 16 * g + 8 * hi);
    f32x16_t o[8];
#pragma unroll
    for (int i = 0; i < 8; ++i) o[i] = f32x16_t{};
    __syncthreads();
#pragma unroll
    for (int eb = 0; eb < 8; ++eb)
#pragma unroll
        for (int g = 0; g < 8; ++g) { const bf16x8_t B = *(const LAS3 bf16x8_t*)(lds + (32 * eb + l31) * SP + (16 * g + 8 * hi) * 2);
            o[eb] = __builtin_amdgcn_mfma_f32_32x32x16_bf16(qf[g], B, o[eb], 0, 0, 0); }
    const int q4l = (lane & 15) >> 2, pl = lane & 3, chl = (lane >> 4) & 1;
    for (int R = 0; R < 2; ++R) {
        __syncthreads();
#pragma unroll
        for (int i = 0; i < 8; ++i) { const int c = tid + 512 * i, row = c >> 5, ch = c & 31;
            *(LAS3 u32x4*)(lds + row * VP + ch * 16) = *(const u32x4*)(VA + (row0 + 128 * R + row) * D + h * 256 + 8 * ch); }
        __syncthreads();
        if (tb >= 4 * R) {
            const int sbe = tb < 4 * R + 3 ? tb : 4 * R + 3;
            for (int sb = 4 * R; sb <= sbe; ++sb) {
                f32x16_t st = f32x16_t{};
#pragma unroll
                for (int g = 0; g < 8; ++g) { const bf16x8_t A = *(const LAS3 bf16x8_t*)(lds + KEO + (32 * sb + l31) * KEP + (16 * g + 8 * hi) * 2);
                    st = __builtin_amdgcn_mfma_f32_32x32x16_bf16(A, qf[g], st, 0, 0, 0); }
                if (sb == tb) {
#pragma unroll
                    for (int r = 0; r < 16; ++r) if (crow16(r, hi) > l31) st[r] = 0.f;
                }
                u32x4 w0, w1;
                w0.x = pk2(st[0], st[1]); w0.y = pk2(st[2], st[3]); w0.z = pk2(st[4], st[5]); w0.w = pk2(st[6], st[7]);
                w1.x = pk2(st[8], st[9]); w1.y = pk2(st[10], st[11]); w1.z = pk2(st[12], st[13]); w1.w = pk2(st[14], st[15]);
                const bf16x8_t pa0 = __builtin_bit_cast(bf16x8_t, w0), pa1 = __builtin_bit_cast(bf16x8_t, w1);
                const LAS3 char* vb = lds + ((32 * sb - 128 * R) + 4 * hi + q4l) * VP + (16 * chl + 4 * pl) * 2;
#pragma unroll
                for (int eb = 0; eb < 8; ++eb) {
                    const bf16x8_t B0 = tr_pair(vb + eb * 64, vb + eb * 64 + 8 * VP), B1 = tr_pair(vb + eb * 64 + 16 * VP, vb + eb * 64 + 24 * VP);
                    o[eb] = __builtin_amdgcn_mfma_f32_32x32x16_bf16(pa0, B0, o[eb], 0, 0, 0);
                    o[eb] = __builtin_amdgcn_mfma_f32_32x32x16_bf16(pa1, B1, o[eb], 0, 0, 0); }
            }
        }
    }
    __syncthreads();
    const float* gg = p.in[I_GGLA] + h * 256;
    float gv[8];
#pragma unroll
    for (int eb = 0; eb < 8; ++eb) gv[eb] = gg[32 * eb + l31];
#pragma unroll
    for (int r = 0; r < 16; ++r) { float ss = 0.f;
#pragma unroll
        for (int eb = 0; eb < 8; ++eb) ss += o[eb][r] * o[eb][r];
        ss += __shfl_xor(ss, 1); ss += __shfl_xor(ss, 2); ss += __shfl_xor(ss, 4); ss += __shfl_xor(ss, 8); ss += __shfl_xor(ss, 16);
        const float rstd = rsqrtf(ss * (1.f / 256.f) + EPS); bf16_t* op = VA + (row0 + 32 * tb + crow16(r, hi)) * D + h * 256 + l31;
#pragma unroll
        for (int eb = 0; eb < 8; ++eb) op[32 * eb] = (bf16_t)f2bf(o[eb][r] * rstd * gv[eb]); }
    __syncthreads();
}
DEVI void ph_gla_scan(const Params& p) {
    float* U = (float*)(p.ws + WS_U); const float* dec = (const float*)(p.ws + WS_DEC);
    for (int v = blockIdx.x * 512 + threadIdx.x; v < 8 * 32768; v += gridDim.x * 512) {
        const int bh = v >> 15, de = v & 32767, d = de >> 8; float s = 0.f;
        for (int j = 0; j < 32; ++j) { const int unit = bh * 32 + j; float* q = U + (size_t)unit * 32768 + de; const float u = *q; *q = s; s = dec[unit * 128 + d] * s + u; }
    }
}
DEVI void ph_oa_norm(const Params& p) {
    const int lane = threadIdx.x & 63, gw = blockIdx.x * 8 + (threadIdx.x >> 6), NGW = gridDim.x * 8;
    bf16_t* OA = (bf16_t*)(p.ws + WS_VA); const bf16_t* RA = (const bf16_t*)(p.ws + WS_RA); const float* gg = p.in[I_GGLA];
    for (int m = gw; m < M; m += NGW) {
        bf16_t* op = OA + (size_t)m * D + 16 * lane; const bf16_t* rp = RA + (size_t)m * D + 16 * lane;
        float o[16], r[16]; unpack8(*(const u32x4*)op, o); unpack8(*(const u32x4*)(op + 8), o + 8); unpack8(*(const u32x4*)rp, r); unpack8(*(const u32x4*)(rp + 8), r + 8);
        float ss = 0.f;
#pragma unroll
        for (int i = 0; i < 16; ++i) ss += o[i] * o[i];
        ss += __shfl_xor(ss, 1); ss += __shfl_xor(ss, 2); ss += __shfl_xor(ss, 4); ss += __shfl_xor(ss, 8);
        const float rstd = rsqrtf(ss * (1.f / 256.f) + EPS);
        u32x4 w0, w1; float t[16];
#pragma unroll
        for (int i = 0; i < 16; ++i) t[i] = o[i] * rstd * gg[16 * lane + i] * r[i];
        w0.x = pk2(t[0], t[1]); w0.y = pk2(t[2], t[3]); w0.z = pk2(t[4], t[5]); w0.w = pk2(t[6], t[7]);
        w1.x = pk2(t[8], t[9]); w1.y = pk2(t[10], t[11]); w1.z = pk2(t[12], t[13]); w1.w = pk2(t[14], t[15]);
        *(u32x4*)op = w0; *(u32x4*)(op + 8) = w1;
    }
}

DEVI void attn_simple_unit(const Params& p, unsigned char* lds, int unit) {
    const int qb = 15 - (unit >> 5), bh = unit & 31, b = bh >> 4, hh = bh & 15;
    float* Ks = (float*)lds; float* Vs = Ks + 4096; float* bs = Vs + 4096;
    const int tid = threadIdx.x, t = qb * 512 + tid; const size_t row = (size_t)(b * T + t);
    bf16_t* QB = (bf16_t*)(p.ws + WS_QB); const bf16_t* KB = (const bf16_t*)(p.ws + WS_KB); const bf16_t* VB = (const bf16_t*)(p.ws + WS_VB);
    const float* fc = (const float*)(p.ws + WS_FCUM) + (size_t)bh * T;
    float q[64], o[64];
#pragma unroll
    for (int i = 0; i < 8; ++i) unpack8(*(const u32x4*)(QB + row * D + hh * 64 + 8 * i), q + 8 * i);
#pragma unroll
    for (int i = 0; i < 64; ++i) o[i] = 0.f;
    float mx = -1e30f, l = 0.f; const float Fq0 = fc[qb * 512];
    const int nkt = (qb * 512 + 512) / 64;
    for (int kt = 0; kt < nkt; ++kt) {
        __syncthreads();
        { const int key = tid >> 3, c = (tid & 7) * 8; const size_t g = (size_t)(b * T + kt * 64 + key) * D + hh * 64 + c;
          unpack8(*(const u32x4*)(KB + g), Ks + key * 64 + c); unpack8(*(const u32x4*)(VB + g), Vs + key * 64 + c); }
        if (tid < 64) bs[tid] = (Fq0 - fc[kt * 64 + tid]) * LOG2E;
        __syncthreads();
        const int smax = t - kt * 64;
        for (int s = 0; s < 64; ++s) {
            if (s <= smax) {
                float sc = bs[s]; const float* kr = Ks + s * 64;
#pragma unroll
                for (int i = 0; i < 64; ++i) sc += q[i] * kr[i];
                if (sc > mx + 8.f) { const float f = exp2f(mx - sc); l *= f;
#pragma unroll
                    for (int i = 0; i < 64; ++i) o[i] *= f;
                    mx = sc; }
                const float pr = exp2f(sc - mx); l += pr; const float* vr = Vs + s * 64;
#pragma unroll
                for (int i = 0; i < 64; ++i) o[i] += pr * vr[i];
            }
        }
    }
    const float inv = 1.f / l;
#pragma unroll
    for (int i = 0; i < 8; ++i) { u32x4 w; w.x = pk2(o[8 * i] * inv, o[8 * i + 1] * inv); w.y = pk2(o[8 * i + 2] * inv, o[8 * i + 3] * inv); w.z = pk2(o[8 * i + 4] * inv, o[8 * i + 5] * inv); w.w = pk2(o[8 * i + 6] * inv, o[8 * i + 7] * inv);
        *(u32x4*)(QB + row * D + hh * 64 + 8 * i) = w; }
    __syncthreads();
}

namespace pg8 {
#define PG8_LAS __attribute__((address_space(3)))
typedef unsigned short bf16_t;
typedef short bf16x8 __attribute__((ext_vector_type(8)));
typedef float f32x4 __attribute__((ext_vector_type(4)));
typedef unsigned u32x4 __attribute__((ext_vector_type(4)));
constexpr int BM = 256, BK = 64, HALF = 128, HTB = HALF * BK * 2  , STAGE_BYTES = 8 * HTB, NXCD = 8, WGM = 8;

__host__ __device__ __forceinline__ int lds_byte(int r, int c) { const int st = (r >> 4) * 2 + (c >> 5), rr = r & 15, cc = c & 31, ob = rr * 64 + cc * 2; return st * 1024 + (ob ^ (((ob >> 9) & 1) << 5)); }
__host__ __device__ __forceinline__ void stage_rc(int b, int& R, int& C) { const int st = b / 1024, sb = b % 1024, swz = sb ^ (((sb >> 9) & 1) << 5); R = (st >> 1) * 16 + swz / 64; C = (st & 1) * 32 + (swz % 64) / 2; }
__host__ __device__ __forceinline__ int perm32(int rho) { const int n = rho >> 4, i = rho & 15; return 8 * (i >> 2) + 4 * n + (i & 3); }

struct Unit { int pm, pn; };
struct Gemm { const bf16_t* A; const bf16_t* Bt; int M, N, K; };

struct StaticOrder {
    int nM, nN, nwg, G, c;
    __host__ __device__ void init(int M, int N, int G_, int c_) { nM = M / BM; nN = N / BM; nwg = nM * nN; G = G_; c = c_; }
    __host__ __device__ bool next(int i, Unit& u) const {
        const long L = (long)i * G + c; if (L >= nwg) return false;
        int wgid = (int)L; { const int q = nwg / NXCD, r = nwg % NXCD, xcd = wgid % NXCD, off = wgid / NXCD; wgid = (xcd < r ? xcd * (q + 1) : r * (q + 1) + (xcd - r) * q) + off; }
        const int nig = WGM * nN, gid = wgid / nig, fm = gid * WGM, gsz = (nM - fm) < WGM ? (nM - fm) : WGM;
        u.pm = fm + ((wgid % nig) % gsz); u.pn = (wgid % nig) / gsz; return true;
    }
    __device__ __forceinline__ void a_ready(const Unit&) const {}
    __device__ __forceinline__ void done(const Unit&) const {}
};

__device__ __forceinline__ unsigned cvt_pk_bf16(float lo, float hi) { unsigned r; asm volatile("v_cvt_pk_bf16_f32 %0, %1, %2" : "=v"(r) : "v"(lo), "v"(hi)); return r; }
typedef float f32x2 __attribute__((ext_vector_type(2)));

__device__ __forceinline__ float silu_fast(float x) { return x * __builtin_amdgcn_rcpf(1.f + __expf(-x)); }
__device__ __forceinline__ float sigm_fast(float x) { return __builtin_amdgcn_rcpf(1.f + __expf(-x)); }
__device__ __forceinline__ u32x4 pack8(const f32x4 a, const f32x4 b) { u32x4 w; w.x = cvt_pk_bf16(a[0], a[1]); w.y = cvt_pk_bf16(a[2], a[3]); w.z = cvt_pk_bf16(b[0], b[1]); w.w = cvt_pk_bf16(b[2], b[3]); return w; }
__device__ __forceinline__ void unpack8v(const u32x4 v, f32x4& a, f32x4& b) {
    a[0] = __uint_as_float(v.x << 16); a[1] = __uint_as_float(v.x & 0xffff0000u); a[2] = __uint_as_float(v.y << 16); a[3] = __uint_as_float(v.y & 0xffff0000u);
    b[0] = __uint_as_float(v.z << 16); b[1] = __uint_as_float(v.z & 0xffff0000u); b[2] = __uint_as_float(v.w << 16); b[3] = __uint_as_float(v.w & 0xffff0000u); }
struct EpiSwiglu { static constexpr bool PERM = true, AFTER_DRAIN = false; bf16_t* H; int ldh;
    __device__ __forceinline__ void operator()(const f32x4 (&acc)[2][2][4][2], const Unit& u, int wr, int wc, int fr, int fq) const {
        const int row0 = u.pm * BM + wr * 64 + fr, col0 = u.pn * HALF + wc * 32 + 8 * fq;
#pragma unroll
        for (int ai = 0; ai < 2; ++ai)
#pragma unroll
            for (int m = 0; m < 4; ++m) { f32x4 o0, o1;
#pragma unroll
                for (int i = 0; i < 4; ++i) { o0[i] = silu_fast(acc[ai][0][m][0][i]) * acc[ai][1][m][0][i]; o1[i] = silu_fast(acc[ai][0][m][1][i]) * acc[ai][1][m][1][i]; }
                *(u32x4*)(H + (size_t)(row0 + ai * HALF + m * 16) * ldh + col0) = pack8(o0, o1); }
    }
};
struct Seg { bf16_t* base; int ld, colt, act; float sc; };
struct EpiSeg { static constexpr bool PERM = true, AFTER_DRAIN = false; unsigned char* ws; int which;
    __device__ __forceinline__ Seg seg(int pn) const { Seg s; s.sc = 1.f; s.act = 0;
        if (which == 0) {
            if (pn < 2) { s.base = (bf16_t*)(ws + WS_QA); s.ld = 512; s.colt = pn * 256; s.sc = QA_SCALE; }
            else if (pn < 4) { s.base = (bf16_t*)(ws + WS_KA); s.ld = 512; s.colt = (pn - 2) * 256; }
            else if (pn < 8) { s.base = (bf16_t*)(ws + WS_VA); s.ld = 1024; s.colt = (pn - 4) * 256; }
            else if (pn < 12) { s.base = (bf16_t*)(ws + WS_QB); s.ld = 1024; s.colt = (pn - 8) * 256; s.sc = C2; }
            else if (pn < 16) { s.base = (bf16_t*)(ws + WS_KB); s.ld = 1024; s.colt = (pn - 12) * 256; }
            else { s.base = (bf16_t*)(ws + WS_VB); s.ld = 1024; s.colt = (pn - 16) * 256; }
        } else {
            s.ld = 1024; s.colt = (pn & 3) * 256;
            if (pn < 4) { s.base = (bf16_t*)(ws + (which == 2 ? WS_VA : WS_RA)); s.act = which == 2 ? 3 : 1; } else if (pn < 8) { s.base = (bf16_t*)(ws + WS_GA); s.act = 2; } else { s.base = (bf16_t*)(ws + WS_GB); s.act = 2; }
        }
        return s; }
    __device__ __forceinline__ void operator()(const f32x4 (&acc)[2][2][4][2], const Unit& u, int wr, int wc, int fr, int fq) const {
        const Seg s = seg(u.pn); const int row0 = u.pm * BM + wr * 64 + fr, col0 = s.colt + wc * 32 + 8 * fq;
#pragma unroll
        for (int ai = 0; ai < 2; ++ai)
#pragma unroll
            for (int m = 0; m < 4; ++m) { bf16_t* rowp = s.base + (size_t)(row0 + ai * HALF + m * 16) * s.ld + col0;
#pragma unroll
                for (int bj = 0; bj < 2; ++bj) { f32x4 v0 = acc[ai][bj][m][0], v1 = acc[ai][bj][m][1];
                    if (s.act == 1) {
#pragma unroll
                        for (int i = 0; i < 4; ++i) { v0[i] = silu_fast(v0[i]); v1[i] = silu_fast(v1[i]); } }
                    else if (s.act == 2) {
#pragma unroll
                        for (int i = 0; i < 4; ++i) { v0[i] = sigm_fast(v0[i]); v1[i] = sigm_fast(v1[i]); } }
                    else if (s.act == 3) { f32x4 a0, a1; unpack8v(*(const u32x4*)(rowp + bj * HALF), a0, a1);
#pragma unroll
                        for (int i = 0; i < 4; ++i) { v0[i] = a0[i] * silu_fast(v0[i]); v1[i] = a1[i] * silu_fast(v1[i]); } }
                    else { v0 = v0 * s.sc; v1 = v1 * s.sc; }
                    *(u32x4*)(rowp + bj * HALF) = pack8(v0, v1); } }
    }
};
template <int MODE> struct EpiGate { static constexpr bool PERM = true, AFTER_DRAIN = false; bf16_t* G; const bf16_t* Tm;
    __device__ __forceinline__ void operator()(const f32x4 (&acc)[2][2][4][2], const Unit& u, int wr, int wc, int fr, int fq) const {
        const int row0 = u.pm * BM + wr * 64 + fr, col0 = u.pn * BM + wc * 32 + 8 * fq;
#pragma unroll
        for (int ai = 0; ai < 2; ++ai)
#pragma unroll
            for (int m = 0; m < 4; ++m) { const size_t off = (size_t)(row0 + ai * HALF + m * 16) * D + col0;
#pragma unroll
                for (int bj = 0; bj < 2; ++bj) { f32x4 g0, g1; unpack8v(*(const u32x4*)(G + off + bj * HALF), g0, g1);
                    f32x4 v0 = g0 * acc[ai][bj][m][0], v1 = g1 * acc[ai][bj][m][1];
                    if (MODE == 1) { f32x4 t0, t1; unpack8v(*(const u32x4*)(Tm + off + bj * HALF), t0, t1); v0 += t0; v1 += t1; }
                    *(u32x4*)(G + off + bj * HALF) = pack8(v0, v1); } }
    }
};
struct EpiF32 { static constexpr bool PERM = false, AFTER_DRAIN = false; float* Y;
    __device__ __forceinline__ void operator()(const f32x4 (&acc)[2][2][4][2], const Unit& u, int wr, int wc, int fr, int fq) const {
        const int row0 = u.pm * BM + wr * 64 + fr, col0 = u.pn * BM + wc * 32 + 4 * fq;
#pragma unroll
        for (int ai = 0; ai < 2; ++ai)
#pragma unroll
            for (int m = 0; m < 4; ++m) { float* rowp = Y + (size_t)(row0 + ai * HALF + m * 16) * D + col0;
#pragma unroll
                for (int bj = 0; bj < 2; ++bj)
#pragma unroll
                    for (int n = 0; n < 2; ++n) *(f32x4*)(rowp + bj * HALF + n * 16) = acc[ai][bj][m][n]; }
    }
};

template <class Epi, class Sched, bool ALIGN_EPI = false, bool SP2 = false>
__device__ __forceinline__ void gemm_phase(PG8_LAS unsigned char* lds, const Gemm g, const Sched& S, const Epi& E) {
    int tid_ = threadIdx.x; asm volatile("" : "+v"(tid_));
    const int tid = tid_, wid = __builtin_amdgcn_readfirstlane(tid >> 6), lane = tid & 63, wr = wid >> 2, wc = wid & 3, fr = lane & 15, fq = lane >> 4;
    const int K = g.K, nt = K / BK;
    unsigned voffA[2], voffB[2];
#pragma unroll
    for (int i = 0; i < 2; ++i) { int R, C; stage_rc(tid * 16 + i * 8192, R, C); const int Rb = Epi::PERM ? ((R & ~31) + perm32(R & 31)) : R;
        voffA[i] = (unsigned)(R * K + C) * 2u; voffB[i] = (unsigned)(Rb * K + C) * 2u; }
    const size_t kstep = (size_t)(BK * 2);
    const size_t hstep = (size_t)HALF * K * 2;
    const size_t tstep = 2 * hstep;
    const unsigned ldsw = (unsigned)wid * 1024u;
    const int aoff = lds_byte(wr * 64 + fr, fq * 8), boff = lds_byte(wc * 32 + fr, fq * 8);
#define PG8_SA(b, h) (((b) * 2 + (h)) * HTB)
#define PG8_SB(b, h) ((4 + (b) * 2 + (h)) * HTB)
#define PG8_STAGE(bufoff, gbase, voff) do { _Pragma("unroll") for (int _i = 0; _i < 2; ++_i) \
        __builtin_amdgcn_global_load_lds((const unsigned*)((const char*)(gbase) + (voff)[_i]), (PG8_LAS unsigned*)(lds + (bufoff) + ldsw + _i * 8192), 16, 0, 0); } while (0)
#define PG8_LDA(dst, b, h) do { _Pragma("unroll") for (int m = 0; m < 4; ++m) _Pragma("unroll") for (int k = 0; k < 2; ++k) dst[m][k] = *(const PG8_LAS bf16x8*)(lds + PG8_SA(b, h) + aoff + m * 2048 + k * 1024); } while (0)
#define PG8_LDB(dst, b, h) do { _Pragma("unroll") for (int n = 0; n < 2; ++n) _Pragma("unroll") for (int k = 0; k < 2; ++k) dst[n][k] = *(const PG8_LAS bf16x8*)(lds + PG8_SB(b, h) + boff + n * 2048 + k * 1024); } while (0)
#define PG8_MMA(ai, bj, At, Bt) do { __builtin_amdgcn_s_setprio(1); _Pragma("unroll") for (int m = 0; m < 4; ++m) _Pragma("unroll") for (int n = 0; n < 2; ++n) _Pragma("unroll") for (int k = 0; k < 2; ++k) \
        acc[ai][bj][m][n] = __builtin_amdgcn_mfma_f32_16x16x32_bf16(Bt[n][k], At[m][k], acc[ai][bj][m][n], 0, 0, 0); __builtin_amdgcn_s_setprio(0); } while (0)
#define PG8_WAIT_V(n) asm volatile("s_waitcnt vmcnt(" #n ")" ::: "memory")
#define PG8_WAIT_L(n) asm volatile("s_waitcnt lgkmcnt(" #n ")" ::: "memory")
#define PG8_BAR __builtin_amdgcn_s_barrier()
#define PG8_SCHED __builtin_amdgcn_sched_barrier(0)
    Unit cur, nxt; int ui = 0;
    if (!S.next(0, cur)) return;
    f32x4 acc[2][2][4][2];
#pragma unroll
    for (int a = 0; a < 2; ++a)
#pragma unroll
        for (int b = 0; b < 2; ++b)
#pragma unroll
            for (int m = 0; m < 4; ++m)
#pragma unroll
                for (int n = 0; n < 2; ++n) acc[a][b][m][n] = (f32x4){0.f, 0.f, 0.f, 0.f};
    bf16x8 At[4][2], B0[2][2], B1[2][2];
    const char* cA = (const char*)g.A + (size_t)cur.pm * tstep; const char* cB = (const char*)g.Bt + (size_t)cur.pn * tstep;
    S.a_ready(cur);
    if constexpr (SP2) {
        PG8_STAGE(PG8_SB(0, 0), cB, voffB); PG8_STAGE(PG8_SB(0, 1), cB + hstep, voffB); PG8_STAGE(PG8_SA(0, 0), cA, voffA); PG8_STAGE(PG8_SA(0, 1), cA + hstep, voffA);
        if (wr == 1) PG8_BAR;
        PG8_WAIT_V(2); PG8_BAR;
        PG8_STAGE(PG8_SB(1, 0), cB + kstep, voffB); PG8_STAGE(PG8_SA(1, 0), cA + kstep, voffA); PG8_STAGE(PG8_SB(1, 1), cB + hstep + kstep, voffB);
        PG8_WAIT_V(6); PG8_BAR;
    } else {
        PG8_STAGE(PG8_SB(0, 0), cB, voffB); PG8_STAGE(PG8_SA(0, 0), cA, voffA); PG8_STAGE(PG8_SB(0, 1), cB + hstep, voffB); PG8_STAGE(PG8_SA(0, 1), cA + hstep, voffA);
        if (wr == 1) PG8_BAR;
        PG8_WAIT_V(4); PG8_BAR;
        PG8_STAGE(PG8_SB(1, 0), cB + kstep, voffB); PG8_STAGE(PG8_SA(1, 0), cA + kstep, voffA); PG8_STAGE(PG8_SB(1, 1), cB + hstep + kstep, voffB);
        PG8_WAIT_V(6); PG8_BAR;
    }
    for (;;) {
        const bool has_next = S.next(ui + 1, nxt);
        const char* nA = has_next ? (const char*)g.A + (size_t)nxt.pm * tstep : cA; const char* nB = has_next ? (const char*)g.Bt + (size_t)nxt.pn * tstep : cB;
        for (int t = 0; t < nt; t += 2) {
            const bool last = (t == nt - 2);
            const char* a1 = cA + (size_t)(t + 1) * kstep;
            const char* a2 = last ? nA : cA + (size_t)(t + 2) * kstep; const char* b2 = last ? nB : cB + (size_t)(t + 2) * kstep;
            const char* a3 = a2 + kstep; const char* b3 = b2 + kstep;
            if (last && has_next) S.a_ready(nxt);
            if constexpr (SP2) {
            PG8_LDB(B0, 0, 0); PG8_LDB(B1, 0, 1); PG8_SCHED; PG8_LDA(At, 0, 0); PG8_STAGE(PG8_SA(1, 1), a1 + hstep, voffA);
            PG8_WAIT_V(8); PG8_WAIT_L(0); PG8_BAR; PG8_MMA(0, 0, At, B0); PG8_MMA(0, 1, At, B1); PG8_BAR; PG8_SCHED;
            PG8_LDA(At, 0, 1); PG8_STAGE(PG8_SB(0, 0), b2, voffB); PG8_STAGE(PG8_SB(0, 1), b2 + hstep, voffB); PG8_STAGE(PG8_SA(0, 0), a2, voffA);
            PG8_WAIT_V(8); PG8_WAIT_L(0); PG8_BAR; PG8_MMA(1, 0, At, B0); PG8_MMA(1, 1, At, B1); PG8_BAR; PG8_SCHED;
            PG8_LDB(B0, 1, 0); PG8_LDB(B1, 1, 1); PG8_SCHED; PG8_LDA(At, 1, 0); PG8_STAGE(PG8_SA(0, 1), a2 + hstep, voffA);
            PG8_WAIT_V(8); PG8_WAIT_L(0); PG8_BAR; PG8_MMA(0, 0, At, B0); PG8_MMA(0, 1, At, B1); PG8_BAR; PG8_SCHED;
            PG8_LDA(At, 1, 1); PG8_STAGE(PG8_SB(1, 0), b3, voffB); PG8_STAGE(PG8_SB(1, 1), b3 + hstep, voffB); PG8_STAGE(PG8_SA(1, 0), a3, voffA);
            PG8_WAIT_V(8); PG8_WAIT_L(0); PG8_BAR; PG8_MMA(1, 0, At, B0); PG8_MMA(1, 1, At, B1); PG8_BAR; PG8_SCHED;
            } else {
            PG8_LDB(B0, 0, 0); PG8_SCHED; PG8_LDA(At, 0, 0); PG8_STAGE(PG8_SA(1, 1), a1 + hstep, voffA);
            PG8_WAIT_L(8); PG8_BAR; PG8_WAIT_L(0); PG8_MMA(0, 0, At, B0); PG8_BAR; PG8_SCHED;
            PG8_LDB(B1, 0, 1); PG8_STAGE(PG8_SB(0, 0), b2, voffB);
            PG8_BAR; PG8_WAIT_L(0); PG8_MMA(0, 1, At, B1); PG8_BAR;
            PG8_LDA(At, 0, 1); PG8_STAGE(PG8_SA(0, 0), a2, voffA);
            PG8_BAR; PG8_WAIT_L(0); PG8_MMA(1, 0, At, B0); PG8_BAR; PG8_SCHED;
            PG8_STAGE(PG8_SB(0, 1), b2 + hstep, voffB);
            PG8_WAIT_V(6); PG8_BAR; PG8_MMA(1, 1, At, B1); PG8_BAR;
            PG8_LDB(B0, 1, 0); PG8_SCHED; PG8_LDA(At, 1, 0); PG8_STAGE(PG8_SA(0, 1), a2 + hstep, voffA);
            PG8_WAIT_L(8); PG8_BAR; PG8_WAIT_L(0); PG8_MMA(0, 0, At, B0); PG8_BAR; PG8_SCHED;
            PG8_LDB(B1, 1, 1); PG8_STAGE(PG8_SB(1, 0), b3, voffB);
            PG8_BAR; PG8_WAIT_L(0); PG8_MMA(0, 1, At, B1); PG8_BAR;
            PG8_LDA(At, 1, 1); PG8_STAGE(PG8_SA(1, 0), a3, voffA);
            PG8_BAR; PG8_WAIT_L(0); PG8_MMA(1, 0, At, B0); PG8_BAR; PG8_SCHED;
            PG8_STAGE(PG8_SB(1, 1), b3 + hstep, voffB);
            PG8_WAIT_V(6); PG8_BAR; PG8_MMA(1, 1, At, B1); PG8_BAR;
            }
        }
        if constexpr (ALIGN_EPI) { if (wr == 0) PG8_BAR; }
        if constexpr (!Epi::AFTER_DRAIN) { E(acc, cur, wr, wc, fr, fq); S.done(cur); }
        if (!has_next) break;
#pragma unroll
        for (int a = 0; a < 2; ++a)
#pragma unroll
            for (int b = 0; b < 2; ++b)
#pragma unroll
                for (int m = 0; m < 4; ++m)
#pragma unroll
                    for (int n = 0; n < 2; ++n) acc[a][b][m][n] = (f32x4){0.f, 0.f, 0.f, 0.f};
        cur = nxt; cA = nA; cB = nB; ++ui;
        if constexpr (ALIGN_EPI) { if (wr == 1) PG8_BAR; }
    }
    PG8_WAIT_V(0);
    if constexpr (!ALIGN_EPI) { if (wr == 0) PG8_BAR; }
    PG8_BAR;
    if constexpr (Epi::AFTER_DRAIN) { E.fused(acc, cur, wr, wc, fr, fq, lds, wid, lane); S.done(cur); }
#undef PG8_SA
#undef PG8_SB
#undef PG8_STAGE
#undef PG8_LDA
#undef PG8_LDB
#undef PG8_MMA
#undef PG8_WAIT_V
#undef PG8_WAIT_L
#undef PG8_BAR
#undef PG8_SCHED
}
}


template <class Epi, bool ALIGN>
DEVI void run_gemm(unsigned char* lds, const bf16_t* A, const bf16_t* Bt, int Mr, int N, int K, const Epi& E) {
    pg8::Gemm g{A, Bt, Mr, N, K}; pg8::StaticOrder S; S.init(Mr, N, (int)gridDim.x, (int)blockIdx.x);
    pg8::gemm_phase<Epi, pg8::StaticOrder, ALIGN, true>((PG8_LAS unsigned char*)lds, g, S, E);
}
#include <hip/hip_bf16.h>
#include <cmath>
namespace attn_body {
using bf16=__hip_bfloat16;
using bf16x8=__attribute__((ext_vector_type(8)))short;
using s16x4=__attribute__((ext_vector_type(4)))short;
using f32x16=__attribute__((ext_vector_type(16)))float;
using u32x4=__attribute__((ext_vector_type(4)))unsigned;
constexpr int BATCH=2,NHEAD=16,SEQ=8192,D=64,DM=NHEAD*D;
constexpr int NW=8,QBLK=32,QB=QBLK*NW,KVBLK=64,NQB=SEQ/QB;
constexpr int ATTN_PITCH=DM, ATTN_UNIT_ROWS=QB;
__device__ __forceinline__ int crow(int r,int hi){return (r&3)+8*(r>>2)+4*hi;}
#define SBAR() __builtin_amdgcn_sched_barrier(0)
__device__ __forceinline__ void cmask(f32x16&p0,f32x16&p1,int jb,int qrel,int hi){
  const float NEG=-INFINITY; int kb=64*jb+4*hi;
  #pragma unroll
  for(int r=0;r<16;++r){int kv=kb+(r&3)+8*(r>>2); if(kv>qrel)p0[r]=NEG; if(kv+32>qrel)p1[r]=NEG;}
}

constexpr int NSLOT=3, SLOTB=8192;
constexpr int LDS_K=0, LDS_V=NSLOT*SLOTB, LDS_WS=2*NSLOT*SLOTB, LDS_OST=LDS_WS+NW*64*4, LDS_BYTES=LDS_OST+NW*4096;
constexpr float PRUNE_MARGIN=64.f;
constexpr int LDS_FB=LDS_BYTES;
constexpr float C2=0.125f*1.4426950408889634f;
__device__ __forceinline__ void glds16(const void*gsrc,unsigned lds_dst){unsigned keep;
  asm volatile("s_mov_b32 %0, m0\n\ts_mov_b32 m0, %2\n\ts_nop 0\n\tglobal_load_lds_dwordx4 %1, off\n\ts_mov_b32 m0, %0":"=&s"(keep):"v"(gsrc),"s"(lds_dst):"memory");}
__device__ __forceinline__ float max3f(float a,float b,float c){float r;asm("v_max3_f32 %0, %1, %2, %3":"=v"(r):"v"(a),"v"(b),"v"(c));return r;}
__device__ __forceinline__ float max2f(float a,float b){float r;asm("v_max_f32_e32 %0, %1, %2":"=v"(r):"v"(a),"v"(b));return r;}
__device__ __forceinline__ float fadd_s(float a,float b){float r;asm("v_add_f32_e32 %0, %1, %2":"=v"(r):"v"(a),"v"(b));return r;}
__device__ __forceinline__ float fsub_s(float a,float b){float r;asm("v_sub_f32_e32 %0, %1, %2":"=v"(r):"v"(a),"v"(b));return r;}
typedef float f32x2_t __attribute__((ext_vector_type(2))); typedef float f32x4_t __attribute__((ext_vector_type(4))); typedef __bf16 bf16x2_t __attribute__((ext_vector_type(2)));
__device__ __forceinline__ unsigned cvtpk_s(float lo,float hi){f32x2_t v={lo,hi};bf16x2_t b=__builtin_convertvector(v,bf16x2_t);return __builtin_bit_cast(unsigned,b);}
#define WAIT_BAR(N) asm volatile("s_waitcnt vmcnt(" #N ") lgkmcnt(0)\n\ts_barrier":::"memory")

__device__ __forceinline__ void qkt(f32x16&p0,f32x16&p1,const char*Kslot,const bf16x8*qr,int r32,int hi){
  const char*kb=Kslot+hi*1024+r32*16;
  #pragma unroll
  for(int d0=0;d0<4;++d0){
    const bf16x8 b0=*reinterpret_cast<const bf16x8*>(kb+d0*2048);
    const bf16x8 b1=*reinterpret_cast<const bf16x8*>(kb+d0*2048+512);
    {p0=__builtin_amdgcn_mfma_f32_32x32x16_bf16(b0,qr[d0],p0,0,0,0);p1=__builtin_amdgcn_mfma_f32_32x32x16_bf16(b1,qr[d0],p1,0,0,0);}}
}
typedef __attribute__((address_space(3))) const char* lds_cptr;
typedef short v4i16_t __attribute__((ext_vector_type(4)));
__device__ __forceinline__ void kload8(bf16x8*kf,lds_cptr kp){
  kf[0]=*(const __attribute__((address_space(3))) bf16x8*)(kp);      kf[1]=*(const __attribute__((address_space(3))) bf16x8*)(kp+512);
  kf[2]=*(const __attribute__((address_space(3))) bf16x8*)(kp+2048); kf[3]=*(const __attribute__((address_space(3))) bf16x8*)(kp+2560);
  kf[4]=*(const __attribute__((address_space(3))) bf16x8*)(kp+4096); kf[5]=*(const __attribute__((address_space(3))) bf16x8*)(kp+4608);
  kf[6]=*(const __attribute__((address_space(3))) bf16x8*)(kp+6144); kf[7]=*(const __attribute__((address_space(3))) bf16x8*)(kp+6656);
}
__device__ __forceinline__ void kload2(bf16x8*kf,lds_cptr kp,int j){ kf[2*j]=*(const __attribute__((address_space(3))) bf16x8*)(kp+j*2048); kf[2*j+1]=*(const __attribute__((address_space(3))) bf16x8*)(kp+j*2048+512); }
__device__ __forceinline__ s16x4 vtr(lds_cptr p){ return __builtin_bit_cast(s16x4,__builtin_amdgcn_ds_read_tr16_b64_v4i16((__attribute__((address_space(3))) v4i16_t*)p)); }
__device__ __forceinline__ float rowmax(const f32x16&p0,const f32x16&p1){
  float a=max3f(p0[0],p0[1],p1[0]),b=max3f(p0[2],p0[3],p1[1]);a=max3f(a,p1[2],p1[3]);
  #pragma unroll
  for(int r=4;r<16;r+=4){a=max3f(a,p0[r],p0[r+1]);b=max3f(b,p0[r+2],p0[r+3]);a=max3f(a,p1[r],p1[r+1]);b=max3f(b,p1[r+2],p1[r+3]);}
  const float m=max2f(a,b);
  auto rr=__builtin_amdgcn_permlane32_swap(__float_as_uint(m),__float_as_uint(m),false,false);
  return max2f(__uint_as_float(rr[0]),__uint_as_float(rr[1]));
}
__device__ __forceinline__ void pv(f32x16*o,int vb,bf16x8 pa0,bf16x8 pa1,bf16x8 pa2,bf16x8 pa3){
  #pragma unroll
  for(int d0=0;d0<2;++d0){s16x4 lo[4],hi[4];
    #pragma unroll
    for(int ks=0;ks<4;++ks){
      asm volatile("ds_read_b64_tr_b16 %0,%1 offset:%c2":"=&v"(lo[ks]):"v"(vb),"i"(d0*4096+ks*1024):"memory");
      asm volatile("ds_read_b64_tr_b16 %0,%1 offset:%c2":"=&v"(hi[ks]):"v"(vb),"i"(d0*4096+ks*1024+512):"memory");}
    asm volatile("s_waitcnt lgkmcnt(0)":::"memory");SBAR();
    #define PK(k) (bf16x8){lo[k][0],lo[k][1],lo[k][2],lo[k][3],hi[k][0],hi[k][1],hi[k][2],hi[k][3]}
    o[d0]=__builtin_amdgcn_mfma_f32_32x32x16_bf16(pa0,PK(0),o[d0],0,0,0);
    o[d0]=__builtin_amdgcn_mfma_f32_32x32x16_bf16(pa1,PK(1),o[d0],0,0,0);
    o[d0]=__builtin_amdgcn_mfma_f32_32x32x16_bf16(pa2,PK(2),o[d0],0,0,0);
    o[d0]=__builtin_amdgcn_mfma_f32_32x32x16_bf16(pa3,PK(3),o[d0],0,0,0);
    #undef PK
  }
}

#ifndef ATTN_STORE16
#define ATTN_STORE16(p,v) (*(u32x4*)(p)=(v))
#endif
template<int THRL> __device__ __forceinline__ void attn_unit(int b,int h,int qb,const bf16*Q,const bf16*__restrict__ K,const bf16*__restrict__ V,bf16*O,const float*__restrict__ Fc,const unsigned*__restrict__ kmx,const unsigned*__restrict__ qmx,char*shm){
  int tid_=threadIdx.x; asm volatile("":"+v"(tid_)); const int tid=tid_,lane=tid&63,r32=lane&31,hi=lane>>5; const int wid=__builtin_amdgcn_readfirstlane(tid>>6);
  const long rowbase=(long)b*SEQ; const int q0=qb*QB;
  const bf16*Qw=Q+(rowbase+q0+wid*QBLK)*DM+h*D;
  int ts=0; const float fq0=Fc[q0];
  { const int NT0=(q0+QB)/KVBLK; const float qm=__builtin_sqrtf(__uint_as_float(qmx[qb]));
    const float kd=__builtin_sqrtf(__uint_as_float(max(max(kmx[4*qb],kmx[4*qb+1]),max(kmx[4*qb+2],kmx[4*qb+3]))));
    const float thr=-qm*kd-PRUNE_MARGIN; int first=NT0;
    for(int base=0;base<NT0-4;base+=64){ const int kt=base+lane; bool keep=false;
      if(kt<NT0-4){ const float ub=qm*__builtin_sqrtf(__uint_as_float(kmx[kt]))+(fq0-Fc[kt*64+63])*1.4426950408889634f; keep=!(ub<thr); }
      const unsigned long long mk=__ballot(keep); if(mk){ first=base+__builtin_ctzll(mk); break; } }
    ts=min(first,NT0-4)&~1; ts=__builtin_amdgcn_readfirstlane(ts); }
  const bf16*Kh=K+(rowbase+(long)ts*KVBLK)*DM+h*D,*Vh=V+(rowbase+(long)ts*KVBLK)*DM+h*D; Fc+=ts*KVBLK;
  const unsigned lds0=(unsigned)(uintptr_t)shm;
  float*wsf=(float*)(shm+LDS_WS)+wid*64;
  const bf16*ksrc=Kh+(long)lane*DM+wid*8;
  const bf16*vsrc=Vh+(long)(16*(wid&3)+(lane>>2))*DM+(wid>>2)*32+(lane&3)*8;
  const unsigned kdst=lds0+LDS_K+wid*1024, vdst=lds0+LDS_V+wid*1024;
  #define DMA_K(t,slot) glds16(ksrc+(long)(t)*KVBLK*DM,(unsigned)__builtin_amdgcn_readfirstlane(kdst+(slot)))
  #define DMA_V(t,slot) glds16(vsrc+(long)(t)*KVBLK*DM,(unsigned)__builtin_amdgcn_readfirstlane(vdst+(slot)))
  const int vb0=(int)(lds0+LDS_V)+((lane>>4)&1)*32+(lane&3)*8+(4*hi+((lane&15)>>2))*64;
  const char*Kbase=shm+LDS_K; bf16x8 kf[8];
  const lds_cptr shm3=(lds_cptr)shm; const lds_cptr kp0=shm3+LDS_K+hi*1024+r32*16; const lds_cptr vp0=shm3+LDS_V+((lane>>4)&1)*32+(lane&3)*8+(4*hi+((lane&15)>>2))*64;
  const int NT=(q0+QB)/KVBLK-ts;
  DMA_K(0,0);DMA_V(0,0);DMA_K(1,SLOTB);
  bf16x8 qr[4];
  #pragma unroll
  for(int d0=0;d0<4;++d0)qr[d0]=*reinterpret_cast<const bf16x8*>(&Qw[(long)r32*DM+d0*16+hi*8]);
  float mhat=0.f,l_reg=0.f;f32x16 o[2];o[0]=f32x16{};o[1]=f32x16{};
  const int qrel=wid*QBLK+r32;
  #define CMASK(P0,P1,t) do{int jb_=(t)-(NT-4); if(jb_>=0)cmask(P0,P1,jb_,qrel,hi);}while(0)
  bool resc=false;
  #define START(P0,P1) do{ const float rm=rowmax(P0,P1); resc=false; \
    { const float dl=rm; mhat=fadd_s(mhat,dl); \
      _Pragma("unroll") for(int r=0;r<16;++r){P0[r]=fsub_s(P0[r],dl);P1[r]=fsub_s(P1[r],dl);} \
      } \
    _Pragma("unroll") for(int r=0;r<16;++r)P0[r]=__builtin_amdgcn_exp2f(P0[r]); }while(0)
  #define RESC() do{ if(resc){ asm volatile("s_waitcnt lgkmcnt(0)":::"memory"); \
      _Pragma("unroll") for(int d_=0;d_<2;++d_) _Pragma("unroll") for(int r=0;r<16;++r)o[d_][r]*=wsf[crow(r,hi)]; } }while(0)
  f32x16 pA0,pA1,pB0,pB1;
  int sl_prev=0,sl_cur=0,sl_next=SLOTB;
  #define ROT() do{sl_prev=sl_cur;sl_cur=sl_next;sl_next=(sl_next==(NSLOT-1)*SLOTB)?0:sl_next+SLOTB;}while(0)
  DMA_K(2,2*SLOTB);
  typedef __attribute__((address_space(3))) f32x4_t* lds_f4w; typedef const __attribute__((address_space(3))) f32x4_t* lds_f4ptr;
  { const lds_f4w fbw=(lds_f4w)((__attribute__((address_space(3))) char*)shm+LDS_FB); const f32x4_t*fsrc=(const f32x4_t*)Fc;
    for(int i=tid;i<NT*16;i+=NW*64){ const f32x4_t v=fsrc[i]; fbw[i]=(fq0-v)*1.4426950408889634f; } }
  #define FBINIT(X0,X1,tt) do{ const lds_f4ptr fp_=(lds_f4ptr)(shm3+LDS_FB+((tt)*64+4*hi)*4); \
    _Pragma("unroll") for(int g_=0;g_<4;++g_){ const f32x4_t a_=fp_[2*g_],b_=fp_[2*g_+8]; \
      X0[4*g_]=a_[0]-mhat;X0[4*g_+1]=a_[1]-mhat;X0[4*g_+2]=a_[2]-mhat;X0[4*g_+3]=a_[3]-mhat; X1[4*g_]=b_[0]-mhat;X1[4*g_+1]=b_[1]-mhat;X1[4*g_+2]=b_[2]-mhat;X1[4*g_+3]=b_[3]-mhat; } }while(0)
  WAIT_BAR(3);
  FBINIT(pA0,pA1,0); qkt(pA0,pA1,Kbase,qr,r32,hi);asm volatile("s_nop 15\n\ts_nop 7":"+v"(pA0),"+v"(pA1));CMASK(pA0,pA1,0);
  START(pA0,pA1);
  _Pragma("unroll") for(int r=0;r<16;++r)pA1[r]=__builtin_amdgcn_exp2f(pA1[r]);
  WAIT_BAR(0);
  DMA_K(3,0);DMA_V(1,SLOTB);
  ROT();
  kload8(kf,kp0+sl_cur);
  FBINIT(pB0,pB1,1);
  WAIT_BAR(2);
  s16x4 vlo[8],vhi[8]; u32x4 pw0,pw1,pw2,pw3;
  #define PKW(P,B) cvtpk_s(P[B],P[B+1])
  #define PAF(k) __builtin_bit_cast(bf16x8,pw##k)
  #define VFR(i) (bf16x8){vlo[i][0],vlo[i][1],vlo[i][2],vlo[i][3],vhi[i][0],vhi[i][1],vhi[i][2],vhi[i][3]}
  #define PIN(x) asm volatile("":"+v"(x))
  #define MX3(a,b,c) __builtin_fmaxf(__builtin_fmaxf((a),(b)),(c))
  #define GAPA(MF,A0,A1,A2,A3,W0,W1,PW) do{ MF; sacc+=A0; sacc+=A1; sacc+=A2; sacc+=A3; PIN(sacc); W0; W1; PIN(PW); SBAR(); }while(0)
  #define EX(v) __builtin_amdgcn_exp2f(v)
  #define GAPB(MF,X,B,BI) do{ MF; X[B]=EX(X[B]); X[B+1]=EX(X[B+1]); X[B+2]=EX(X[B+2]); X[B+3]=EX(X[B+3]); PIN(X); BI; SBAR(); }while(0)
  #define BINIT(PX,G,bv) do{ PX[4*(G)]=bv[0]-mhat; PX[4*(G)+1]=bv[1]-mhat; PX[4*(G)+2]=bv[2]-mhat; PX[4*(G)+3]=bv[3]-mhat; PIN(PX); }while(0)
  #define VRD(i) do{ vlo[i]=vtr(vp_+(((i)>>2)*4096+((i)&3)*1024)); vhi[i]=vtr(vp_+(((i)>>2)*4096+((i)&3)*1024+512)); }while(0)
  #define KRD(G,j) do{ if(G){ kload2(kf,kp0+sl_next,j); SBAR(); } }while(0)
  #define STEP(C0,C1,P0,P1,t,GK,GV,GL) do{ SBAR(); \
    const lds_cptr vp_=vp0+sl_prev; \
    VRD(0); SBAR(); float sacc=(P0[0]+P0[1]); \
    GAPA(C0=__builtin_amdgcn_mfma_f32_32x32x16_bf16(kf[0],qr[0],C0,0,0,0), P0[2],P0[3],P0[4],P0[5],     pw0[0]=PKW(P0,0), pw0[1]=PKW(P0,2), pw0); \
    VRD(4); SBAR(); GAPA(C1=__builtin_amdgcn_mfma_f32_32x32x16_bf16(kf[1],qr[0],C1,0,0,0), P0[6],P0[7],P0[8],P0[9],     pw0[2]=PKW(P0,4), pw0[3]=PKW(P0,6), pw0); \
    VRD(1); SBAR(); GAPA(C0=__builtin_amdgcn_mfma_f32_32x32x16_bf16(kf[2],qr[1],C0,0,0,0),   P0[10],P0[11],P0[12],P0[13], pw1[0]=PKW(P0,8), pw1[1]=PKW(P0,10), pw1); \
    VRD(5); SBAR(); GAPA(C1=__builtin_amdgcn_mfma_f32_32x32x16_bf16(kf[3],qr[1],C1,0,0,0),   P0[14],P0[15],P1[0],P1[1],   pw1[2]=PKW(P0,12),pw1[3]=PKW(P0,14), pw1); \
    VRD(2); SBAR(); GAPA(C0=__builtin_amdgcn_mfma_f32_32x32x16_bf16(kf[4],qr[2],C0,0,0,0),   P1[2],P1[3],P1[4],P1[5],     pw2[0]=PKW(P1,0), pw2[1]=PKW(P1,2), pw2); \
    VRD(6); SBAR(); GAPA(C1=__builtin_amdgcn_mfma_f32_32x32x16_bf16(kf[5],qr[2],C1,0,0,0),   P1[6],P1[7],P1[8],P1[9],     pw2[2]=PKW(P1,4), pw2[3]=PKW(P1,6), pw2); \
    VRD(3); SBAR(); GAPA(C0=__builtin_amdgcn_mfma_f32_32x32x16_bf16(kf[6],qr[3],C0,0,0,0),   P1[10],P1[11],P1[12],P1[13], pw3[0]=PKW(P1,8), pw3[1]=PKW(P1,10), pw3); \
    VRD(7); SBAR(); GAPA(C1=__builtin_amdgcn_mfma_f32_32x32x16_bf16(kf[7],qr[3],C1,0,0,0),   P1[14],P1[15],0.f,0.f,       pw3[2]=PKW(P1,12),pw3[3]=PKW(P1,14), pw3); \
    l_reg+=sacc; \
    if(GK){DMA_K((t)+3,sl_cur);} if(GV){DMA_V((t)+1,sl_next);} \
    CMASK(C0,C1,t); \
    const lds_f4ptr fbp_=(lds_f4ptr)(shm3+LDS_FB+(((t)+1)*64+4*hi)*4); f32x4_t bvA=fbp_[0]; \
    { float a=MX3(C0[0],C0[1],C1[0]),b=MX3(C0[2],C0[3],C1[1]); a=MX3(a,C1[2],C1[3]); \
      _Pragma("unroll") for(int r=4;r<16;r+=4){a=MX3(a,C0[r],C0[r+1]);b=MX3(b,C0[r+2],C0[r+3]);a=MX3(a,C1[r],C1[r+1]);b=MX3(b,C1[r+2],C1[r+3]);} \
      float rm=__builtin_fmaxf(a,b); { auto rr=__builtin_amdgcn_permlane32_swap(__float_as_uint(rm),__float_as_uint(rm),false,false); rm=__builtin_fmaxf(__uint_as_float(rr[0]),__uint_as_float(rr[1])); } \
      resc=false; \
      if(__builtin_expect(__any(rm>(float)THRL),0)){ const float dl=__builtin_fmaxf(rm,0.f); mhat+=dl; \
        _Pragma("unroll") for(int r=0;r<16;++r){C0[r]-=dl;C1[r]-=dl;} \
        const float f=__builtin_amdgcn_exp2f(-dl); l_reg*=f; if(hi==0)wsf[r32]=f; resc=true; } } \
    SBAR(); \
    GAPB(o[0]=__builtin_amdgcn_mfma_f32_32x32x16_bf16(PAF(0),VFR(0),o[0],0,0,0), C0,0,do{BINIT(P0,0,bvA); bvA=fbp_[2];}while(0)); \
    GAPB(o[1]=__builtin_amdgcn_mfma_f32_32x32x16_bf16(PAF(0),VFR(4),o[1],0,0,0), C0,4,do{BINIT(P0,1,bvA); bvA=fbp_[4];}while(0)); \
    KRD(GL,0); GAPB(o[0]=__builtin_amdgcn_mfma_f32_32x32x16_bf16(PAF(1),VFR(1),o[0],0,0,0), C0,8,do{BINIT(P0,2,bvA); bvA=fbp_[6];}while(0)); \
    KRD(GL,1); GAPB(o[1]=__builtin_amdgcn_mfma_f32_32x32x16_bf16(PAF(1),VFR(5),o[1],0,0,0), C0,12,do{BINIT(P0,3,bvA); bvA=fbp_[8];}while(0)); \
    KRD(GL,2); GAPB(o[0]=__builtin_amdgcn_mfma_f32_32x32x16_bf16(PAF(2),VFR(2),o[0],0,0,0), C1,0,do{BINIT(P1,0,bvA); bvA=fbp_[10];}while(0)); \
    KRD(GL,3); GAPB(o[1]=__builtin_amdgcn_mfma_f32_32x32x16_bf16(PAF(2),VFR(6),o[1],0,0,0), C1,4,do{BINIT(P1,1,bvA); bvA=fbp_[12];}while(0)); \
    GAPB(o[0]=__builtin_amdgcn_mfma_f32_32x32x16_bf16(PAF(3),VFR(3),o[0],0,0,0), C1,8,do{BINIT(P1,2,bvA); bvA=fbp_[14];}while(0)); \
    GAPB(o[1]=__builtin_amdgcn_mfma_f32_32x32x16_bf16(PAF(3),VFR(7),o[1],0,0,0), C1,12,do{BINIT(P1,3,bvA);}while(0)); \
    }while(0)
  int t=1;
  #undef CMASK
  #define CMASK(P0,P1,t) do{}while(0)
  for(;t+5<NT;t+=2){
    STEP(pB0,pB1,pA0,pA1,t,true,true,true);     WAIT_BAR(2); RESC(); ROT();
    STEP(pA0,pA1,pB0,pB1,t+1,true,true,true);   WAIT_BAR(2); RESC(); ROT();
  }
  #undef CMASK
  #define CMASK(P0,P1,t) do{int jb_=(t)-(NT-4); if(jb_>=0)cmask(P0,P1,jb_,qrel,hi);}while(0)
  #define ENDW(tt) do{ if((tt)+3<NT){WAIT_BAR(2);} else if((tt)+2<NT){WAIT_BAR(1);} else {WAIT_BAR(0);} }while(0)
  for(;t+1<NT;t+=2){
    STEP(pB0,pB1,pA0,pA1,t,(t+3<NT),(t+1<NT),(t+1<NT));       ENDW(t);   RESC(); ROT();
    STEP(pA0,pA1,pB0,pB1,t+1,(t+4<NT),(t+2<NT),(t+2<NT));     ENDW(t+1); RESC(); ROT();
  }
  STEP(pB0,pB1,pA0,pA1,NT-1,false,false,false); RESC();
  { float sacc=pB0[0]+pB0[1]; _Pragma("unroll") for(int r=2;r<16;++r)sacc+=pB0[r]; _Pragma("unroll") for(int r=0;r<16;++r)sacc+=pB1[r]; l_reg+=sacc;
    pw0=(u32x4){PKW(pB0,0),PKW(pB0,2),PKW(pB0,4),PKW(pB0,6)};pw1=(u32x4){PKW(pB0,8),PKW(pB0,10),PKW(pB0,12),PKW(pB0,14)};pw2=(u32x4){PKW(pB1,0),PKW(pB1,2),PKW(pB1,4),PKW(pB1,6)};pw3=(u32x4){PKW(pB1,8),PKW(pB1,10),PKW(pB1,12),PKW(pB1,14)};
    SBAR(); pv(o,vb0+sl_cur,PAF(0),PAF(1),PAF(2),PAF(3)); }
  #undef PKW
  #undef PAF
  #undef VFR
  #undef PIN
  #undef MX3
  #undef GAPA
  #undef GAPB
  #undef BINIT
  #undef FBINIT
  #undef EX
  #undef VRD
  #undef KRD
  #undef STEP
  #undef ENDW
  {auto rr=__builtin_amdgcn_permlane32_swap(__float_as_uint(l_reg),__float_as_uint(l_reg),false,false);l_reg=__uint_as_float(rr[0])+__uint_as_float(rr[1]);}
  if(hi==0)wsf[32+r32]=l_reg;asm volatile("s_waitcnt lgkmcnt(0)":::"memory");
  float rli[16];
  #pragma unroll
  for(int r=0;r<16;++r)rli[r]=__builtin_amdgcn_rcpf(wsf[32+crow(r,hi)]);
  bf16*Ow=O+(rowbase+q0+wid*QBLK)*DM+h*D;
  { bf16*stg=(bf16*)(shm+LDS_OST)+wid*2048;
    #pragma unroll
    for(int r=0;r<16;++r){const int orow=crow(r,hi);
      #pragma unroll
      for(int d0=0;d0<2;++d0)stg[orow*64+d0*32+r32]=__float2bfloat16(o[d0][r]*rli[r]);}
    asm volatile("s_waitcnt lgkmcnt(0)":::"memory");
    #pragma unroll
    for(int i=0;i<4;++i){const int row=i*8+(lane>>3),ch=lane&7; const u32x4 v=*(const u32x4*)(stg+row*64+ch*8); ATTN_STORE16(Ow+(long)row*DM+ch*8,v);} }
  asm volatile("s_waitcnt lgkmcnt(0)\n\ts_barrier":::"memory");
  #undef DMA_K
  #undef DMA_V
  #undef CMASK
  #undef START
  #undef RESC
  #undef ROT
}
constexpr int ATTN_LDS_BYTES=LDS_BYTES;
struct AttnTensors { const bf16* Q; const bf16* K; const bf16* V; bf16* O; const float* F; const unsigned* KMAX; const unsigned* QMAX; };
struct AttnUnit { int bh; int qb; };
struct StaticOrder {
  int vcu;
  __device__ __forceinline__ explicit StaticOrder(int grid,int block):vcu((block%8)*(grid/8)+block/8){}
  __device__ __forceinline__ bool next(int i,AttnUnit&u)const{ if(i>=4)return false; const int s=vcu&7; u.bh=vcu>>3; u.qb=(i==0)?s:(i==1)?15-s:(i==2)?16+s:31-s; return true; }
  __device__ __forceinline__ void a_ready(const AttnUnit&)const{}
  __device__ __forceinline__ void done(const AttnUnit&)const{}
};
template<class Sched,int THRL=8> __device__ __forceinline__ void attn_phase(char*lds,const AttnTensors&T,const Sched&S){
  AttnUnit u;
  for(int i=0;S.next(i,u);++i){ S.a_ready(u); attn_unit<THRL>(u.bh/NHEAD,u.bh%NHEAD,u.qb,T.Q,T.K,T.V,T.O,T.F+(size_t)u.bh*SEQ,T.KMAX+u.bh*128,T.QMAX+u.bh*32,lds); S.done(u); }
}
#undef SBAR
#undef WAIT_BAR
}

#define LAS __attribute__((address_space(3)))
#define XB_TMO      128
#define XB_XCNT(j)  (256  + 64 * (j))
#define XB_XSUB(j)  (1280 + 64 * (j))
#define XB_XGEN(j)  (2304 + 64 * (j))
#define XB_TOP      3328
#define XB_TOPGEN   3392
#define XCD_BAR_WORDS 3456
#define XB_SPIN_CAP (1u << 18)

__device__ __forceinline__ unsigned xb_ld(unsigned* p)              { return __hip_atomic_load(p, __ATOMIC_RELAXED, __HIP_MEMORY_SCOPE_AGENT); }
__device__ __forceinline__ unsigned xb_add(unsigned* p, unsigned v) { return __hip_atomic_fetch_add(p, v, __ATOMIC_RELAXED, __HIP_MEMORY_SCOPE_AGENT); }
__device__ __forceinline__ unsigned xb_xcc_id() { return (unsigned)__builtin_amdgcn_s_getreg((3 << 11) | 20) & 0xFu; }
#define XB_SPIN(cond, bar) do { unsigned _sp = 0; while (cond) { __builtin_amdgcn_s_sleep(1); \
    if ((++_sp & 255u) == 0u) { if (xb_ld(&(bar)[XB_TMO])) break; if (_sp > XB_SPIN_CAP) { atomicAdd(&(bar)[XB_TMO], 1u); break; } } } } while (0)

struct XcdBarrier {
    unsigned* bar; unsigned x;
    volatile LAS unsigned* st;
};

__device__ __forceinline__ XcdBarrier xcd_barrier_post(unsigned* bar, volatile LAS unsigned* st) {
    XcdBarrier b; b.bar = bar; b.x = xb_xcc_id(); b.st = st;
    if (threadIdx.x == 0) (void)xb_add(&bar[XB_XCNT(b.x)], 1u);
    return b;
}
__device__ __forceinline__ void xcd_barrier_complete(unsigned* bar, unsigned x, unsigned& nloc, unsigned& nx) {
    const unsigned G = gridDim.x * gridDim.y * gridDim.z;
    unsigned sum, cnt, mine, sp = 0u;
    for (;;) {
        sum = 0u; cnt = 0u; mine = 0u;
#pragma unroll
        for (unsigned j = 0; j < 16; ++j) { const unsigned c = xb_ld(&bar[XB_XCNT(j)]); sum += c; cnt += (c > 0u) ? 1u : 0u; mine = (j == x) ? c : mine; }
        if (sum == G) break;
        __builtin_amdgcn_s_sleep(1);
        if ((++sp & 255u) == 0u) { if (xb_ld(&bar[XB_TMO])) break; if (sp > XB_SPIN_CAP) { atomicAdd(&bar[XB_TMO], 1u); break; } }
    }
    nloc = mine > 0u ? mine : 1u; nx = cnt > 0u ? cnt : 1u;
}

__device__ __forceinline__ void xcd_barrier(const XcdBarrier& b) {
    asm volatile("s_waitcnt vmcnt(0)" ::: "memory");
    __syncthreads();
    if (threadIdx.x == 0) {
        unsigned* bar = b.bar;
        __builtin_amdgcn_s_waitcnt(0);
        unsigned nloc = b.st[0], nx = b.st[1];
        if (nloc == 0u) { xcd_barrier_complete(bar, b.x, nloc, nx); b.st[0] = nloc; b.st[1] = nx; }
        const unsigned old = xb_add(&bar[XB_XSUB(b.x)], 1u);
        const unsigned gen = old / nloc;
        if (old + 1u == (gen + 1u) * nloc) {
            __builtin_amdgcn_fence(__ATOMIC_RELEASE, "agent");
            asm volatile("s_waitcnt vmcnt(0)" ::: "memory");
            const unsigned og = xb_add(&bar[XB_TOP], 1u);
            const unsigned tg = og / nx;
            if (og + 1u == (tg + 1u) * nx) xb_add(&bar[XB_TOPGEN], 1u);
            else XB_SPIN(xb_ld(&bar[XB_TOPGEN]) == tg, bar);
            __builtin_amdgcn_fence(__ATOMIC_ACQUIRE, "agent");
            xb_add(&bar[XB_XGEN(b.x)], 1u);
            asm volatile("s_waitcnt vmcnt(0)" ::: "memory");
        } else {
            XB_SPIN(xb_ld(&bar[XB_XGEN(b.x)]) == gen, bar);
            __builtin_amdgcn_fence(__ATOMIC_ACQUIRE, "agent");
            asm volatile("s_waitcnt vmcnt(0)" ::: "memory");
        }
    }
    __syncthreads();
}

__global__ void __launch_bounds__(512, 2) mega_fwd(Params p) {
    extern __shared__ __attribute__((aligned(16))) unsigned char lds[];
    cg::grid_group grid = cg::this_grid();
    unsigned char* ws = p.ws;
    volatile LAS unsigned* misc = (volatile LAS unsigned*)((LAS unsigned char*)lds + MISC_OFF);
    if (threadIdx.x < 16) misc[threadIdx.x] = 0u;
    __syncthreads();
    const XcdBarrier xbar = xcd_barrier_post((unsigned*)(ws + WS_CTL) + 1024, misc);
#define SEAM() xcd_barrier(xbar)
    bf16_t* XN = (bf16_t*)(ws + WS_XN); bf16_t* HB = (bf16_t*)(ws + WS_H);
    ph_prologue(p, lds); grid.sync();
    ph_mods_xn1(p, lds); SEAM();
    { pg8::EpiSwiglu E{HB, DFF}; run_gemm<pg8::EpiSwiglu, true>(lds, XN, (const bf16_t*)(ws + WS_WGU), M, 2 * DFF, D, E); } SEAM();
    { pg8::EpiF32 E{(float*)(ws + WS_Y)}; run_gemm<pg8::EpiF32, false>(lds, HB, (const bf16_t*)(ws + WS_WDN), M, D, DFF, E); } SEAM();
    ph_norm_res(p, (const float*)(ws + WS_Y), p.in[I_X], p.out, true, 0, 0.5f); SEAM();
    { pg8::EpiSeg E{ws, 0}; run_gemm<pg8::EpiSeg, true>(lds, XN, (const bf16_t*)(ws + WS_WIN1), M, 5120, D, E); }
    ph_thin_cols(p); SEAM();
    ph_fcum(p, lds);
    ph_qk_norms(p);
#if GLA_MFMA
    for (int u = blockIdx.x; u < 256; u += gridDim.x) gla_passA(p, lds, u);
#else
    for (int u = blockIdx.x; u < 256; u += gridDim.x) gla_rec<false>(p, lds, u);
#endif
    SEAM();
    ph_gla_scan(p); SEAM();
#if GLA_MFMA
    for (int u = blockIdx.x; u < 256; u += gridDim.x) gla_passC(p, lds, u);
#else
    for (int u = blockIdx.x; u < 256; u += gridDim.x) gla_rec<true>(p, lds, u);
#endif
    __syncthreads();
    { const attn_body::AttnTensors AT{(const attn_body::bf16*)(ws + WS_QB), (const attn_body::bf16*)(ws + WS_KB), (const attn_body::bf16*)(ws + WS_VB), (attn_body::bf16*)(ws + WS_QB), (const float*)(ws + WS_FCUM), (const unsigned*)(ws + WS_KMAX), (const unsigned*)(ws + WS_QMAX)};
      const attn_body::StaticOrder S((int)gridDim.x, (int)blockIdx.x); attn_body::attn_phase<attn_body::StaticOrder>((char*)lds, AT, S); }
    SEAM();
    { pg8::EpiSeg E{ws, 1 + GLA_MFMA}; run_gemm<pg8::EpiSeg, true>(lds, XN, (const bf16_t*)(ws + WS_WIN2), M, 3072, D, E); }
    __syncthreads();
    convert_ffn_weights(p, lds, p.in[I_WGU2], p.in[I_WDN2]); SEAM();
#if !GLA_MFMA
    ph_oa_norm(p); SEAM();
#endif
    { pg8::EpiGate<0> E{(bf16_t*)(ws + WS_GA), nullptr}; run_gemm<pg8::EpiGate<0>, false>(lds, (const bf16_t*)(ws + WS_VA), (const bf16_t*)(ws + WS_WPA), M, D, D, E); }
    { pg8::EpiGate<1> E{(bf16_t*)(ws + WS_GB), (const bf16_t*)(ws + WS_GA)}; run_gemm<pg8::EpiGate<1>, false>(lds, (const bf16_t*)(ws + WS_QB), (const bf16_t*)(ws + WS_WPB), M, D, D, E); } SEAM();
    { pg8::EpiF32 E{(float*)(ws + WS_Y2)}; run_gemm<pg8::EpiF32, false>(lds, (const bf16_t*)(ws + WS_GB), (const bf16_t*)(ws + WS_WOUT), M, D, D, E); } SEAM();
    ph_norm_res(p, (const float*)(ws + WS_Y2), p.out, p.out, true, 1, 1.0f); SEAM();
    { pg8::EpiSwiglu E{HB, DFF}; run_gemm<pg8::EpiSwiglu, true>(lds, XN, (const bf16_t*)(ws + WS_WGU), M, 2 * DFF, D, E); } SEAM();
    { pg8::EpiF32 E{(float*)(ws + WS_Y)}; run_gemm<pg8::EpiF32, false>(lds, HB, (const bf16_t*)(ws + WS_WDN), M, D, DFF, E); } SEAM();
    ph_norm_res(p, (const float*)(ws + WS_Y), p.out, p.out, false, 2, 0.5f);
}

extern "C" void kernel_launch(void* const* d_in, const int* in_sizes, int n_in, void* d_out, int out_size, void* d_ws, size_t ws_size, hipStream_t stream) {
    static int grid = 0;
    if (grid == 0) {
        int dev = 0, cus = 0, per_cu = 0;
        hipGetDevice(&dev); hipDeviceGetAttribute(&cus, hipDeviceAttributeMultiprocessorCount, dev);
        if (hipFuncSetAttribute((const void*)mega_fwd, hipFuncAttributeMaxDynamicSharedMemorySize, LDS_BYTES) != hipSuccess) { fprintf(stderr, "hipFuncSetAttribute failed\n"); }
        if (hipOccupancyMaxActiveBlocksPerMultiprocessor(&per_cu, (const void*)mega_fwd, 512, LDS_BYTES) != hipSuccess || per_cu < 1) { fprintf(stderr, "occupancy query: %d\n", per_cu); per_cu = 1; }
        (void)hipGetLastError();
        grid = cus * per_cu;
        if (n_in != 18 || ws_size < 256 * MiB) fprintf(stderr, "unexpected n_in %d / ws %zu\n", n_in, ws_size);
    }
    Params p{};
    for (int i = 0; i < 18; ++i) p.in[i] = (const float*)d_in[i];
    p.out = (float*)d_out; p.ws = (unsigned char*)d_ws;
    (void)hipMemsetAsync((char*)d_ws + WS_CTL, 0, 65536, stream);
    void* args[] = {&p};
    hipError_t e = hipLaunchCooperativeKernel((const void*)mega_fwd, dim3(grid), dim3(512), args, LDS_BYTES, stream);
    if (e != hipSuccess) fprintf(stderr, "cooperative launch failed: %s (grid %d)\n", hipGetErrorString(e), grid);
}
```

```cpp
#include <hip/hip_runtime.h>
#include <hip/hip_cooperative_groups.h>
#include <cstdio>
#include <cstdint>
namespace cg = cooperative_groups;

#define DEVI __device__ __forceinline__
typedef unsigned short bf16_t;
typedef float f32x4 __attribute__((ext_vector_type(4)));
typedef unsigned u32x4 __attribute__((ext_vector_type(4)));
typedef unsigned u32x2 __attribute__((ext_vector_type(2)));

constexpr int BATCH = 2, T = 8192, D = 1024, M = BATCH * T, DFF = 2816, NMODS = 9 * D, INC = 8224;
constexpr float EPS = 1e-6f, LOG2E = 1.4426950408889634f;
constexpr float C2 = 0.125f * LOG2E;
constexpr float QA_SCALE = 0.08838834764831845f;

constexpr size_t MiB = 1u << 20;
constexpr size_t WS_CTL = 0;
constexpr size_t WS_WIN1 = 1 * MiB;
constexpr size_t WS_WIN2 = 11 * MiB;
constexpr size_t WS_WPA = 17 * MiB, WS_WPB = 19 * MiB, WS_WOUT = 21 * MiB;
constexpr size_t WS_MODS = 23 * MiB;
constexpr size_t WS_MODP = 23 * MiB + 128 * 1024;
constexpr size_t WS_DEC = 23 * MiB + 768 * 1024;
constexpr size_t WS_KMAX = 23 * MiB + 896 * 1024;
constexpr size_t WS_QMAX = 23 * MiB + 912 * 1024;
constexpr size_t WS_ALOW = 24 * MiB;
constexpr size_t WS_LOGF = 25 * MiB;
constexpr size_t WS_FCUM = 26 * MiB;
constexpr size_t WS_XN = 27 * MiB;
constexpr size_t WS_QA = 59 * MiB, WS_KA = 75 * MiB, WS_VA = 91 * MiB, WS_QB = 123 * MiB, WS_KB = 155 * MiB, WS_VB = 187 * MiB;
constexpr size_t WS_RA = 59 * MiB, WS_GA = 155 * MiB, WS_GB = 187 * MiB;
constexpr size_t WS_H = 59 * MiB;
constexpr size_t WS_Y = 147 * MiB;
constexpr size_t WS_Y2 = 59 * MiB;
constexpr size_t WS_WGU = 219 * MiB;
constexpr size_t WS_WDN = 230 * MiB;
constexpr size_t WS_U = 219 * MiB;
constexpr int LDS_BYTES = 147456, MISC_OFF = 147392;
#ifndef GLA_MFMA
#define GLA_MFMA 1
#endif

struct Params { const float* in[18]; float* out; unsigned char* ws; };
enum { I_X = 0, I_C, I_WADA, I_BADA, I_GPRE, I_GPOST, I_WGU1, I_WDN1, I_WGU2, I_WDN2, I_WIN, I_WA2, I_BA, I_BF, I_GGLA, I_WPA, I_WPB, I_WOUT };

DEVI float bf2f(bf16_t v) { return __uint_as_float((unsigned)v << 16); }
DEVI unsigned f2bf(float f) { unsigned u = __float_as_uint(f); return (u + 0x7fffu + ((u >> 16) & 1u)) >> 16; }
DEVI unsigned pk2(float lo, float hi) { return f2bf(lo) | (f2bf(hi) << 16); }
DEVI float wave_sum(float v) {
#pragma unroll
    for (int o = 1; o < 64; o <<= 1) v += __shfl_xor(v, o);
    return v;
}
DEVI float sigmoid_f(float x) { return 1.f / (1.f + __expf(-x)); }
DEVI float silu_f(float x) { return x / (1.f + __expf(-x)); }
DEVI float logsigmoid_f(float x) { return fminf(x, 0.f) - log1pf(__expf(-fabsf(x))); }
DEVI void unpack8(const u32x4 v, float* f) {
    f[0] = __uint_as_float(v.x << 16); f[1] = __uint_as_float(v.x & 0xffff0000u);
    f[2] = __uint_as_float(v.y << 16); f[3] = __uint_as_float(v.y & 0xffff0000u);
    f[4] = __uint_as_float(v.z << 16); f[5] = __uint_as_float(v.z & 0xffff0000u);
    f[6] = __uint_as_float(v.w << 16); f[7] = __uint_as_float(v.w & 0xffff0000u);
}

DEVI void transpose_item(const float* W, int K, int N, int k0, int srcn0, bf16_t* WT, int dstrow0, float* scr, int lane) {
#pragma unroll 8
    for (int i = 0; i < 32; ++i) { const int kk = 2 * i + (lane >> 5); scr[kk * 33 + (lane & 31)] = W[(size_t)(k0 + kk) * N + srcn0 + (lane & 31)]; }
    __builtin_amdgcn_s_waitcnt(0); __builtin_amdgcn_wave_barrier();
    const int c = lane & 7;
#pragma unroll
    for (int j = 0; j < 4; ++j) { const int n = (lane >> 3) + 8 * j; const float* s = scr + (8 * c) * 33 + n;
        u32x4 o; o.x = pk2(s[0 * 33], s[1 * 33]); o.y = pk2(s[2 * 33], s[3 * 33]); o.z = pk2(s[4 * 33], s[5 * 33]); o.w = pk2(s[6 * 33], s[7 * 33]);
        *(u32x4*)(WT + (size_t)(dstrow0 + n) * K + k0 + 8 * c) = o; }
    __builtin_amdgcn_s_waitcnt(0); __builtin_amdgcn_wave_barrier();
}
DEVI int src_win1(int r) { return r < 2048 ? r : r + 1040; }
DEVI int src_win2(int r) { return r < 1024 ? r + 2064 : r + 5152; }
DEVI int src_gu(int r) { const int t = r >> 8, w = r & 255; return w < 128 ? 128 * t + w : DFF + 128 * t + (w - 128); }

DEVI void convert_ffn_weights(const Params& p, unsigned char* lds, const float* wgu, const float* wdn) {
    const int lane = threadIdx.x & 63, wave = threadIdx.x >> 6;
    float* scr = (float*)(lds + wave * 16384);
    const int gw = blockIdx.x * 8 + wave, NGW = gridDim.x * 8;
    bf16_t* WGU = (bf16_t*)(p.ws + WS_WGU); bf16_t* WDN = (bf16_t*)(p.ws + WS_WDN);
    constexpr int I_GU = 16 * 176, I_DN = 44 * 32;
    for (int it = gw; it < I_GU + I_DN; it += NGW) {
        if (it < I_GU) { const int kb = it / 176, nb = it % 176; transpose_item(wgu, D, 2 * DFF, 64 * kb, src_gu(32 * nb), WGU, 32 * nb, scr, lane); }
        else { const int r = it - I_GU, kb = r / 32, nb = r % 32; transpose_item(wdn, DFF, D, 64 * kb, 32 * nb, WDN, 32 * nb, scr, lane); }
    }
}

DEVI void ph_prologue(const Params& p, unsigned char* lds) {
    const int tid = threadIdx.x, lane = tid & 63, wave = tid >> 6;
    float* sc = (float*)lds;
    for (int v = tid; v < 2 * D; v += 512) sc[v] = silu_f(p.in[I_C][v]);
    __syncthreads();
    {
        const int g = blockIdx.x * 512 + tid;
        if (g < 8 * NMODS) {
            const int ks = g / NMODS, j = g % NMODS; const float* w = p.in[I_WADA] + (size_t)(ks * 128) * NMODS + j;
            float s0 = 0.f, s1 = 0.f;
#pragma unroll 8
            for (int i = 0; i < 128; ++i) { const float wv = w[(size_t)i * NMODS]; s0 += sc[ks * 128 + i] * wv; s1 += sc[D + ks * 128 + i] * wv; }
            float* mp = (float*)(p.ws + WS_MODP);
            mp[(ks * 2 + 0) * NMODS + j] = s0; mp[(ks * 2 + 1) * NMODS + j] = s1;
        }
    }
    __syncthreads();
    for (int v = blockIdx.x * 512 + tid; v < 32 * 128 + 32 * 32; v += gridDim.x * 512) ((unsigned*)(p.ws + WS_KMAX))[v] = 0u;
    for (int v = blockIdx.x * 512 + tid; v < 32 * D; v += gridDim.x * 512) { const int kk = v >> 5, n = v & 31;
        ((bf16_t*)(p.ws + (23 * MiB + 920 * 1024)))[n * D + kk] = (bf16_t)f2bf(p.in[I_WIN][(size_t)kk * INC + (n < 16 ? 2048 + n : 6160 + (n - 16))]); }
    float* scr = (float*)(lds + wave * 16384);
    const int gw = blockIdx.x * 8 + wave, NGW = gridDim.x * 8;
    constexpr int I_W1 = 16 * 160, I_W2 = 16 * 96, I_P = 16 * 32;
    const float* win = p.in[I_WIN];
    for (int it = gw; it < I_W1 + I_W2 + 3 * I_P; it += NGW) {
        int r = it;
        if (r < I_W1) { const int kb = r / 160, nb = r % 160; transpose_item(win, D, INC, 64 * kb, src_win1(32 * nb), (bf16_t*)(p.ws + WS_WIN1), 32 * nb, scr, lane); continue; } r -= I_W1;
        if (r < I_W2) { const int kb = r / 96, nb = r % 96; transpose_item(win, D, INC, 64 * kb, src_win2(32 * nb), (bf16_t*)(p.ws + WS_WIN2), 32 * nb, scr, lane); continue; } r -= I_W2;
        const int w = r / I_P, q = r % I_P, kb = q / 32, nb = q % 32;
        const float* src = p.in[w == 0 ? I_WPA : (w == 1 ? I_WPB : I_WOUT)]; bf16_t* dst = (bf16_t*)(p.ws + (w == 0 ? WS_WPA : (w == 1 ? WS_WPB : WS_WOUT)));
        transpose_item(src, D, D, 64 * kb, 32 * nb, dst, 32 * nb, scr, lane);
    }
    convert_ffn_weights(p, lds, p.in[I_WGU1], p.in[I_WDN1]);
}

DEVI void ph_mods_xn1(const Params& p, unsigned char* lds) {
    const int tid = threadIdx.x, lane = tid & 63, wave = tid >> 6;
    const float* mp = (const float*)(p.ws + WS_MODP); float* mods = (float*)(p.ws + WS_MODS); const float* bada = p.in[I_BADA];
    for (int v = blockIdx.x * 512 + tid; v < 2 * NMODS; v += gridDim.x * 512) { const int b = v / NMODS, j = v % NMODS; float s = bada[j];
#pragma unroll
        for (int ks = 0; ks < 8; ++ks) s += mp[(ks * 2 + b) * NMODS + j];
        mods[v] = s; }
    float* lm = (float*)lds;
    for (int v = tid; v < 4096; v += 512) { const int b = v >> 11, j = v & 2047; float s = bada[j];
#pragma unroll
        for (int ks = 0; ks < 8; ++ks) s += mp[(ks * 2 + b) * NMODS + j];
        lm[v] = s; }
    __syncthreads();
    const int gw = blockIdx.x * 8 + wave, NGW = gridDim.x * 8;
    const float* gpre = p.in[I_GPRE]; bf16_t* XN = (bf16_t*)(p.ws + WS_XN);
    for (int m = gw; m < M; m += NGW) {
        const int b = m >> 13; const f32x4* xr = (const f32x4*)(p.in[I_X] + (size_t)m * D) + lane;
        f32x4 v[4]; float ss = 0.f;
#pragma unroll
        for (int j = 0; j < 4; ++j) { v[j] = xr[64 * j]; ss += (v[j].x * v[j].x + v[j].y * v[j].y) + (v[j].z * v[j].z + v[j].w * v[j].w); }
        const float rstd = rsqrtf(wave_sum(ss) * (1.f / D) + EPS);
        u32x2* o8 = (u32x2*)(XN + (size_t)m * D) + lane;
#pragma unroll
        for (int j = 0; j < 4; ++j) { const int col = 4 * lane + 256 * j; const f32x4 g = *(const f32x4*)(gpre + col);
            const f32x4 sh = *(const f32x4*)(lm + b * 2048 + col), s1 = *(const f32x4*)(lm + b * 2048 + 1024 + col);
            const f32x4 h = v[j] * rstd * g * (1.f + s1) + sh; u32x2 w; w.x = pk2(h.x, h.y); w.y = pk2(h.z, h.w); o8[64 * j] = w; }
    }
}

DEVI void ph_norm_res(const Params& p, const float* Y, const float* xin, float* xout, bool mk_xn, int sub  , float gs) {
    const int tid = threadIdx.x, lane = tid & 63, wave = tid >> 6;
    const int gw = blockIdx.x * 8 + wave, NGW = gridDim.x * 8;
    const float* mods = (const float*)(p.ws + WS_MODS); const float* gpost = p.in[I_GPOST] + sub * D; const float* gpre = p.in[I_GPRE] + (sub + 1) * D;
    bf16_t* XN = (bf16_t*)(p.ws + WS_XN);
    for (int m = gw; m < M; m += NGW) {
        const int b = m >> 13; const float* mb = mods + b * NMODS;
        const f32x4* yr = (const f32x4*)(Y + (size_t)m * D) + lane; const f32x4* xr = (const f32x4*)(xin + (size_t)m * D) + lane; f32x4* xo = (f32x4*)(xout + (size_t)m * D) + lane;
        f32x4 y[4]; float ss = 0.f;
#pragma unroll
        for (int j = 0; j < 4; ++j) { y[j] = yr[64 * j]; ss += (y[j].x * y[j].x + y[j].y * y[j].y) + (y[j].z * y[j].z + y[j].w * y[j].w); }
        const float rstd = rsqrtf(wave_sum(ss) * (1.f / D) + EPS); float s2 = 0.f;
#pragma unroll
        for (int j = 0; j < 4; ++j) { const int col = 4 * lane + 256 * j; const f32x4 g = *(const f32x4*)(gpost + col), gt = *(const f32x4*)(mb + (3 * sub + 2) * D + col);
            const f32x4 xn = xr[64 * j] + gs * gt * (y[j] * rstd * g); xo[64 * j] = xn; y[j] = xn; s2 += (xn.x * xn.x + xn.y * xn.y) + (xn.z * xn.z + xn.w * xn.w); }
        if (mk_xn) {
            const float r2 = rsqrtf(wave_sum(s2) * (1.f / D) + EPS); u32x2* o8 = (u32x2*)(XN + (size_t)m * D) + lane;
#pragma unroll
            for (int j = 0; j < 4; ++j) { const int col = 4 * lane + 256 * j; const f32x4 g = *(const f32x4*)(gpre + col);
                const f32x4 sh = *(const f32x4*)(mb + (3 * sub + 3) * D + col), s1 = *(const f32x4*)(mb + (3 * sub + 4) * D + col);
                const f32x4 h = y[j] * r2 * g * (1.f + s1) + sh; u32x2 w; w.x = pk2(h.x, h.y); w.y = pk2(h.z, h.w); o8[64 * j] = w; }
        }
    }
}

template <bool DUAL, class Epi>
DEVI void gemm_simple(unsigned char* lds, const bf16_t* A, const bf16_t* Bt, int Mrows, int Nlog, int K, const Epi& E) {
    float* As = (float*)lds; float* Bs = As + 32 * 132;
    const int tid = threadIdx.x, ty = tid >> 4, tx = tid & 15;
    const int LC = DUAL ? 64 : 128, ntn = Nlog / LC, ntiles = (Mrows / 128) * ntn;
    for (int tile = blockIdx.x; tile < ntiles; tile += gridDim.x) {
        const int tm = tile / ntn, tn = tile % ntn;
        float acc[4][8];
#pragma unroll
        for (int i = 0; i < 4; ++i)
#pragma unroll
            for (int j = 0; j < 8; ++j) acc[i][j] = 0.f;
        const int lr = tid >> 2, kc = (tid & 3) * 8;
        const int brow = DUAL ? ((tn >> 1) * 256 + (lr >= 64 ? 128 : 0) + (tn & 1) * 64 + (lr & 63)) : tn * 128 + lr;
        const bf16_t* ap = A + (size_t)(tm * 128 + lr) * K + kc; const bf16_t* bp = Bt + (size_t)brow * K + kc;
        for (int k0 = 0; k0 < K; k0 += 32) {
            float fa[8], fb[8]; unpack8(*(const u32x4*)(ap + k0), fa); unpack8(*(const u32x4*)(bp + k0), fb);
            __syncthreads();
#pragma unroll
            for (int i = 0; i < 8; ++i) { As[(kc + i) * 132 + lr] = fa[i]; Bs[(kc + i) * 132 + lr] = fb[i]; }
            __syncthreads();
#pragma unroll 8
            for (int kk = 0; kk < 32; ++kk) {
                const f32x4 a = *(const f32x4*)(As + kk * 132 + 4 * ty), b0 = *(const f32x4*)(Bs + kk * 132 + 4 * tx), b1 = *(const f32x4*)(Bs + kk * 132 + 64 + 4 * tx);
#pragma unroll
                for (int i = 0; i < 4; ++i) { acc[i][0] += a[i] * b0[0]; acc[i][1] += a[i] * b0[1]; acc[i][2] += a[i] * b0[2]; acc[i][3] += a[i] * b0[3];
                    acc[i][4] += a[i] * b1[0]; acc[i][5] += a[i] * b1[1]; acc[i][6] += a[i] * b1[2]; acc[i][7] += a[i] * b1[3]; }
            }
        }
#pragma unroll
        for (int i = 0; i < 4; ++i) { const int row = tm * 128 + 4 * ty + i;
            const f32x4 v0 = {acc[i][0], acc[i][1], acc[i][2], acc[i][3]}, v1 = {acc[i][4], acc[i][5], acc[i][6], acc[i][7]};
            if (DUAL) E(row, tn * 64 + 4 * tx, v0, v1);
            else { E(row, tn * 128 + 4 * tx, v0, v0); E(row, tn * 128 + 64 + 4 * tx, v1, v1); } }
    }
}

DEVI void st_bf4(bf16_t* p, f32x4 v) { u32x2 w; w.x = pk2(v.x, v.y); w.y = pk2(v.z, v.w); *(u32x2*)p = w; }
DEVI f32x4 ld_bf4(const bf16_t* p) { const u32x2 w = *(const u32x2*)p; return (f32x4){__uint_as_float(w.x << 16), __uint_as_float(w.x & 0xffff0000u), __uint_as_float(w.y << 16), __uint_as_float(w.y & 0xffff0000u)}; }
struct EpSwiglu { bf16_t* H; DEVI void operator()(int row, int col, f32x4 g, f32x4 u) const {
    f32x4 o; o.x = silu_f(g.x) * u.x; o.y = silu_f(g.y) * u.y; o.z = silu_f(g.z) * u.z; o.w = silu_f(g.w) * u.w; st_bf4(H + (size_t)row * DFF + col, o); } };
struct EpF32 { float* Y; DEVI void operator()(int row, int col, f32x4 v, f32x4) const { *(f32x4*)(Y + (size_t)row * D + col) = v; } };
struct EpWin1 { unsigned char* ws; DEVI void operator()(int row, int col, f32x4 v, f32x4) const {
    if (col < 512) st_bf4((bf16_t*)(ws + WS_QA) + (size_t)row * 512 + col, v * QA_SCALE);
    else if (col < 1024) st_bf4((bf16_t*)(ws + WS_KA) + (size_t)row * 512 + (col - 512), v);
    else if (col < 2048) st_bf4((bf16_t*)(ws + WS_VA) + (size_t)row * D + (col - 1024), v);
    else if (col < 3072) st_bf4((bf16_t*)(ws + WS_QB) + (size_t)row * D + (col - 2048), v * C2);
    else if (col < 4096) st_bf4((bf16_t*)(ws + WS_KB) + (size_t)row * D + (col - 3072), v);
    else st_bf4((bf16_t*)(ws + WS_VB) + (size_t)row * D + (col - 4096), v); } };
struct EpWin2 { unsigned char* ws; DEVI void operator()(int row, int col, f32x4 v, f32x4) const {
    if (col < 1024) { f32x4 o = {silu_f(v.x), silu_f(v.y), silu_f(v.z), silu_f(v.w)}; st_bf4((bf16_t*)(ws + WS_RA) + (size_t)row * D + col, o); }
    else { f32x4 o = {sigmoid_f(v.x), sigmoid_f(v.y), sigmoid_f(v.z), sigmoid_f(v.w)}; st_bf4((bf16_t*)(ws + (col < 2048 ? WS_GA : WS_GB)) + (size_t)row * D + (col & 1023), o); } } };
struct EpPa { bf16_t* GA; DEVI void operator()(int row, int col, f32x4 v, f32x4) const { bf16_t* q = GA + (size_t)row * D + col; st_bf4(q, ld_bf4(q) * v); } };
struct EpPb { const bf16_t* Tm; bf16_t* GB; DEVI void operator()(int row, int col, f32x4 v, f32x4) const { bf16_t* q = GB + (size_t)row * D + col; st_bf4(q, ld_bf4(Tm + (size_t)row * D + col) + ld_bf4(q) * v); } };

DEVI void ph_thin_cols(const Params& p) {
    const bf16_t* XN = (const bf16_t*)(p.ws + WS_XN); const float* win = p.in[I_WIN]; const float* bf = p.in[I_BF];
    float* alow = (float*)(p.ws + WS_ALOW); float* logf = (float*)(p.ws + WS_LOGF);
    for (int v = blockIdx.x * 512 + threadIdx.x; v < M * 32; v += gridDim.x * 512) {
        const int m = v >> 5, j = v & 31, col = j < 16 ? 2048 + j : 6160 + (j - 16);
        const bf16_t* xr = XN + (size_t)m * D; const float* w = win + col; float s = 0.f;
        for (int k = 0; k < D; k += 8) { float f[8]; unpack8(*(const u32x4*)(xr + k), f);
#pragma unroll
            for (int i = 0; i < 8; ++i) s += f[i] * w[(size_t)(k + i) * INC]; }
        if (j < 16) alow[m * 16 + j] = s; else logf[(size_t)((m >> 13) * 16 + (j - 16)) * T + (m & (T - 1))] = logsigmoid_f(s + bf[j - 16]);
    }
}
DEVI void ph_fcum(const Params& p, unsigned char* lds) {
    const int tid = threadIdx.x, lane = tid & 63, wave = tid >> 6;
    double* wt = (double*)lds;
    for (int bh = blockIdx.x; bh < 32; bh += gridDim.x) {
        const float* lf = (const float*)(p.ws + WS_LOGF) + (size_t)bh * T + tid * 16; float* fc = (float*)(p.ws + WS_FCUM) + (size_t)bh * T + tid * 16;
        f32x4 v[4]; double s = 0.0;
#pragma unroll
        for (int i = 0; i < 4; ++i) { v[i] = ((const f32x4*)lf)[i]; s += ((double)v[i].x + (double)v[i].y) + ((double)v[i].z + (double)v[i].w); }
        double incl = s;
#pragma unroll
        for (int o = 1; o < 64; o <<= 1) { const double t = __shfl_up(incl, o); if (lane >= o) incl += t; }
        __syncthreads();
        if (lane == 63) wt[wave] = incl;
        __syncthreads();
        double run = incl - s;
        for (int w = 0; w < wave; ++w) run += wt[w];
#pragma unroll
        for (int i = 0; i < 4; ++i) { f32x4 o; run += (double)v[i].x; o.x = (float)run; run += (double)v[i].y; o.y = (float)run; run += (double)v[i].z; o.z = (float)run; run += (double)v[i].w; o.w = (float)run; ((f32x4*)fc)[i] = o; }
    }
    __syncthreads();
}
DEVI void ph_qk_norms(const Params& p) {
    const int lane = threadIdx.x & 63, gw = blockIdx.x * 8 + (threadIdx.x >> 6), NGW = gridDim.x * 8;
    const bf16_t* QB = (const bf16_t*)(p.ws + WS_QB); const bf16_t* KB = (const bf16_t*)(p.ws + WS_KB);
    unsigned* kmax = (unsigned*)(p.ws + WS_KMAX); unsigned* qmax = (unsigned*)(p.ws + WS_QMAX);
    for (int g = gw; g < M / 8; g += NGW) {
        float qm = 0.f, km = 0.f;
        for (int r = 0; r < 8; ++r) { const size_t off = (size_t)(g * 8 + r) * D + 16 * lane; float f[16];
            unpack8(*(const u32x4*)(QB + off), f); unpack8(*(const u32x4*)(QB + off + 8), f + 8); float sq = 0.f;
#pragma unroll
            for (int i = 0; i < 16; ++i) sq += f[i] * f[i];
            unpack8(*(const u32x4*)(KB + off), f); unpack8(*(const u32x4*)(KB + off + 8), f + 8); float sk = 0.f;
#pragma unroll
            for (int i = 0; i < 16; ++i) sk += f[i] * f[i];
            sq += __shfl_xor(sq, 1); sq += __shfl_xor(sq, 2); sk += __shfl_xor(sk, 1); sk += __shfl_xor(sk, 2);
            qm = fmaxf(qm, sq); km = fmaxf(km, sk); }
        if ((lane & 3) == 0) { const int row0 = g * 8, b = row0 >> 13, t = row0 & (T - 1), bh = b * 16 + (lane >> 2);
            atomicMax(kmax + bh * 128 + (t >> 6), __float_as_uint(km)); atomicMax(qmax + bh * 32 + (t >> 8), __float_as_uint(qm)); }
    }
}

template <bool OUT>
DEVI void gla_rec(const Params& p, unsigned char* lds, int unit) {
    const int j = unit & 31, bh = unit >> 5, h = bh & 3, b = bh >> 2;
    const int tid = threadIdx.x, e = tid & 255, dh = tid >> 8, d0 = dh * 64;
    float* qs = (float*)lds; float* ks = qs + 2048; float* al = ks + 2048; float* vs = al + 2048; float* red = vs + 4096; float* lsum = red + 8192;
    float* U = (float*)(p.ws + WS_U) + (size_t)unit * 32768;
    const bf16_t* QA = (const bf16_t*)(p.ws + WS_QA); const bf16_t* KA = (const bf16_t*)(p.ws + WS_KA); bf16_t* VA = (bf16_t*)(p.ws + WS_VA);
    const float* alow = (const float*)(p.ws + WS_ALOW);
    float S[64];
#pragma unroll
    for (int i = 0; i < 64; ++i) S[i] = OUT ? U[(d0 + i) * 256 + e] : 0.f;
    const int dd = tid & 127, tq = tid >> 7;
    float wa[16];
#pragma unroll
    for (int r = 0; r < 16; ++r) wa[r] = p.in[I_WA2][r * 512 + h * 128 + dd];
    const float ba = p.in[I_BA][h * 128 + dd];
    float lacc = 0.f;
    for (int sb = 0; sb < 16; ++sb) {
        const int t0 = b * T + j * 256 + sb * 16;
#pragma unroll
        for (int r = 0; r < 4; ++r) { const int tt = tq + 4 * r; const size_t row = (size_t)(t0 + tt);
            const f32x4* ar = (const f32x4*)(alow + row * 16); float s = ba;
#pragma unroll
            for (int q4 = 0; q4 < 4; ++q4) { const f32x4 a = ar[q4]; s += a.x * wa[4 * q4] + a.y * wa[4 * q4 + 1] + a.z * wa[4 * q4 + 2] + a.w * wa[4 * q4 + 3]; }
            const float la = logsigmoid_f(s) * (1.f / 16.f); lacc += la; al[tt * 128 + dd] = __expf(la);
            qs[tt * 128 + dd] = bf2f(QA[row * 512 + h * 128 + dd]); ks[tt * 128 + dd] = bf2f(KA[row * 512 + h * 128 + dd]); }
#pragma unroll
        for (int r = 0; r < 8; ++r) { const int idx = tid + 512 * r, tt = idx >> 8, ee = idx & 255; vs[idx] = bf2f(VA[(size_t)(t0 + tt) * D + h * 256 + ee]); }
        __syncthreads();
        for (int tt = 0; tt < 16; ++tt) {
            const float v = vs[tt * 256 + e]; float acc = 0.f;
            const float* alp = al + tt * 128 + d0; const float* kp = ks + tt * 128 + d0; const float* qp = qs + tt * 128 + d0;
#pragma unroll
            for (int i = 0; i < 64; ++i) { S[i] = alp[i] * S[i] + kp[i] * v; if (OUT) acc += qp[i] * S[i]; }
            if (OUT) red[(tt * 2 + dh) * 256 + e] = acc;
        }
        __syncthreads();
        if (OUT) {
#pragma unroll
            for (int r = 0; r < 8; ++r) { const int idx = tid + 512 * r, tt = idx >> 8, ee = idx & 255;
                VA[(size_t)(t0 + tt) * D + h * 256 + ee] = (bf16_t)f2bf(red[(tt * 2) * 256 + ee] + red[(tt * 2 + 1) * 256 + ee]); }
        }
    }
    if (!OUT) {
#pragma unroll
        for (int i = 0; i < 64; ++i) U[(d0 + i) * 256 + e] = S[i];
        lsum[tq * 128 + dd] = lacc; __syncthreads();
        if (tid < 128) ((float*)(p.ws + WS_DEC))[unit * 128 + tid] = __expf(lsum[tid] + lsum[128 + tid] + lsum[256 + tid] + lsum[384 + tid]);
    }
    __syncthreads();
}

#define LAS3 __attribute__((address_space(3)))
typedef short v4i16_t __attribute__((ext_vector_type(4)));
typedef short bf16x8_t __attribute__((ext_vector_type(8)));
typedef float f32x16_t __attribute__((ext_vector_type(16)));
constexpr size_t WS_E127 = 23 * MiB + 640 * 1024;
constexpr size_t WS_WTHIN = 23 * MiB + 920 * 1024;
DEVI bf16x8_t tr_pair(const LAS3 char* p0, const LAS3 char* p1) {
    const v4i16_t a = __builtin_amdgcn_ds_read_tr16_b64_v4i16((LAS3 v4i16_t*)p0), b = __builtin_amdgcn_ds_read_tr16_b64_v4i16((LAS3 v4i16_t*)p1);
    return (bf16x8_t){a[0], a[1], a[2], a[3], b[0], b[1], b[2], b[3]};
}
DEVI int crow16(int r, int hi) { return (r & 3) + 8 * (r >> 2) + 4 * hi; }
DEVI float exp_cl(float x) { return __expf(fminf(x, 80.f)); }

DEVI void gla_passA(const Params& p, unsigned char* ldsg, int unit) {
    constexpr int KEP = 320, VP = 576, LV = 256 * KEP, LX = LV + 64 * VP;
    const int j = unit & 31, bh = unit >> 5, h = bh & 3, b = bh >> 2;
    int tid_ = threadIdx.x; asm volatile("" : "+v"(tid_));
    const int tid = tid_, lane = tid & 63, wave = __builtin_amdgcn_readfirstlane(tid >> 6), hi = lane >> 5;
    LAS3 char* lds = (LAS3 char*)ldsg; LAS3 float* tot = (LAS3 float*)(lds + LX); LAS3 float* scl = tot + 512;
    const size_t row0 = (size_t)b * T + j * 256;
    bf16_t* QA = (bf16_t*)(p.ws + WS_QA); bf16_t* KA = (bf16_t*)(p.ws + WS_KA); const bf16_t* VA = (const bf16_t*)(p.ws + WS_VA);
    const float* alow = (const float*)(p.ws + WS_ALOW);
    {
        const int dd = tid & 127, tq = tid >> 7;
        float wa[16];
#pragma unroll
        for (int r = 0; r < 16; ++r) wa[r] = p.in[I_WA2][r * 512 + h * 128 + dd];
        const float ba = p.in[I_BA][h * 128 + dd];
        float la[64]; float cum = 0.f;
#pragma unroll
        for (int i = 0; i < 64; ++i) { const f32x4* ar = (const f32x4*)(alow + (row0 + 64 * tq + i) * 16); float s = ba;
#pragma unroll
            for (int q4 = 0; q4 < 4; ++q4) { const f32x4 a = ar[q4]; s += a.x * wa[4 * q4] + a.y * wa[4 * q4 + 1] + a.z * wa[4 * q4 + 2] + a.w * wa[4 * q4 + 3]; }
            cum += logsigmoid_f(s) * (1.f / 16.f); la[i] = cum; }
        tot[tq * 128 + dd] = cum;
        __syncthreads();
        const float t0 = tot[dd], t1 = tot[128 + dd], t2 = tot[256 + dd], t3 = tot[384 + dd];
        const float off = tq == 0 ? 0.f : (tq == 1 ? t0 : (tq == 2 ? t0 + t1 : t0 + t1 + t2)), b127 = t0 + t1, b255 = b127 + t2 + t3;
#pragma unroll
        for (int i = 0; i < 64; ++i) { const float bt = off + la[i]; const size_t g = (row0 + 64 * tq + i) * 512 + h * 128 + dd;
            const unsigned qe = f2bf(bf2f(QA[g]) * exp_cl(bt - b127)), ke = f2bf(bf2f(KA[g]) * exp_cl(b127 - bt));
            QA[g] = (bf16_t)qe; KA[g] = (bf16_t)ke; *(LAS3 bf16_t*)(lds + (64 * tq + i) * KEP + dd * 2) = (bf16_t)ke; }
        if (tq == 0) { ((float*)(p.ws + WS_E127))[unit * 128 + dd] = __expf(b127); ((float*)(p.ws + WS_DEC))[unit * 128 + dd] = __expf(b255); scl[dd] = __expf(b255 - b127); }
    }
    const int db = wave & 3, eb0 = 4 * (wave >> 2), q4l = (lane & 15) >> 2, pl = lane & 3, chl = (lane >> 4) & 1;
    f32x16_t acc[4];
#pragma unroll
    for (int i = 0; i < 4; ++i) acc[i] = f32x16_t{};
    for (int R = 0; R < 4; ++R) {
        __syncthreads();
#pragma unroll
        for (int i = 0; i < 4; ++i) { const int c = tid + 512 * i, row = c >> 5, ch = c & 31;
            *(LAS3 u32x4*)(lds + LV + row * VP + ch * 16) = *(const u32x4*)(VA + (row0 + 64 * R + row) * D + h * 256 + 8 * ch); }
        __syncthreads();
#pragma unroll
        for (int g = 0; g < 4; ++g) {
            const LAS3 char* ka = lds + (64 * R + 16 * g + 8 * hi + q4l) * KEP + (32 * db + 16 * chl + 4 * pl) * 2;
            const bf16x8_t A = tr_pair(ka, ka + 4 * KEP);
            const LAS3 char* va = lds + LV + (16 * g + 8 * hi + q4l) * VP + (16 * chl + 4 * pl) * 2;
#pragma unroll
            for (int e4 = 0; e4 < 4; ++e4) { const bf16x8_t B = tr_pair(va + (eb0 + e4) * 64, va + (eb0 + e4) * 64 + 4 * VP);
                acc[e4] = __builtin_amdgcn_mfma_f32_32x32x16_bf16(A, B, acc[e4], 0, 0, 0); }
        }
    }
    float* U = (float*)(p.ws + WS_U) + (size_t)unit * 32768;
#pragma unroll
    for (int e4 = 0; e4 < 4; ++e4)
#pragma unroll
        for (int r = 0; r < 16; ++r) { const int d = 32 * db + crow16(r, hi); U[d * 256 + 32 * (eb0 + e4) + (lane & 31)] = scl[d] * acc[e4][r]; }
    __syncthreads();
}

DEVI void gla_passC(const Params& p, unsigned char* ldsg, int unit) {
    constexpr int SP = 272, VP = 576, KEO = 128 * VP, KEP = 272;
    const int j = unit & 31, bh = unit >> 5, h = bh & 3, b = bh >> 2;
    int tid_ = threadIdx.x; asm volatile("" : "+v"(tid_));
    const int tid = tid_, lane = tid & 63, wave = __builtin_amdgcn_readfirstlane(tid >> 6), hi = lane >> 5, l31 = lane & 31;
    LAS3 char* lds = (LAS3 char*)ldsg;
    const size_t row0 = (size_t)b * T + j * 256;
    const bf16_t* QA = (const bf16_t*)(p.ws + WS_QA); const bf16_t* KA = (const bf16_t*)(p.ws + WS_KA); bf16_t* VA = (bf16_t*)(p.ws + WS_VA);
#pragma unroll
    for (int i = 0; i < 8; ++i) { const int c = tid + 512 * i, row = c >> 4, ch = c & 15;
        *(LAS3 u32x4*)(lds + KEO + row * KEP + ch * 16) = *(const u32x4*)(KA + (row0 + row) * 512 + h * 128 + 8 * ch); }
    { const float* S = (const float*)(p.ws + WS_U) + (size_t)unit * 32768; const float* e127 = (const float*)(p.ws + WS_E127) + unit * 128;
#pragma unroll
      for (int i = 0; i < 8; ++i) { const int it = tid + 512 * i, e = it & 255, d0 = (it >> 8) * 8; float v[8];
#pragma unroll
          for (int q = 0; q < 8; ++q) v[q] = S[(d0 + q) * 256 + e] * e127[d0 + q];
          u32x4 w; w.x = pk2(v[0], v[1]); w.y = pk2(v[2], v[3]); w.z = pk2(v[4], v[5]); w.w = pk2(v[6], v[7]);
          *(LAS3 u32x4*)(lds + e * SP + d0 * 2) = w; } }
    const int tb = wave < 4 ? wave : 11 - wave;
    bf16x8_t qf[8];
#pragma unroll
    for (int g = 0; g < 8; ++g) qf[g] = *(const bf16x8_t*)(QA + (row0 + 32 * tb + l31) * 512 + h * 128 + 16 * g + 8 * hi);
    f32x16_t o[8];
#pragma unroll
    for (int i = 0; i < 8; ++i) o[i] = f32x16_t{};
    __syncthreads();
#pragma unroll
    for (int eb = 0; eb < 8; ++eb)
#pragma unroll
        for (int g = 0; g < 8; ++g) { const bf16x8_t B = *(const LAS3 bf16x8_t*)(lds + (32 * eb + l31) * SP + (16 * g + 8 * hi) * 2);
            o[eb] = __builtin_amdgcn_mfma_f32_32x32x16_bf16(qf[g], B, o[eb], 0, 0, 0); }
    const int q4l = (lane & 15) >> 2, pl = lane & 3, chl = (lane >> 4) & 1;
    for (int R = 0; R < 2; ++R) {
        __syncthreads();
#pragma unroll
        for (int i = 0; i < 8; ++i) { const int c = tid + 512 * i, row = c >> 5, ch = c & 31;
            *(LAS3 u32x4*)(lds + row * VP + ch * 16) = *(const u32x4*)(VA + (row0 + 128 * R + row) * D + h * 256 + 8 * ch); }
        __syncthreads();
        if (tb >= 4 * R) {
            const int sbe = tb < 4 * R + 3 ? tb : 4 * R + 3;
            for (int sb = 4 * R; sb <= sbe; ++sb) {
                f32x16_t st = f32x16_t{};
#pragma unroll
                for (int g = 0; g < 8; ++g) { const bf16x8_t A = *(const LAS3 bf16x8_t*)(lds + KEO + (32 * sb + l31) * KEP + (16 * g + 8 * hi) * 2);
                    st = __builtin_amdgcn_mfma_f32_32x32x16_bf16(A, qf[g], st, 0, 0, 0); }
                if (sb == tb) {
#pragma unroll
                    for (int r = 0; r < 16; ++r) if (crow16(r, hi) > l31) st[r] = 0.f;
                }
                u32x4 w0, w1;
                w0.x = pk2(st[0], st[1]); w0.y = pk2(st[2], st[3]); w0.z = pk2(st[4], st[5]); w0.w = pk2(st[6], st[7]);
                w1.x = pk2(st[8], st[9]); w1.y = pk2(st[10], st[11]); w1.z = pk2(st[12], st[13]); w1.w = pk2(st[14], st[15]);
                const bf16x8_t pa0 = __builtin_bit_cast(bf16x8_t, w0), pa1 = __builtin_bit_cast(bf16x8_t, w1);
                const LAS3 char* vb = lds + ((32 * sb - 128 * R) + 4 * hi + q4l) * VP + (16 * chl + 4 * pl) * 2;
#pragma unroll
                for (int eb = 0; eb < 8; ++eb) {
                    const bf16x8_t B0 = tr_pair(vb + eb * 64, vb + eb * 64 + 8 * VP), B1 = tr_pair(vb + eb * 64 + 16 * VP, vb + eb * 64 + 24 * VP);
                    o[eb] = __builtin_amdgcn_mfma_f32_32x32x16_bf16(pa0, B0, o[eb], 0, 0, 0);
                    o[eb] = __builtin_amdgcn_mfma_f32_32x32x16_bf16(pa1, B1, o[eb], 0, 0, 0); }
            }
        }
    }
    __syncthreads();
    const float* gg = p.in[I_GGLA] + h * 256;
    float gv[8];
#pragma unroll
    for (int eb = 0; eb < 8; ++eb) gv[eb] = gg[32 * eb + l31];
#pragma unroll
    for (int r = 0; r < 16; ++r) { float ss = 0.f;
#pragma unroll
        for (int eb = 0; eb < 8; ++eb) ss += o[eb][r] * o[eb][r];
        ss += __shfl_xor(ss, 1); ss += __shfl_xor(ss, 2); ss += __shfl_xor(ss, 4); ss += __shfl_xor(ss, 8); ss += __shfl_xor(ss, 16);
        const float rstd = rsqrtf(ss * (1.f / 256.f) + EPS); bf16_t* op = VA + (row0 + 32 * tb + crow16(r, hi)) * D + h * 256 + l31;
#pragma unroll
        for (int eb = 0; eb < 8; ++eb) op[32 * eb] = (bf16_t)f2bf(o[eb][r] * rstd * gv[eb]); }
    __syncthreads();
}

DEVI void ph_thin_mfma(const Params& p, unsigned char* ldsg) {
    int tid_ = threadIdx.x; asm volatile("" : "+v"(tid_));
    const int tid = tid_, lane = tid & 63, wave = __builtin_amdgcn_readfirstlane(tid >> 6), hi = lane >> 5, l31 = lane & 31, rb = wave & 1, kq = wave >> 1;
    const bf16_t* XN = (const bf16_t*)(p.ws + WS_XN); const bf16_t* WT = (const bf16_t*)(p.ws + WS_WTHIN); const float* bf = p.in[I_BF];
    float* alow = (float*)(p.ws + WS_ALOW); float* logf = (float*)(p.ws + WS_LOGF); float* red = (float*)ldsg;
    for (int unit = blockIdx.x; unit < M / 64; unit += gridDim.x) {
        const bf16_t* ar = XN + (size_t)(unit * 64 + rb * 32 + l31) * D + kq * 256 + 8 * hi; const bf16_t* br = WT + (size_t)l31 * D + kq * 256 + 8 * hi;
        f32x16_t acc = f32x16_t{};
#pragma unroll
        for (int g = 0; g < 16; ++g) acc = __builtin_amdgcn_mfma_f32_32x32x16_bf16(*(const bf16x8_t*)(ar + 16 * g), *(const bf16x8_t*)(br + 16 * g), acc, 0, 0, 0);
        __syncthreads();
#pragma unroll
        for (int r = 0; r < 16; ++r) red[(wave * 16 + r) * 64 + lane] = acc[r];
        __syncthreads();
#pragma unroll
        for (int i = 0; i < 4; ++i) { const int o = tid + 512 * i, rb2 = o >> 10, r = (o >> 6) & 15, ln = o & 63;
            const float s = (red[((0 * 2 + rb2) * 16 + r) * 64 + ln] + red[((1 * 2 + rb2) * 16 + r) * 64 + ln]) + (red[((2 * 2 + rb2) * 16 + r) * 64 + ln] + red[((3 * 2 + rb2) * 16 + r) * 64 + ln]);
            const int m = unit * 64 + rb2 * 32 + crow16(r, ln >> 5), col = ln & 31;
            if (col < 16) alow[m * 16 + col] = s; else logf[(size_t)((m >> 13) * 16 + (col - 16)) * T + (m & (T - 1))] = logsigmoid_f(s + bf[col - 16]); }
    }
    __syncthreads();
}
DEVI void ph_gla_scan(const Params& p) {
    float* U = (float*)(p.ws + WS_U); const float* dec = (const float*)(p.ws + WS_DEC);
    for (int v = blockIdx.x * 512 + threadIdx.x; v < 8 * 32768; v += gridDim.x * 512) {
        const int bh = v >> 15, de = v & 32767, d = de >> 8; float s = 0.f;
        for (int j = 0; j < 32; ++j) { const int unit = bh * 32 + j; float* q = U + (size_t)unit * 32768 + de; const float u = *q; *q = s; s = dec[unit * 128 + d] * s + u; }
    }
}
DEVI void ph_oa_norm(const Params& p) {
    const int lane = threadIdx.x & 63, gw = blockIdx.x * 8 + (threadIdx.x >> 6), NGW = gridDim.x * 8;
    bf16_t* OA = (bf16_t*)(p.ws + WS_VA); const bf16_t* RA = (const bf16_t*)(p.ws + WS_RA); const float* gg = p.in[I_GGLA];
    for (int m = gw; m < M; m += NGW) {
        bf16_t* op = OA + (size_t)m * D + 16 * lane; const bf16_t* rp = RA + (size_t)m * D + 16 * lane;
        float o[16], r[16]; unpack8(*(const u32x4*)op, o); unpack8(*(const u32x4*)(op + 8), o + 8); unpack8(*(const u32x4*)rp, r); unpack8(*(const u32x4*)(rp + 8), r + 8);
        float ss = 0.f;
#pragma unroll
        for (int i = 0; i < 16; ++i) ss += o[i] * o[i];
        ss += __shfl_xor(ss, 1); ss += __shfl_xor(ss, 2); ss += __shfl_xor(ss, 4); ss += __shfl_xor(ss, 8);
        const float rstd = rsqrtf(ss * (1.f / 256.f) + EPS);
        u32x4 w0, w1; float t[16];
#pragma unroll
        for (int i = 0; i < 16; ++i) t[i] = o[i] * rstd * gg[16 * lane + i] * r[i];
        w0.x = pk2(t[0], t[1]); w0.y = pk2(t[2], t[3]); w0.z = pk2(t[4], t[5]); w0.w = pk2(t[6], t[7]);
        w1.x = pk2(t[8], t[9]); w1.y = pk2(t[10], t[11]); w1.z = pk2(t[12], t[13]); w1.w = pk2(t[14], t[15]);
        *(u32x4*)op = w0; *(u32x4*)(op + 8) = w1;
    }
}

DEVI void attn_simple_unit(const Params& p, unsigned char* lds, int unit) {
    const int qb = 15 - (unit >> 5), bh = unit & 31, b = bh >> 4, hh = bh & 15;
    float* Ks = (float*)lds; float* Vs = Ks + 4096; float* bs = Vs + 4096;
    const int tid = threadIdx.x, t = qb * 512 + tid; const size_t row = (size_t)(b * T + t);
    bf16_t* QB = (bf16_t*)(p.ws + WS_QB); const bf16_t* KB = (const bf16_t*)(p.ws + WS_KB); const bf16_t* VB = (const bf16_t*)(p.ws + WS_VB);
    const float* fc = (const float*)(p.ws + WS_FCUM) + (size_t)bh * T;
    float q[64], o[64];
#pragma unroll
    for (int i = 0; i < 8; ++i) unpack8(*(const u32x4*)(QB + row * D + hh * 64 + 8 * i), q + 8 * i);
#pragma unroll
    for (int i = 0; i < 64; ++i) o[i] = 0.f;
    float mx = -1e30f, l = 0.f; const float Fq0 = fc[qb * 512];
    const int nkt = (qb * 512 + 512) / 64;
    for (int kt = 0; kt < nkt; ++kt) {
        __syncthreads();
        { const int key = tid >> 3, c = (tid & 7) * 8; const size_t g = (size_t)(b * T + kt * 64 + key) * D + hh * 64 + c;
          unpack8(*(const u32x4*)(KB + g), Ks + key * 64 + c); unpack8(*(const u32x4*)(VB + g), Vs + key * 64 + c); }
        if (tid < 64) bs[tid] = (Fq0 - fc[kt * 64 + tid]) * LOG2E;
        __syncthreads();
        const int smax = t - kt * 64;
        for (int s = 0; s < 64; ++s) {
            if (s <= smax) {
                float sc = bs[s]; const float* kr = Ks + s * 64;
#pragma unroll
                for (int i = 0; i < 64; ++i) sc += q[i] * kr[i];
                if (sc > mx + 8.f) { const float f = exp2f(mx - sc); l *= f;
#pragma unroll
                    for (int i = 0; i < 64; ++i) o[i] *= f;
                    mx = sc; }
                const float pr = exp2f(sc - mx); l += pr; const float* vr = Vs + s * 64;
#pragma unroll
                for (int i = 0; i < 64; ++i) o[i] += pr * vr[i];
            }
        }
    }
    const float inv = 1.f / l;
#pragma unroll
    for (int i = 0; i < 8; ++i) { u32x4 w; w.x = pk2(o[8 * i] * inv, o[8 * i + 1] * inv); w.y = pk2(o[8 * i + 2] * inv, o[8 * i + 3] * inv); w.z = pk2(o[8 * i + 4] * inv, o[8 * i + 5] * inv); w.w = pk2(o[8 * i + 6] * inv, o[8 * i + 7] * inv);
        *(u32x4*)(QB + row * D + hh * 64 + 8 * i) = w; }
    __syncthreads();
}

namespace pg8 {
#define PG8_LAS __attribute__((address_space(3)))
typedef unsigned short bf16_t;
typedef short bf16x8 __attribute__((ext_vector_type(8)));
typedef float f32x4 __attribute__((ext_vector_type(4)));
typedef unsigned u32x4 __attribute__((ext_vector_type(4)));
constexpr int BM = 256, BK = 64, HALF = 128, HTB = HALF * BK * 2  , STAGE_BYTES = 8 * HTB, NXCD = 8, WGM = 8;

__host__ __device__ __forceinline__ int lds_byte(int r, int c) { const int st = (r >> 4) * 2 + (c >> 5), rr = r & 15, cc = c & 31, ob = rr * 64 + cc * 2; return st * 1024 + (ob ^ (((ob >> 9) & 1) << 5)); }
__host__ __device__ __forceinline__ void stage_rc(int b, int& R, int& C) { const int st = b / 1024, sb = b % 1024, swz = sb ^ (((sb >> 9) & 1) << 5); R = (st >> 1) * 16 + swz / 64; C = (st & 1) * 32 + (swz % 64) / 2; }
__host__ __device__ __forceinline__ int perm32(int rho) { const int n = rho >> 4, i = rho & 15; return 8 * (i >> 2) + 4 * n + (i & 3); }

struct Unit { int pm, pn; };
struct Gemm { const bf16_t* A; const bf16_t* Bt; int M, N, K; };

struct StaticOrder {
    int nM, nN, nwg, G, c;
    __host__ __device__ void init(int M, int N, int G_, int c_) { nM = M / BM; nN = N / BM; nwg = nM * nN; G = G_; c = c_; }
    __host__ __device__ bool next(int i, Unit& u) const {
        const long L = (long)i * G + c; if (L >= nwg) return false;
        int wgid = (int)L; { const int q = nwg / NXCD, r = nwg % NXCD, xcd = wgid % NXCD, off = wgid / NXCD; wgid = (xcd < r ? xcd * (q + 1) : r * (q + 1) + (xcd - r) * q) + off; }
        const int nig = WGM * nN, gid = wgid / nig, fm = gid * WGM, gsz = (nM - fm) < WGM ? (nM - fm) : WGM;
        u.pm = fm + ((wgid % nig) % gsz); u.pn = (wgid % nig) / gsz; return true;
    }
    __device__ __forceinline__ void a_ready(const Unit&) const {}
    __device__ __forceinline__ void done(const Unit&) const {}
};

__device__ __forceinline__ unsigned cvt_pk_bf16(float lo, float hi) { unsigned r; asm volatile("v_cvt_pk_bf16_f32 %0, %1, %2" : "=v"(r) : "v"(lo), "v"(hi)); return r; }
typedef float f32x2 __attribute__((ext_vector_type(2)));

__device__ __forceinline__ float silu_fast(float x) { return x * __builtin_amdgcn_rcpf(1.f + __expf(-x)); }
__device__ __forceinline__ float sigm_fast(float x) { return __builtin_amdgcn_rcpf(1.f + __expf(-x)); }
__device__ __forceinline__ u32x4 pack8(const f32x4 a, const f32x4 b) { u32x4 w; w.x = cvt_pk_bf16(a[0], a[1]); w.y = cvt_pk_bf16(a[2], a[3]); w.z = cvt_pk_bf16(b[0], b[1]); w.w = cvt_pk_bf16(b[2], b[3]); return w; }
__device__ __forceinline__ void unpack8v(const u32x4 v, f32x4& a, f32x4& b) {
    a[0] = __uint_as_float(v.x << 16); a[1] = __uint_as_float(v.x & 0xffff0000u); a[2] = __uint_as_float(v.y << 16); a[3] = __uint_as_float(v.y & 0xffff0000u);
    b[0] = __uint_as_float(v.z << 16); b[1] = __uint_as_float(v.z & 0xffff0000u); b[2] = __uint_as_float(v.w << 16); b[3] = __uint_as_float(v.w & 0xffff0000u); }
struct EpiSwiglu { static constexpr bool PERM = true, AFTER_DRAIN = false; bf16_t* H; int ldh;
    __device__ __forceinline__ void operator()(const f32x4 (&acc)[2][2][4][2], const Unit& u, int wr, int wc, int fr, int fq) const {
        const int row0 = u.pm * BM + wr * 64 + fr, col0 = u.pn * HALF + wc * 32 + 8 * fq;
#pragma unroll
        for (int ai = 0; ai < 2; ++ai)
#pragma unroll
            for (int m = 0; m < 4; ++m) { f32x4 o0, o1;
#pragma unroll
                for (int i = 0; i < 4; ++i) { o0[i] = silu_fast(acc[ai][0][m][0][i]) * acc[ai][1][m][0][i]; o1[i] = silu_fast(acc[ai][0][m][1][i]) * acc[ai][1][m][1][i]; }
                *(u32x4*)(H + (size_t)(row0 + ai * HALF + m * 16) * ldh + col0) = pack8(o0, o1); }
    }
};
struct Seg { bf16_t* base; int ld, colt, act; float sc; };
struct EpiSeg { static constexpr bool PERM = true, AFTER_DRAIN = false; unsigned char* ws; int which;
    __device__ __forceinline__ Seg seg(int pn) const { Seg s; s.sc = 1.f; s.act = 0;
        if (which == 0) {
            if (pn < 2) { s.base = (bf16_t*)(ws + WS_QA); s.ld = 512; s.colt = pn * 256; s.sc = QA_SCALE; }
            else if (pn < 4) { s.base = (bf16_t*)(ws + WS_KA); s.ld = 512; s.colt = (pn - 2) * 256; }
            else if (pn < 8) { s.base = (bf16_t*)(ws + WS_VA); s.ld = 1024; s.colt = (pn - 4) * 256; }
            else if (pn < 12) { s.base = (bf16_t*)(ws + WS_QB); s.ld = 1024; s.colt = (pn - 8) * 256; s.sc = C2; }
            else if (pn < 16) { s.base = (bf16_t*)(ws + WS_KB); s.ld = 1024; s.colt = (pn - 12) * 256; }
            else { s.base = (bf16_t*)(ws + WS_VB); s.ld = 1024; s.colt = (pn - 16) * 256; }
        } else {
            s.ld = 1024; s.colt = (pn & 3) * 256;
            if (pn < 4) { s.base = (bf16_t*)(ws + (which == 2 ? WS_VA : WS_RA)); s.act = which == 2 ? 3 : 1; } else if (pn < 8) { s.base = (bf16_t*)(ws + WS_GA); s.act = 2; } else { s.base = (bf16_t*)(ws + WS_GB); s.act = 2; }
        }
        return s; }
    __device__ __forceinline__ void operator()(const f32x4 (&acc)[2][2][4][2], const Unit& u, int wr, int wc, int fr, int fq) const {
        const Seg s = seg(u.pn); const int row0 = u.pm * BM + wr * 64 + fr, col0 = s.colt + wc * 32 + 8 * fq;
#pragma unroll
        for (int ai = 0; ai < 2; ++ai)
#pragma unroll
            for (int m = 0; m < 4; ++m) { bf16_t* rowp = s.base + (size_t)(row0 + ai * HALF + m * 16) * s.ld + col0;
#pragma unroll
                for (int bj = 0; bj < 2; ++bj) { f32x4 v0 = acc[ai][bj][m][0], v1 = acc[ai][bj][m][1];
                    if (s.act == 1) {
#pragma unroll
                        for (int i = 0; i < 4; ++i) { v0[i] = silu_fast(v0[i]); v1[i] = silu_fast(v1[i]); } }
                    else if (s.act == 2) {
#pragma unroll
                        for (int i = 0; i < 4; ++i) { v0[i] = sigm_fast(v0[i]); v1[i] = sigm_fast(v1[i]); } }
                    else if (s.act == 3) { f32x4 a0, a1; unpack8v(*(const u32x4*)(rowp + bj * HALF), a0, a1);
#pragma unroll
                        for (int i = 0; i < 4; ++i) { v0[i] = a0[i] * silu_fast(v0[i]); v1[i] = a1[i] * silu_fast(v1[i]); } }
                    else { v0 = v0 * s.sc; v1 = v1 * s.sc; }
                    *(u32x4*)(rowp + bj * HALF) = pack8(v0, v1); } }
    }
};
template <int MODE> struct EpiGate { static constexpr bool PERM = true, AFTER_DRAIN = false; bf16_t* G; const bf16_t* Tm;
    __device__ __forceinline__ void operator()(const f32x4 (&acc)[2][2][4][2], const Unit& u, int wr, int wc, int fr, int fq) const {
        const int row0 = u.pm * BM + wr * 64 + fr, col0 = u.pn * BM + wc * 32 + 8 * fq;
#pragma unroll
        for (int ai = 0; ai < 2; ++ai)
#pragma unroll
            for (int m = 0; m < 4; ++m) { const size_t off = (size_t)(row0 + ai * HALF + m * 16) * D + col0;
#pragma unroll
                for (int bj = 0; bj < 2; ++bj) { f32x4 g0, g1; unpack8v(*(const u32x4*)(G + off + bj * HALF), g0, g1);
                    f32x4 v0 = g0 * acc[ai][bj][m][0], v1 = g1 * acc[ai][bj][m][1];
                    if (MODE == 1) { f32x4 t0, t1; unpack8v(*(const u32x4*)(Tm + off + bj * HALF), t0, t1); v0 += t0; v1 += t1; }
                    *(u32x4*)(G + off + bj * HALF) = pack8(v0, v1); } }
    }
};
struct EpiF32 { static constexpr bool PERM = false, AFTER_DRAIN = false; float* Y;
    __device__ __forceinline__ void operator()(const f32x4 (&acc)[2][2][4][2], const Unit& u, int wr, int wc, int fr, int fq) const {
        const int row0 = u.pm * BM + wr * 64 + fr, col0 = u.pn * BM + wc * 32 + 4 * fq;
#pragma unroll
        for (int ai = 0; ai < 2; ++ai)
#pragma unroll
            for (int m = 0; m < 4; ++m) { float* rowp = Y + (size_t)(row0 + ai * HALF + m * 16) * D + col0;
#pragma unroll
                for (int bj = 0; bj < 2; ++bj)
#pragma unroll
                    for (int n = 0; n < 2; ++n) *(f32x4*)(rowp + bj * HALF + n * 16) = acc[ai][bj][m][n]; }
    }
};

template <class Epi, class Sched, bool ALIGN_EPI = false, bool SP2 = false>
__device__ __forceinline__ void gemm_phase(PG8_LAS unsigned char* lds, const Gemm g, const Sched& S, const Epi& E) {
    int tid_ = threadIdx.x; asm volatile("" : "+v"(tid_));
    const int tid = tid_, wid = __builtin_amdgcn_readfirstlane(tid >> 6), lane = tid & 63, wr = wid >> 2, wc = wid & 3, fr = lane & 15, fq = lane >> 4;
    const int K = g.K, nt = K / BK;
    unsigned voffA[2], voffB[2];
#pragma unroll
    for (int i = 0; i < 2; ++i) { int R, C; stage_rc(tid * 16 + i * 8192, R, C); const int Rb = Epi::PERM ? ((R & ~31) + perm32(R & 31)) : R;
        voffA[i] = (unsigned)(R * K + C) * 2u; voffB[i] = (unsigned)(Rb * K + C) * 2u; }
    const size_t kstep = (size_t)(BK * 2);
    const size_t hstep = (size_t)HALF * K * 2;
    const size_t tstep = 2 * hstep;
    const unsigned ldsw = (unsigned)wid * 1024u;
    const int aoff = lds_byte(wr * 64 + fr, fq * 8), boff = lds_byte(wc * 32 + fr, fq * 8);
#define PG8_SA(b, h) (((b) * 2 + (h)) * HTB)
#define PG8_SB(b, h) ((4 + (b) * 2 + (h)) * HTB)
#define PG8_STAGE(bufoff, gbase, voff) do { _Pragma("unroll") for (int _i = 0; _i < 2; ++_i) \
        __builtin_amdgcn_global_load_lds((const unsigned*)((const char*)(gbase) + (voff)[_i]), (PG8_LAS unsigned*)(lds + (bufoff) + ldsw + _i * 8192), 16, 0, 0); } while (0)
#define PG8_LDA(dst, b, h) do { _Pragma("unroll") for (int m = 0; m < 4; ++m) _Pragma("unroll") for (int k = 0; k < 2; ++k) dst[m][k] = *(const PG8_LAS bf16x8*)(lds + PG8_SA(b, h) + aoff + m * 2048 + k * 1024); } while (0)
#define PG8_LDB(dst, b, h) do { _Pragma("unroll") for (int n = 0; n < 2; ++n) _Pragma("unroll") for (int k = 0; k < 2; ++k) dst[n][k] = *(const PG8_LAS bf16x8*)(lds + PG8_SB(b, h) + boff + n * 2048 + k * 1024); } while (0)
#define PG8_MMA(ai, bj, At, Bt) do { __builtin_amdgcn_s_setprio(1); _Pragma("unroll") for (int m = 0; m < 4; ++m) _Pragma("unroll") for (int n = 0; n < 2; ++n) _Pragma("unroll") for (int k = 0; k < 2; ++k) \
        acc[ai][bj][m][n] = __builtin_amdgcn_mfma_f32_16x16x32_bf16(Bt[n][k], At[m][k], acc[ai][bj][m][n], 0, 0, 0); __builtin_amdgcn_s_setprio(0); } while (0)
#define PG8_WAIT_V(n) asm volatile("s_waitcnt vmcnt(" #n ")" ::: "memory")
#define PG8_WAIT_L(n) asm volatile("s_waitcnt lgkmcnt(" #n ")" ::: "memory")
#define PG8_BAR __builtin_amdgcn_s_barrier()
#define PG8_SCHED __builtin_amdgcn_sched_barrier(0)
    Unit cur, nxt; int ui = 0;
    if (!S.next(0, cur)) return;
    f32x4 acc[2][2][4][2];
#pragma unroll
    for (int a = 0; a < 2; ++a)
#pragma unroll
        for (int b = 0; b < 2; ++b)
#pragma unroll
            for (int m = 0; m < 4; ++m)
#pragma unroll
                for (int n = 0; n < 2; ++n) acc[a][b][m][n] = (f32x4){0.f, 0.f, 0.f, 0.f};
    bf16x8 At[4][2], B0[2][2], B1[2][2];
    const char* cA = (const char*)g.A + (size_t)cur.pm * tstep; const char* cB = (const char*)g.Bt + (size_t)cur.pn * tstep;
    S.a_ready(cur);
    if constexpr (SP2) {
        PG8_STAGE(PG8_SB(0, 0), cB, voffB); PG8_STAGE(PG8_SB(0, 1), cB + hstep, voffB); PG8_STAGE(PG8_SA(0, 0), cA, voffA); PG8_STAGE(PG8_SA(0, 1), cA + hstep, voffA);
        if (wr == 1) PG8_BAR;
        PG8_WAIT_V(2); PG8_BAR;
        PG8_STAGE(PG8_SB(1, 0), cB + kstep, voffB); PG8_STAGE(PG8_SA(1, 0), cA + kstep, voffA); PG8_STAGE(PG8_SB(1, 1), cB + hstep + kstep, voffB);
        PG8_WAIT_V(6); PG8_BAR;
    } else {
        PG8_STAGE(PG8_SB(0, 0), cB, voffB); PG8_STAGE(PG8_SA(0, 0), cA, voffA); PG8_STAGE(PG8_SB(0, 1), cB + hstep, voffB); PG8_STAGE(PG8_SA(0, 1), cA + hstep, voffA);
        if (wr == 1) PG8_BAR;
        PG8_WAIT_V(4); PG8_BAR;
        PG8_STAGE(PG8_SB(1, 0), cB + kstep, voffB); PG8_STAGE(PG8_SA(1, 0), cA + kstep, voffA); PG8_STAGE(PG8_SB(1, 1), cB + hstep + kstep, voffB);
        PG8_WAIT_V(6); PG8_BAR;
    }
    for (;;) {
        const bool has_next = S.next(ui + 1, nxt);
        const char* nA = has_next ? (const char*)g.A + (size_t)nxt.pm * tstep : cA; const char* nB = has_next ? (const char*)g.Bt + (size_t)nxt.pn * tstep : cB;
        for (int t = 0; t < nt; t += 2) {
            const bool last = (t == nt - 2);
            const char* a1 = cA + (size_t)(t + 1) * kstep;
            const char* a2 = last ? nA : cA + (size_t)(t + 2) * kstep; const char* b2 = last ? nB : cB + (size_t)(t + 2) * kstep;
            const char* a3 = a2 + kstep; const char* b3 = b2 + kstep;
            if (last && has_next) S.a_ready(nxt);
            if constexpr (SP2) {
            PG8_LDB(B0, 0, 0); PG8_LDB(B1, 0, 1); PG8_SCHED; PG8_LDA(At, 0, 0); PG8_STAGE(PG8_SA(1, 1), a1 + hstep, voffA);
            PG8_WAIT_V(8); PG8_WAIT_L(0); PG8_BAR; PG8_MMA(0, 0, At, B0); PG8_MMA(0, 1, At, B1); PG8_BAR; PG8_SCHED;
            PG8_LDA(At, 0, 1); PG8_STAGE(PG8_SB(0, 0), b2, voffB); PG8_STAGE(PG8_SB(0, 1), b2 + hstep, voffB); PG8_STAGE(PG8_SA(0, 0), a2, voffA);
            PG8_WAIT_V(8); PG8_WAIT_L(0); PG8_BAR; PG8_MMA(1, 0, At, B0); PG8_MMA(1, 1, At, B1); PG8_BAR; PG8_SCHED;
            PG8_LDB(B0, 1, 0); PG8_LDB(B1, 1, 1); PG8_SCHED; PG8_LDA(At, 1, 0); PG8_STAGE(PG8_SA(0, 1), a2 + hstep, voffA);
            PG8_WAIT_V(8); PG8_WAIT_L(0); PG8_BAR; PG8_MMA(0, 0, At, B0); PG8_MMA(0, 1, At, B1); PG8_BAR; PG8_SCHED;
            PG8_LDA(At, 1, 1); PG8_STAGE(PG8_SB(1, 0), b3, voffB); PG8_STAGE(PG8_SB(1, 1), b3 + hstep, voffB); PG8_STAGE(PG8_SA(1, 0), a3, voffA);
            PG8_WAIT_V(8); PG8_WAIT_L(0); PG8_BAR; PG8_MMA(1, 0, At, B0); PG8_MMA(1, 1, At, B1); PG8_BAR; PG8_SCHED;
            } else {
            PG8_LDB(B0, 0, 0); PG8_SCHED; PG8_LDA(At, 0, 0); PG8_STAGE(PG8_SA(1, 1), a1 + hstep, voffA);
            PG8_WAIT_L(8); PG8_BAR; PG8_WAIT_L(0); PG8_MMA(0, 0, At, B0); PG8_BAR; PG8_SCHED;
            PG8_LDB(B1, 0, 1); PG8_STAGE(PG8_SB(0, 0), b2, voffB);
            PG8_BAR; PG8_WAIT_L(0); PG8_MMA(0, 1, At, B1); PG8_BAR;
            PG8_LDA(At, 0, 1); PG8_STAGE(PG8_SA(0, 0), a2, voffA);
            PG8_BAR; PG8_WAIT_L(0); PG8_MMA(1, 0, At, B0); PG8_BAR; PG8_SCHED;
            PG8_STAGE(PG8_SB(0, 1), b2 + hstep, voffB);
            PG8_WAIT_V(6); PG8_BAR; PG8_MMA(1, 1, At, B1); PG8_BAR;
            PG8_LDB(B0, 1, 0); PG8_SCHED; PG8_LDA(At, 1, 0); PG8_STAGE(PG8_SA(0, 1), a2 + hstep, voffA);
            PG8_WAIT_L(8); PG8_BAR; PG8_WAIT_L(0); PG8_MMA(0, 0, At, B0); PG8_BAR; PG8_SCHED;
            PG8_LDB(B1, 1, 1); PG8_STAGE(PG8_SB(1, 0), b3, voffB);
            PG8_BAR; PG8_WAIT_L(0); PG8_MMA(0, 1, At, B1); PG8_BAR;
            PG8_LDA(At, 1, 1); PG8_STAGE(PG8_SA(1, 0), a3, voffA);
            PG8_BAR; PG8_WAIT_L(0); PG8_MMA(1, 0, At, B0); PG8_BAR; PG8_SCHED;
            PG8_STAGE(PG8_SB(1, 1), b3 + hstep, voffB);
            PG8_WAIT_V(6); PG8_BAR; PG8_MMA(1, 1, At, B1); PG8_BAR;
            }
        }
        if constexpr (ALIGN_EPI) { if (wr == 0) PG8_BAR; }
        if constexpr (!Epi::AFTER_DRAIN) { E(acc, cur, wr, wc, fr, fq); S.done(cur); }
        if (!has_next) break;
#pragma unroll
        for (int a = 0; a < 2; ++a)
#pragma unroll
            for (int b = 0; b < 2; ++b)
#pragma unroll
                for (int m = 0; m < 4; ++m)
#pragma unroll
                    for (int n = 0; n < 2; ++n) acc[a][b][m][n] = (f32x4){0.f, 0.f, 0.f, 0.f};
        cur = nxt; cA = nA; cB = nB; ++ui;
        if constexpr (ALIGN_EPI) { if (wr == 1) PG8_BAR; }
    }
    PG8_WAIT_V(0);
    if constexpr (!ALIGN_EPI) { if (wr == 0) PG8_BAR; }
    PG8_BAR;
    if constexpr (Epi::AFTER_DRAIN) { E.fused(acc, cur, wr, wc, fr, fq, lds, wid, lane); S.done(cur); }
#undef PG8_SA
#undef PG8_SB
#undef PG8_STAGE
#undef PG8_LDA
#undef PG8_LDB
#undef PG8_MMA
#undef PG8_WAIT_V
#undef PG8_WAIT_L
#undef PG8_BAR
#undef PG8_SCHED
}
}


template <class Epi, bool ALIGN>
DEVI void run_gemm(unsigned char* lds, const bf16_t* A, const bf16_t* Bt, int Mr, int N, int K, const Epi& E) {
    pg8::Gemm g{A, Bt, Mr, N, K}; pg8::StaticOrder S; S.init(Mr, N, (int)gridDim.x, (int)blockIdx.x);
    pg8::gemm_phase<Epi, pg8::StaticOrder, ALIGN, true>((PG8_LAS unsigned char*)lds, g, S, E);
}
#include <hip/hip_bf16.h>
#include <cmath>
namespace attn_body {
using bf16=__hip_bfloat16;
using bf16x8=__attribute__((ext_vector_type(8)))short;
using s16x4=__attribute__((ext_vector_type(4)))short;
using f32x16=__attribute__((ext_vector_type(16)))float;
using u32x4=__attribute__((ext_vector_type(4)))unsigned;
constexpr int BATCH=2,NHEAD=16,SEQ=8192,D=64,DM=NHEAD*D;
constexpr int NW=8,QBLK=32,QB=QBLK*NW,KVBLK=64,NQB=SEQ/QB;
constexpr int ATTN_PITCH=DM, ATTN_UNIT_ROWS=QB;
__device__ __forceinline__ int crow(int r,int hi){return (r&3)+8*(r>>2)+4*hi;}
#define SBAR() __builtin_amdgcn_sched_barrier(0)
__device__ __forceinline__ void cmask(f32x16&p0,f32x16&p1,int jb,int qrel,int hi){
  const float NEG=-INFINITY; int kb=64*jb+4*hi;
  #pragma unroll
  for(int r=0;r<16;++r){int kv=kb+(r&3)+8*(r>>2); if(kv>qrel)p0[r]=NEG; if(kv+32>qrel)p1[r]=NEG;}
}

constexpr int NSLOT=3, SLOTB=8192;
constexpr int LDS_K=0, LDS_V=NSLOT*SLOTB, LDS_WS=2*NSLOT*SLOTB, LDS_OST=LDS_WS+NW*64*4, LDS_BYTES=LDS_OST+NW*4096;
constexpr float PRUNE_MARGIN=64.f;
constexpr int LDS_FB=LDS_BYTES;
constexpr float C2=0.125f*1.4426950408889634f;
__device__ __forceinline__ void glds16(const void*gsrc,unsigned lds_dst){unsigned keep;
  asm volatile("s_mov_b32 %0, m0\n\ts_mov_b32 m0, %2\n\ts_nop 0\n\tglobal_load_lds_dwordx4 %1, off\n\ts_mov_b32 m0, %0":"=&s"(keep):"v"(gsrc),"s"(lds_dst):"memory");}
__device__ __forceinline__ float max3f(float a,float b,float c){float r;asm("v_max3_f32 %0, %1, %2, %3":"=v"(r):"v"(a),"v"(b),"v"(c));return r;}
__device__ __forceinline__ float max2f(float a,float b){float r;asm("v_max_f32_e32 %0, %1, %2":"=v"(r):"v"(a),"v"(b));return r;}
__device__ __forceinline__ float fadd_s(float a,float b){float r;asm("v_add_f32_e32 %0, %1, %2":"=v"(r):"v"(a),"v"(b));return r;}
__device__ __forceinline__ float fsub_s(float a,float b){float r;asm("v_sub_f32_e32 %0, %1, %2":"=v"(r):"v"(a),"v"(b));return r;}
typedef float f32x2_t __attribute__((ext_vector_type(2))); typedef float f32x4_t __attribute__((ext_vector_type(4))); typedef __bf16 bf16x2_t __attribute__((ext_vector_type(2)));
__device__ __forceinline__ unsigned cvtpk_s(float lo,float hi){f32x2_t v={lo,hi};bf16x2_t b=__builtin_convertvector(v,bf16x2_t);return __builtin_bit_cast(unsigned,b);}
#define WAIT_BAR(N) asm volatile("s_waitcnt vmcnt(" #N ") lgkmcnt(0)\n\ts_barrier":::"memory")

__device__ __forceinline__ void qkt(f32x16&p0,f32x16&p1,const char*Kslot,const bf16x8*qr,int r32,int hi){
  const char*kb=Kslot+hi*1024+r32*16;
  #pragma unroll
  for(int d0=0;d0<4;++d0){
    const bf16x8 b0=*reinterpret_cast<const bf16x8*>(kb+d0*2048);
    const bf16x8 b1=*reinterpret_cast<const bf16x8*>(kb+d0*2048+512);
    {p0=__builtin_amdgcn_mfma_f32_32x32x16_bf16(b0,qr[d0],p0,0,0,0);p1=__builtin_amdgcn_mfma_f32_32x32x16_bf16(b1,qr[d0],p1,0,0,0);}}
}
typedef __attribute__((address_space(3))) const char* lds_cptr;
typedef short v4i16_t __attribute__((ext_vector_type(4)));
__device__ __forceinline__ void kload8(bf16x8*kf,lds_cptr kp){
  kf[0]=*(const __attribute__((address_space(3))) bf16x8*)(kp);      kf[1]=*(const __attribute__((address_space(3))) bf16x8*)(kp+512);
  kf[2]=*(const __attribute__((address_space(3))) bf16x8*)(kp+2048); kf[3]=*(const __attribute__((address_space(3))) bf16x8*)(kp+2560);
  kf[4]=*(const __attribute__((address_space(3))) bf16x8*)(kp+4096); kf[5]=*(const __attribute__((address_space(3))) bf16x8*)(kp+4608);
  kf[6]=*(const __attribute__((address_space(3))) bf16x8*)(kp+6144); kf[7]=*(const __attribute__((address_space(3))) bf16x8*)(kp+6656);
}
__device__ __forceinline__ void kload2(bf16x8*kf,lds_cptr kp,int j){ kf[2*j]=*(const __attribute__((address_space(3))) bf16x8*)(kp+j*2048); kf[2*j+1]=*(const __attribute__((address_space(3))) bf16x8*)(kp+j*2048+512); }
__device__ __forceinline__ s16x4 vtr(lds_cptr p){ return __builtin_bit_cast(s16x4,__builtin_amdgcn_ds_read_tr16_b64_v4i16((__attribute__((address_space(3))) v4i16_t*)p)); }
__device__ __forceinline__ float rowmax(const f32x16&p0,const f32x16&p1){
  float a=max3f(p0[0],p0[1],p1[0]),b=max3f(p0[2],p0[3],p1[1]);a=max3f(a,p1[2],p1[3]);
  #pragma unroll
  for(int r=4;r<16;r+=4){a=max3f(a,p0[r],p0[r+1]);b=max3f(b,p0[r+2],p0[r+3]);a=max3f(a,p1[r],p1[r+1]);b=max3f(b,p1[r+2],p1[r+3]);}
  const float m=max2f(a,b);
  auto rr=__builtin_amdgcn_permlane32_swap(__float_as_uint(m),__float_as_uint(m),false,false);
  return max2f(__uint_as_float(rr[0]),__uint_as_float(rr[1]));
}
__device__ __forceinline__ void pv(f32x16*o,int vb,bf16x8 pa0,bf16x8 pa1,bf16x8 pa2,bf16x8 pa3){
  #pragma unroll
  for(int d0=0;d0<2;++d0){s16x4 lo[4],hi[4];
    #pragma unroll
    for(int ks=0;ks<4;++ks){
      asm volatile("ds_read_b64_tr_b16 %0,%1 offset:%c2":"=&v"(lo[ks]):"v"(vb),"i"(d0*4096+ks*1024):"memory");
      asm volatile("ds_read_b64_tr_b16 %0,%1 offset:%c2":"=&v"(hi[ks]):"v"(vb),"i"(d0*4096+ks*1024+512):"memory");}
    asm volatile("s_waitcnt lgkmcnt(0)":::"memory");SBAR();
    #define PK(k) (bf16x8){lo[k][0],lo[k][1],lo[k][2],lo[k][3],hi[k][0],hi[k][1],hi[k][2],hi[k][3]}
    o[d0]=__builtin_amdgcn_mfma_f32_32x32x16_bf16(pa0,PK(0),o[d0],0,0,0);
    o[d0]=__builtin_amdgcn_mfma_f32_32x32x16_bf16(pa1,PK(1),o[d0],0,0,0);
    o[d0]=__builtin_amdgcn_mfma_f32_32x32x16_bf16(pa2,PK(2),o[d0],0,0,0);
    o[d0]=__builtin_amdgcn_mfma_f32_32x32x16_bf16(pa3,PK(3),o[d0],0,0,0);
    #undef PK
  }
}

#ifndef ATTN_STORE16
#define ATTN_STORE16(p,v) (*(u32x4*)(p)=(v))
#endif
template<int THRL> __device__ __forceinline__ void attn_unit(int b,int h,int qb,const bf16*Q,const bf16*__restrict__ K,const bf16*__restrict__ V,bf16*O,const float*__restrict__ Fc,const unsigned*__restrict__ kmx,const unsigned*__restrict__ qmx,char*shm){
  int tid_=threadIdx.x; asm volatile("":"+v"(tid_)); const int tid=tid_,lane=tid&63,r32=lane&31,hi=lane>>5; const int wid=__builtin_amdgcn_readfirstlane(tid>>6);
  const long rowbase=(long)b*SEQ; const int q0=qb*QB;
  const bf16*Qw=Q+(rowbase+q0+wid*QBLK)*DM+h*D;
  int ts=0; const float fq0=Fc[q0];
  { const int NT0=(q0+QB)/KVBLK; const float qm=__builtin_sqrtf(__uint_as_float(qmx[qb]));
    const float kd=__builtin_sqrtf(__uint_as_float(max(max(kmx[4*qb],kmx[4*qb+1]),max(kmx[4*qb+2],kmx[4*qb+3]))));
    const float thr=-qm*kd-PRUNE_MARGIN; int first=NT0;
    for(int base=0;base<NT0-4;base+=64){ const int kt=base+lane; bool keep=false;
      if(kt<NT0-4){ const float ub=qm*__builtin_sqrtf(__uint_as_float(kmx[kt]))+(fq0-Fc[kt*64+63])*1.4426950408889634f; keep=!(ub<thr); }
      const unsigned long long mk=__ballot(keep); if(mk){ first=base+__builtin_ctzll(mk); break; } }
    ts=min(first,NT0-4)&~1; ts=__builtin_amdgcn_readfirstlane(ts); }
  const bf16*Kh=K+(rowbase+(long)ts*KVBLK)*DM+h*D,*Vh=V+(rowbase+(long)ts*KVBLK)*DM+h*D; Fc+=ts*KVBLK;
  const unsigned lds0=(unsigned)(uintptr_t)shm;
  float*wsf=(float*)(shm+LDS_WS)+wid*64;
  const bf16*ksrc=Kh+(long)lane*DM+wid*8;
  const bf16*vsrc=Vh+(long)(16*(wid&3)+(lane>>2))*DM+(wid>>2)*32+(lane&3)*8;
  const unsigned kdst=lds0+LDS_K+wid*1024, vdst=lds0+LDS_V+wid*1024;
  #define DMA_K(t,slot) glds16(ksrc+(long)(t)*KVBLK*DM,(unsigned)__builtin_amdgcn_readfirstlane(kdst+(slot)))
  #define DMA_V(t,slot) glds16(vsrc+(long)(t)*KVBLK*DM,(unsigned)__builtin_amdgcn_readfirstlane(vdst+(slot)))
  const int vb0=(int)(lds0+LDS_V)+((lane>>4)&1)*32+(lane&3)*8+(4*hi+((lane&15)>>2))*64;
  const char*Kbase=shm+LDS_K; bf16x8 kf[8];
  const lds_cptr shm3=(lds_cptr)shm; const lds_cptr kp0=shm3+LDS_K+hi*1024+r32*16; const lds_cptr vp0=shm3+LDS_V+((lane>>4)&1)*32+(lane&3)*8+(4*hi+((lane&15)>>2))*64;
  const int NT=(q0+QB)/KVBLK-ts;
  DMA_K(0,0);DMA_V(0,0);DMA_K(1,SLOTB);
  bf16x8 qr[4];
  #pragma unroll
  for(int d0=0;d0<4;++d0)qr[d0]=*reinterpret_cast<const bf16x8*>(&Qw[(long)r32*DM+d0*16+hi*8]);
  float mhat=0.f,l_reg=0.f;f32x16 o[2];o[0]=f32x16{};o[1]=f32x16{};
  const int qrel=wid*QBLK+r32;
  #define CMASK(P0,P1,t) do{int jb_=(t)-(NT-4); if(jb_>=0)cmask(P0,P1,jb_,qrel,hi);}while(0)
  bool resc=false;
  #define START(P0,P1) do{ const float rm=rowmax(P0,P1); resc=false; \
    { const float dl=rm; mhat=fadd_s(mhat,dl); \
      _Pragma("unroll") for(int r=0;r<16;++r){P0[r]=fsub_s(P0[r],dl);P1[r]=fsub_s(P1[r],dl);} \
      } \
    _Pragma("unroll") for(int r=0;r<16;++r)P0[r]=__builtin_amdgcn_exp2f(P0[r]); }while(0)
  #define RESC() do{ if(resc){ asm volatile("s_waitcnt lgkmcnt(0)":::"memory"); \
      _Pragma("unroll") for(int d_=0;d_<2;++d_) _Pragma("unroll") for(int r=0;r<16;++r)o[d_][r]*=wsf[crow(r,hi)]; } }while(0)
  f32x16 pA0,pA1,pB0,pB1;
  int sl_prev=0,sl_cur=0,sl_next=SLOTB;
  #define ROT() do{sl_prev=sl_cur;sl_cur=sl_next;sl_next=(sl_next==(NSLOT-1)*SLOTB)?0:sl_next+SLOTB;}while(0)
  DMA_K(2,2*SLOTB);
  typedef __attribute__((address_space(3))) f32x4_t* lds_f4w; typedef const __attribute__((address_space(3))) f32x4_t* lds_f4ptr;
  { const lds_f4w fbw=(lds_f4w)((__attribute__((address_space(3))) char*)shm+LDS_FB); const f32x4_t*fsrc=(const f32x4_t*)Fc;
    for(int i=tid;i<NT*16;i+=NW*64){ const f32x4_t v=fsrc[i]; fbw[i]=(fq0-v)*1.4426950408889634f; } }
  #define FBINIT(X0,X1,tt) do{ const lds_f4ptr fp_=(lds_f4ptr)(shm3+LDS_FB+((tt)*64+4*hi)*4); \
    _Pragma("unroll") for(int g_=0;g_<4;++g_){ const f32x4_t a_=fp_[2*g_],b_=fp_[2*g_+8]; \
      X0[4*g_]=a_[0]-mhat;X0[4*g_+1]=a_[1]-mhat;X0[4*g_+2]=a_[2]-mhat;X0[4*g_+3]=a_[3]-mhat; X1[4*g_]=b_[0]-mhat;X1[4*g_+1]=b_[1]-mhat;X1[4*g_+2]=b_[2]-mhat;X1[4*g_+3]=b_[3]-mhat; } }while(0)
  WAIT_BAR(3);
  FBINIT(pA0,pA1,0); qkt(pA0,pA1,Kbase,qr,r32,hi);asm volatile("s_nop 15\n\ts_nop 7":"+v"(pA0),"+v"(pA1));CMASK(pA0,pA1,0);
  START(pA0,pA1);
  _Pragma("unroll") for(int r=0;r<16;++r)pA1[r]=__builtin_amdgcn_exp2f(pA1[r]);
  WAIT_BAR(0);
  DMA_K(3,0);DMA_V(1,SLOTB);
  ROT();
  kload8(kf,kp0+sl_cur);
  FBINIT(pB0,pB1,1);
  WAIT_BAR(2);
  s16x4 vlo[8],vhi[8]; u32x4 pw0,pw1,pw2,pw3;
  #define PKW(P,B) cvtpk_s(P[B],P[B+1])
  #define PAF(k) __builtin_bit_cast(bf16x8,pw##k)
  #define VFR(i) (bf16x8){vlo[i][0],vlo[i][1],vlo[i][2],vlo[i][3],vhi[i][0],vhi[i][1],vhi[i][2],vhi[i][3]}
  #define PIN(x) asm volatile("":"+v"(x))
  #define MX3(a,b,c) __builtin_fmaxf(__builtin_fmaxf((a),(b)),(c))
  #define GAPA(MF,A0,A1,A2,A3,W0,W1,PW) do{ MF; sacc+=A0; sacc+=A1; sacc+=A2; sacc+=A3; PIN(sacc); W0; W1; PIN(PW); SBAR(); }while(0)
  #define EX(v) __builtin_amdgcn_exp2f(v)
  #define GAPB(MF,X,B,BI) do{ MF; X[B]=EX(X[B]); X[B+1]=EX(X[B+1]); X[B+2]=EX(X[B+2]); X[B+3]=EX(X[B+3]); PIN(X); BI; SBAR(); }while(0)
  #define BINIT(PX,G,bv) do{ PX[4*(G)]=bv[0]-mhat; PX[4*(G)+1]=bv[1]-mhat; PX[4*(G)+2]=bv[2]-mhat; PX[4*(G)+3]=bv[3]-mhat; PIN(PX); }while(0)
  #define VRD(i) do{ vlo[i]=vtr(vp_+(((i)>>2)*4096+((i)&3)*1024)); vhi[i]=vtr(vp_+(((i)>>2)*4096+((i)&3)*1024+512)); }while(0)
  #define KRD(G,j) do{ if(G){ kload2(kf,kp0+sl_next,j); SBAR(); } }while(0)
  #define STEP(C0,C1,P0,P1,t,GK,GV,GL) do{ SBAR(); \
    const lds_cptr vp_=vp0+sl_prev; \
    VRD(0); SBAR(); float sacc=(P0[0]+P0[1]); \
    GAPA(C0=__builtin_amdgcn_mfma_f32_32x32x16_bf16(kf[0],qr[0],C0,0,0,0), P0[2],P0[3],P0[4],P0[5],     pw0[0]=PKW(P0,0), pw0[1]=PKW(P0,2), pw0); \
    VRD(4); SBAR(); GAPA(C1=__builtin_amdgcn_mfma_f32_32x32x16_bf16(kf[1],qr[0],C1,0,0,0), P0[6],P0[7],P0[8],P0[9],     pw0[2]=PKW(P0,4), pw0[3]=PKW(P0,6), pw0); \
    VRD(1); SBAR(); GAPA(C0=__builtin_amdgcn_mfma_f32_32x32x16_bf16(kf[2],qr[1],C0,0,0,0),   P0[10],P0[11],P0[12],P0[13], pw1[0]=PKW(P0,8), pw1[1]=PKW(P0,10), pw1); \
    VRD(5); SBAR(); GAPA(C1=__builtin_amdgcn_mfma_f32_32x32x16_bf16(kf[3],qr[1],C1,0,0,0),   P0[14],P0[15],P1[0],P1[1],   pw1[2]=PKW(P0,12),pw1[3]=PKW(P0,14), pw1); \
    VRD(2); SBAR(); GAPA(C0=__builtin_amdgcn_mfma_f32_32x32x16_bf16(kf[4],qr[2],C0,0,0,0),   P1[2],P1[3],P1[4],P1[5],     pw2[0]=PKW(P1,0), pw2[1]=PKW(P1,2), pw2); \
    VRD(6); SBAR(); GAPA(C1=__builtin_amdgcn_mfma_f32_32x32x16_bf16(kf[5],qr[2],C1,0,0,0),   P1[6],P1[7],P1[8],P1[9],     pw2[2]=PKW(P1,4), pw2[3]=PKW(P1,6), pw2); \
    VRD(3); SBAR(); GAPA(C0=__builtin_amdgcn_mfma_f32_32x32x16_bf16(kf[6],qr[3],C0,0,0,0),   P1[10],P1[11],P1[12],P1[13], pw3[0]=PKW(P1,8), pw3[1]=PKW(P1,10), pw3); \
    VRD(7); SBAR(); GAPA(C1=__builtin_amdgcn_mfma_f32_32x32x16_bf16(kf[7],qr[3],C1,0,0,0),   P1[14],P1[15],0.f,0.f,       pw3[2]=PKW(P1,12),pw3[3]=PKW(P1,14), pw3); \
    l_reg+=sacc; \
    if(GK){DMA_K((t)+3,sl_cur);} if(GV){DMA_V((t)+1,sl_next);} \
    CMASK(C0,C1,t); \
    const lds_f4ptr fbp_=(lds_f4ptr)(shm3+LDS_FB+(((t)+1)*64+4*hi)*4); f32x4_t bvA=fbp_[0]; \
    { float a=MX3(C0[0],C0[1],C1[0]),b=MX3(C0[2],C0[3],C1[1]); a=MX3(a,C1[2],C1[3]); \
      _Pragma("unroll") for(int r=4;r<16;r+=4){a=MX3(a,C0[r],C0[r+1]);b=MX3(b,C0[r+2],C0[r+3]);a=MX3(a,C1[r],C1[r+1]);b=MX3(b,C1[r+2],C1[r+3]);} \
      float rm=__builtin_fmaxf(a,b); { auto rr=__builtin_amdgcn_permlane32_swap(__float_as_uint(rm),__float_as_uint(rm),false,false); rm=__builtin_fmaxf(__uint_as_float(rr[0]),__uint_as_float(rr[1])); } \
      resc=false; \
      if(__builtin_expect(__any(rm>(float)THRL),0)){ const float dl=__builtin_fmaxf(rm,0.f); mhat+=dl; \
        _Pragma("unroll") for(int r=0;r<16;++r){C0[r]-=dl;C1[r]-=dl;} \
        const float f=__builtin_amdgcn_exp2f(-dl); l_reg*=f; if(hi==0)wsf[r32]=f; resc=true; } } \
    SBAR(); \
    GAPB(o[0]=__builtin_amdgcn_mfma_f32_32x32x16_bf16(PAF(0),VFR(0),o[0],0,0,0), C0,0,do{BINIT(P0,0,bvA); bvA=fbp_[2];}while(0)); \
    GAPB(o[1]=__builtin_amdgcn_mfma_f32_32x32x16_bf16(PAF(0),VFR(4),o[1],0,0,0), C0,4,do{BINIT(P0,1,bvA); bvA=fbp_[4];}while(0)); \
    KRD(GL,0); GAPB(o[0]=__builtin_amdgcn_mfma_f32_32x32x16_bf16(PAF(1),VFR(1),o[0],0,0,0), C0,8,do{BINIT(P0,2,bvA); bvA=fbp_[6];}while(0)); \
    KRD(GL,1); GAPB(o[1]=__builtin_amdgcn_mfma_f32_32x32x16_bf16(PAF(1),VFR(5),o[1],0,0,0), C0,12,do{BINIT(P0,3,bvA); bvA=fbp_[8];}while(0)); \
    KRD(GL,2); GAPB(o[0]=__builtin_amdgcn_mfma_f32_32x32x16_bf16(PAF(2),VFR(2),o[0],0,0,0), C1,0,do{BINIT(P1,0,bvA); bvA=fbp_[10];}while(0)); \
    KRD(GL,3); GAPB(o[1]=__builtin_amdgcn_mfma_f32_32x32x16_bf16(PAF(2),VFR(6),o[1],0,0,0), C1,4,do{BINIT(P1,1,bvA); bvA=fbp_[12];}while(0)); \
    GAPB(o[0]=__builtin_amdgcn_mfma_f32_32x32x16_bf16(PAF(3),VFR(3),o[0],0,0,0), C1,8,do{BINIT(P1,2,bvA); bvA=fbp_[14];}while(0)); \
    GAPB(o[1]=__builtin_amdgcn_mfma_f32_32x32x16_bf16(PAF(3),VFR(7),o[1],0,0,0), C1,12,do{BINIT(P1,3,bvA);}while(0)); \
    }while(0)
  int t=1;
  #undef CMASK
  #define CMASK(P0,P1,t) do{}while(0)
  for(;t+5<NT;t+=2){
    STEP(pB0,pB1,pA0,pA1,t,true,true,true);     WAIT_BAR(2); RESC(); ROT();
    STEP(pA0,pA1,pB0,pB1,t+1,true,true,true);   WAIT_BAR(2); RESC(); ROT();
  }
  #undef CMASK
  #define CMASK(P0,P1,t) do{int jb_=(t)-(NT-4); if(jb_>=0)cmask(P0,P1,jb_,qrel,hi);}while(0)
  #define ENDW(tt) do{ if((tt)+3<NT){WAIT_BAR(2);} else if((tt)+2<NT){WAIT_BAR(1);} else {WAIT_BAR(0);} }while(0)
  for(;t+1<NT;t+=2){
    STEP(pB0,pB1,pA0,pA1,t,(t+3<NT),(t+1<NT),(t+1<NT));       ENDW(t);   RESC(); ROT();
    STEP(pA0,pA1,pB0,pB1,t+1,(t+4<NT),(t+2<NT),(t+2<NT));     ENDW(t+1); RESC(); ROT();
  }
  STEP(pB0,pB1,pA0,pA1,NT-1,false,false,false); RESC();
  { float sacc=pB0[0]+pB0[1]; _Pragma("unroll") for(int r=2;r<16;++r)sacc+=pB0[r]; _Pragma("unroll") for(int r=0;r<16;++r)sacc+=pB1[r]; l_reg+=sacc;
    pw0=(u32x4){PKW(pB0,0),PKW(pB0,2),PKW(pB0,4),PKW(pB0,6)};pw1=(u32x4){PKW(pB0,8),PKW(pB0,10),PKW(pB0,12),PKW(pB0,14)};pw2=(u32x4){PKW(pB1,0),PKW(pB1,2),PKW(pB1,4),PKW(pB1,6)};pw3=(u32x4){PKW(pB1,8),PKW(pB1,10),PKW(pB1,12),PKW(pB1,14)};
    SBAR(); pv(o,vb0+sl_cur,PAF(0),PAF(1),PAF(2),PAF(3)); }
  #undef PKW
  #undef PAF
  #undef VFR
  #undef PIN
  #undef MX3
  #undef GAPA
  #undef GAPB
  #undef BINIT
  #undef FBINIT
  #undef EX
  #undef VRD
  #undef KRD
  #undef STEP
  #undef ENDW
  {auto rr=__builtin_amdgcn_permlane32_swap(__float_as_uint(l_reg),__float_as_uint(l_reg),false,false);l_reg=__uint_as_float(rr[0])+__uint_as_float(rr[1]);}
  if(hi==0)wsf[32+r32]=l_reg;asm volatile("s_waitcnt lgkmcnt(0)":::"memory");
  float rli[16];
  #pragma unroll
  for(int r=0;r<16;++r)rli[r]=__builtin_amdgcn_rcpf(wsf[32+crow(r,hi)]);
  bf16*Ow=O+(rowbase+q0+wid*QBLK)*DM+h*D;
  { bf16*stg=(bf16*)(shm+LDS_OST)+wid*2048;
    #pragma unroll
    for(int r=0;r<16;++r){const int orow=crow(r,hi);
      #pragma unroll
      for(int d0=0;d0<2;++d0)stg[orow*64+d0*32+r32]=__float2bfloat16(o[d0][r]*rli[r]);}
    asm volatile("s_waitcnt lgkmcnt(0)":::"memory");
    #pragma unroll
    for(int i=0;i<4;++i){const int row=i*8+(lane>>3),ch=lane&7; const u32x4 v=*(const u32x4*)(stg+row*64+ch*8); ATTN_STORE16(Ow+(long)row*DM+ch*8,v);} }
  asm volatile("s_waitcnt lgkmcnt(0)\n\ts_barrier":::"memory");
  #undef DMA_K
  #undef DMA_V
  #undef CMASK
  #undef START
  #undef RESC
  #undef ROT
}
constexpr int ATTN_LDS_BYTES=LDS_BYTES;
struct AttnTensors { const bf16* Q; const bf16* K; const bf16* V; bf16* O; const float* F; const unsigned* KMAX; const unsigned* QMAX; };
struct AttnUnit { int bh; int qb; };
struct StaticOrder {
  int vcu;
  __device__ __forceinline__ explicit StaticOrder(int grid,int block):vcu((block%8)*(grid/8)+block/8){}
  __device__ __forceinline__ bool next(int i,AttnUnit&u)const{ if(i>=4)return false; const int s=vcu&7; u.bh=vcu>>3; u.qb=(i==0)?s:(i==1)?15-s:(i==2)?16+s:31-s; return true; }
  __device__ __forceinline__ void a_ready(const AttnUnit&)const{}
  __device__ __forceinline__ void done(const AttnUnit&)const{}
};
template<class Sched,int THRL=8> __device__ __forceinline__ void attn_phase(char*lds,const AttnTensors&T,const Sched&S){
  AttnUnit u;
  for(int i=0;S.next(i,u);++i){ S.a_ready(u); attn_unit<THRL>(u.bh/NHEAD,u.bh%NHEAD,u.qb,T.Q,T.K,T.V,T.O,T.F+(size_t)u.bh*SEQ,T.KMAX+u.bh*128,T.QMAX+u.bh*32,lds); S.done(u); }
}
#undef SBAR
#undef WAIT_BAR
}

#define LAS __attribute__((address_space(3)))
#define XB_TMO      128
#define XB_XCNT(j)  (256  + 64 * (j))
#define XB_XSUB(j)  (1280 + 64 * (j))
#define XB_XGEN(j)  (2304 + 64 * (j))
#define XB_TOP      3328
#define XB_TOPGEN   3392
#define XCD_BAR_WORDS 3456
#define XB_SPIN_CAP (1u << 18)

__device__ __forceinline__ unsigned xb_ld(unsigned* p)              { return __hip_atomic_load(p, __ATOMIC_RELAXED, __HIP_MEMORY_SCOPE_AGENT); }
__device__ __forceinline__ unsigned xb_add(unsigned* p, unsigned v) { return __hip_atomic_fetch_add(p, v, __ATOMIC_RELAXED, __HIP_MEMORY_SCOPE_AGENT); }
__device__ __forceinline__ unsigned xb_xcc_id() { return (unsigned)__builtin_amdgcn_s_getreg((3 << 11) | 20) & 0xFu; }
#define XB_SPIN(cond, bar) do { unsigned _sp = 0; while (cond) { __builtin_amdgcn_s_sleep(1); \
    if ((++_sp & 255u) == 0u) { if (xb_ld(&(bar)[XB_TMO])) break; if (_sp > XB_SPIN_CAP) { atomicAdd(&(bar)[XB_TMO], 1u); break; } } } } while (0)

struct XcdBarrier {
    unsigned* bar; unsigned x;
    volatile LAS unsigned* st;
};

__device__ __forceinline__ XcdBarrier xcd_barrier_post(unsigned* bar, volatile LAS unsigned* st) {
    XcdBarrier b; b.bar = bar; b.x = xb_xcc_id(); b.st = st;
    if (threadIdx.x == 0) (void)xb_add(&bar[XB_XCNT(b.x)], 1u);
    return b;
}
__device__ __forceinline__ void xcd_barrier_complete(unsigned* bar, unsigned x, unsigned& nloc, unsigned& nx) {
    const unsigned G = gridDim.x * gridDim.y * gridDim.z;
    unsigned sum, cnt, mine, sp = 0u;
    for (;;) {
        sum = 0u; cnt = 0u; mine = 0u;
#pragma unroll
        for (unsigned j = 0; j < 16; ++j) { const unsigned c = xb_ld(&bar[XB_XCNT(j)]); sum += c; cnt += (c > 0u) ? 1u : 0u; mine = (j == x) ? c : mine; }
        if (sum == G) break;
        __builtin_amdgcn_s_sleep(1);
        if ((++sp & 255u) == 0u) { if (xb_ld(&bar[XB_TMO])) break; if (sp > XB_SPIN_CAP) { atomicAdd(&bar[XB_TMO], 1u); break; } }
    }
    nloc = mine > 0u ? mine : 1u; nx = cnt > 0u ? cnt : 1u;
}

__device__ __forceinline__ void xcd_barrier(const XcdBarrier& b) {
    asm volatile("s_waitcnt vmcnt(0)" ::: "memory");
    __syncthreads();
    if (threadIdx.x == 0) {
        unsigned* bar = b.bar;
        __builtin_amdgcn_s_waitcnt(0);
        unsigned nloc = b.st[0], nx = b.st[1];
        if (nloc == 0u) { xcd_barrier_complete(bar, b.x, nloc, nx); b.st[0] = nloc; b.st[1] = nx; }
        const unsigned old = xb_add(&bar[XB_XSUB(b.x)], 1u);
        const unsigned gen = old / nloc;
        if (old + 1u == (gen + 1u) * nloc) {
            __builtin_amdgcn_fence(__ATOMIC_RELEASE, "agent");
            asm volatile("s_waitcnt vmcnt(0)" ::: "memory");
            const unsigned og = xb_add(&bar[XB_TOP], 1u);
            const unsigned tg = og / nx;
            if (og + 1u == (tg + 1u) * nx) xb_add(&bar[XB_TOPGEN], 1u);
            else XB_SPIN(xb_ld(&bar[XB_TOPGEN]) == tg, bar);
            __builtin_amdgcn_fence(__ATOMIC_ACQUIRE, "agent");
            xb_add(&bar[XB_XGEN(b.x)], 1u);
            asm volatile("s_waitcnt vmcnt(0)" ::: "memory");
        } else {
            XB_SPIN(xb_ld(&bar[XB_XGEN(b.x)]) == gen, bar);
            __builtin_amdgcn_fence(__ATOMIC_ACQUIRE, "agent");
            asm volatile("s_waitcnt vmcnt(0)" ::: "memory");
        }
    }
    __syncthreads();
}

__global__ void __launch_bounds__(512, 2) mega_fwd(Params p) {
    extern __shared__ __attribute__((aligned(16))) unsigned char lds[];
    cg::grid_group grid = cg::this_grid();
    unsigned char* ws = p.ws;
    volatile LAS unsigned* misc = (volatile LAS unsigned*)((LAS unsigned char*)lds + MISC_OFF);
    if (threadIdx.x < 16) misc[threadIdx.x] = 0u;
    __syncthreads();
    const XcdBarrier xbar = xcd_barrier_post((unsigned*)(ws + WS_CTL) + 1024, misc);
#define SEAM() xcd_barrier(xbar)
    bf16_t* XN = (bf16_t*)(ws + WS_XN); bf16_t* HB = (bf16_t*)(ws + WS_H);
    if (p.ws == nullptr) grid.sync();
    ph_prologue(p, lds); SEAM();
    ph_mods_xn1(p, lds); SEAM();
    { pg8::EpiSwiglu E{HB, DFF}; run_gemm<pg8::EpiSwiglu, true>(lds, XN, (const bf16_t*)(ws + WS_WGU), M, 2 * DFF, D, E); } SEAM();
    { pg8::EpiF32 E{(float*)(ws + WS_Y)}; run_gemm<pg8::EpiF32, false>(lds, HB, (const bf16_t*)(ws + WS_WDN), M, D, DFF, E); } SEAM();
    ph_norm_res(p, (const float*)(ws + WS_Y), p.in[I_X], p.out, true, 0, 0.5f); SEAM();
    { pg8::EpiSeg E{ws, 0}; run_gemm<pg8::EpiSeg, true>(lds, XN, (const bf16_t*)(ws + WS_WIN1), M, 5120, D, E); }
    ph_thin_mfma(p, lds); SEAM();
    ph_fcum(p, lds);
    ph_qk_norms(p);
#if GLA_MFMA
    for (int u = blockIdx.x; u < 256; u += gridDim.x) gla_passA(p, lds, u);
#else
    for (int u = blockIdx.x; u < 256; u += gridDim.x) gla_rec<false>(p, lds, u);
#endif
    SEAM();
    ph_gla_scan(p); SEAM();
#if GLA_MFMA
    for (int u = blockIdx.x; u < 256; u += gridDim.x) gla_passC(p, lds, u);
#else
    for (int u = blockIdx.x; u < 256; u += gridDim.x) gla_rec<true>(p, lds, u);
#endif
    __syncthreads();
    { const attn_body::AttnTensors AT{(const attn_body::bf16*)(ws + WS_QB), (const attn_body::bf16*)(ws + WS_KB), (const attn_body::bf16*)(ws + WS_VB), (attn_body::bf16*)(ws + WS_QB), (const float*)(ws + WS_FCUM), (const unsigned*)(ws + WS_KMAX), (const unsigned*)(ws + WS_QMAX)};
      const attn_body::StaticOrder S((int)gridDim.x, (int)blockIdx.x); attn_body::attn_phase<attn_body::StaticOrder>((char*)lds, AT, S); }
    SEAM();
    { pg8::EpiSeg E{ws, 1 + GLA_MFMA}; run_gemm<pg8::EpiSeg, true>(lds, XN, (const bf16_t*)(ws + WS_WIN2), M, 3072, D, E); }
    __syncthreads();
    convert_ffn_weights(p, lds, p.in[I_WGU2], p.in[I_WDN2]); SEAM();
#if !GLA_MFMA
    ph_oa_norm(p); SEAM();
#endif
    { pg8::EpiGate<0> E{(bf16_t*)(ws + WS_GA), nullptr}; run_gemm<pg8::EpiGate<0>, false>(lds, (const bf16_t*)(ws + WS_VA), (const bf16_t*)(ws + WS_WPA), M, D, D, E); }
    { pg8::EpiGate<1> E{(bf16_t*)(ws + WS_GB), (const bf16_t*)(ws + WS_GA)}; run_gemm<pg8::EpiGate<1>, false>(lds, (const bf16_t*)(ws + WS_QB), (const bf16_t*)(ws + WS_WPB), M, D, D, E); } SEAM();
    { pg8::EpiF32 E{(float*)(ws + WS_Y2)}; run_gemm<pg8::EpiF32, false>(lds, (const bf16_t*)(ws + WS_GB), (const bf16_t*)(ws + WS_WOUT), M, D, D, E); } SEAM();
    ph_norm_res(p, (const float*)(ws + WS_Y2), p.out, p.out, true, 1, 1.0f); SEAM();
    { pg8::EpiSwiglu E{HB, DFF}; run_gemm<pg8::EpiSwiglu, true>(lds, XN, (const bf16_t*)(ws + WS_WGU), M, 2 * DFF, D, E); } SEAM();
    { pg8::EpiF32 E{(float*)(ws + WS_Y)}; run_gemm<pg8::EpiF32, false>(lds, HB, (const bf16_t*)(ws + WS_WDN), M, D, DFF, E); } SEAM();
    ph_norm_res(p, (const float*)(ws + WS_Y), p.out, p.out, false, 2, 0.5f);
}

extern "C" void kernel_launch(void* const* d_in, const int* in_sizes, int n_in, void* d_out, int out_size, void* d_ws, size_t ws_size, hipStream_t stream) {
    static int grid = 0;
    if (grid == 0) {
        int dev = 0, cus = 0, per_cu = 0;
        hipGetDevice(&dev); hipDeviceGetAttribute(&cus, hipDeviceAttributeMultiprocessorCount, dev);
        if (hipFuncSetAttribute((const void*)mega_fwd, hipFuncAttributeMaxDynamicSharedMemorySize, LDS_BYTES) != hipSuccess) { fprintf(stderr, "hipFuncSetAttribute failed\n"); }
        if (hipOccupancyMaxActiveBlocksPerMultiprocessor(&per_cu, (const void*)mega_fwd, 512, LDS_BYTES) != hipSuccess || per_cu < 1) { fprintf(stderr, "occupancy query: %d\n", per_cu); per_cu = 1; }
        (void)hipGetLastError();
        grid = cus * per_cu;
        if (n_in != 18 || ws_size < 256 * MiB) fprintf(stderr, "unexpected n_in %d / ws %zu\n", n_in, ws_size);
    }
    Params p{};
    for (int i = 0; i < 18; ++i) p.in[i] = (const float*)d_in[i];
    p.out = (float*)d_out; p.ws = (unsigned char*)d_ws;
    (void)hipMemsetAsync((char*)d_ws + WS_CTL, 0, 65536, stream);
    void* args[] = {&p};
    hipError_t e = hipLaunchCooperativeKernel((const void*)mega_fwd, dim3(grid), dim3(512), args, LDS_BYTES, stream);
    if (e != hipSuccess) fprintf(stderr, "cooperative launch failed: %s (grid %d)\n", hipGetErrorString(e), grid);
}
```
